# Optimizing an MI355X kernel written in HIP

```python
import math
import jax
import jax.numpy as jnp
from jax import lax
import numpy as np

D_MODEL = 2048
BATCH = 1
SEQ = 8192
DEPTH = 2

N_MIXERS = 2
MEM_LEN = 256
HEAD_DIM = 128
N_ATTN_HEADS = 12
N_MEM_HEADS = 4
ATTN_WIDTH = N_ATTN_HEADS * HEAD_DIM
MEM_WIDTH = N_MEM_HEADS * HEAD_DIM
MOBA_BLOCK = 256
MOBA_TOPK = 3
MOBA_Q_CHUNK = 32
ROPE_THETA = 500000.0
ROT_DIM = HEAD_DIM // 4
SSD_D_INNER = 1536
SSD_HEAD_DIM = 64
SSD_N_HEADS = SSD_D_INNER // SSD_HEAD_DIM
SSD_N_GROUPS = 4
SSD_HEADS_PER_GROUP = SSD_N_HEADS // SSD_N_GROUPS
SSD_D_STATE = 128
SSD_CONV = 4
SSD_CHUNK = 256
SSD_CONV_DIM = SSD_D_INNER + 2 * SSD_N_GROUPS * SSD_D_STATE
MIX_WIDTH = ATTN_WIDTH + MEM_WIDTH
MOBA_IN_WIDTH = 3 * ATTN_WIDTH + MEM_WIDTH
SSD_IN_WIDTH = SSD_D_INNER + SSD_CONV_DIM + SSD_N_HEADS + MEM_WIDTH
D_FF = 7168
N_EXPERTS = 8
TOP_K = 2
EXPERT_BLOCK = 256
LN_EPS = 1e-5
RMS_EPS = 1e-5
DEEPNORM_ALPHA = (2 * DEPTH) ** 0.25
DEEPNORM_BETA = (8 * DEPTH) ** -0.25

kernel_name = "hybrid_moba_ssd_memxattn_deepnorm_moe"


def _pad_to(t, multiple, axis=1):
    n = t.shape[axis]
    n_pad = -(-n // multiple) * multiple
    if n_pad == n:
        return t
    widths = [(0, 0)] * t.ndim
    widths[axis] = (0, n_pad - n)
    return jnp.pad(t, widths)


def layer_norm(x, g, b):
    xf = x.astype(jnp.float32)
    mu = jnp.mean(xf, axis=-1, keepdims=True)
    xc = xf - mu
    var = jnp.mean(xc * xc, axis=-1, keepdims=True)
    return (xc * lax.rsqrt(var + LN_EPS) * g.astype(jnp.float32) + b.astype(jnp.float32)).astype(x.dtype)


def swiglu(x, w_gate, w_up, w_down):
    return (jax.nn.silu(x @ w_gate) * (x @ w_up)) @ w_down


def rotary_tables(positions, dtype):
    inv_freq = ROPE_THETA ** (-jnp.arange(0, ROT_DIM, 2, dtype=jnp.float32) / ROT_DIM)
    ang = positions.astype(jnp.float32)[..., None] * inv_freq
    return jnp.cos(ang)[:, :, None, :].astype(dtype), jnp.sin(ang)[:, :, None, :].astype(dtype)


def apply_partial_rotary(t, cos, sin):
    half = ROT_DIM // 2
    t1 = t[..., :half]
    t2 = t[..., half:ROT_DIM]
    return jnp.concatenate([t1 * cos - t2 * sin, t2 * cos + t1 * sin, t[..., ROT_DIM:]], axis=-1)


def memory_attention(mq, mem_k, mem_v):
    s = jnp.einsum("bthd,bmhd->bhtm", mq, mem_k).astype(jnp.float32) * (HEAD_DIM ** -0.5)
    p = jax.nn.softmax(s, axis=-1).astype(mem_v.dtype)
    return jnp.einsum("bhtm,bmhd->bthd", p, mem_v)


def moba_attention(q, k, v):
    bsz, seq, n_heads, hd = q.shape
    qh = _pad_to(q, MOBA_BLOCK).transpose(0, 2, 1, 3)
    t_pad = qh.shape[2]
    nb = t_pad // MOBA_BLOCK
    kb = _pad_to(k, MOBA_BLOCK).transpose(0, 2, 1, 3).reshape(bsz, n_heads, nb, MOBA_BLOCK, hd)
    vb = _pad_to(v, MOBA_BLOCK).transpose(0, 2, 1, 3).reshape(bsz, n_heads, nb, MOBA_BLOCK, hd)
    k_mean = jnp.mean(kb.astype(jnp.float32), axis=3)
    gate = jnp.einsum("bhtd,bhnd->bhtn", qh.astype(jnp.float32), k_mean)
    q_block = jnp.arange(t_pad) // MOBA_BLOCK
    fully_past = jnp.arange(nb)[None, :] < q_block[:, None]
    gate = jnp.where(fully_past, gate, -jnp.inf)
    n_sel = min(MOBA_TOPK, nb)
    _, sel = lax.top_k(gate, n_sel)
    sel_valid = jnp.arange(n_sel)[None, :] < q_block[:, None]
    b_idx = jnp.arange(bsz)[:, None, None, None]
    h_idx = jnp.arange(n_heads)[None, :, None, None]
    scale = hd ** -0.5

    def chunk_fn(c):
        t0 = c * MOBA_Q_CHUNK
        qc = lax.dynamic_slice_in_dim(qh, t0, MOBA_Q_CHUNK, axis=2)
        selc = lax.dynamic_slice_in_dim(sel, t0, MOBA_Q_CHUNK, axis=2)
        validc = lax.dynamic_slice_in_dim(sel_valid, t0, MOBA_Q_CHUNK, axis=0)
        own = t0 // MOBA_BLOCK
        k_own = lax.dynamic_index_in_dim(kb, own, axis=2, keepdims=False)
        v_own = lax.dynamic_index_in_dim(vb, own, axis=2, keepdims=False)
        k_sel = kb[b_idx, h_idx, selc]
        v_sel = vb[b_idx, h_idx, selc]
        s_sel = jnp.einsum("bhqd,bhqnsd->bhqns", qc, k_sel).astype(jnp.float32) * scale
        s_sel = jnp.where(validc[None, None, :, :, None], s_sel, -jnp.inf)
        s_own = jnp.einsum("bhqd,bhsd->bhqs", qc, k_own).astype(jnp.float32) * scale
        causal = (t0 + jnp.arange(MOBA_Q_CHUNK))[:, None] >= own * MOBA_BLOCK + jnp.arange(MOBA_BLOCK)[None, :]
        s_own = jnp.where(causal, s_own, -jnp.inf)
        s = jnp.concatenate([s_sel.reshape(bsz, n_heads, MOBA_Q_CHUNK, n_sel * MOBA_BLOCK), s_own], axis=-1)
        p = jax.nn.softmax(s, axis=-1).astype(vb.dtype)
        p_sel = p[..., :n_sel * MOBA_BLOCK].reshape(bsz, n_heads, MOBA_Q_CHUNK, n_sel, MOBA_BLOCK)
        p_own = p[..., n_sel * MOBA_BLOCK:]
        return (jnp.einsum("bhqns,bhqnsd->bhqd", p_sel, v_sel)
                + jnp.einsum("bhqs,bhsd->bhqd", p_own, v_own))

    out = lax.map(chunk_fn, jnp.arange(t_pad // MOBA_Q_CHUNK))
    out = out.transpose(1, 0, 3, 2, 4).reshape(bsz, t_pad, n_heads, hd)
    return out[:, :seq]


def causal_depthwise_conv(u, w, b):
    n_ch = u.shape[-1]
    out = lax.conv_general_dilated(
        u, w[:, None, :].astype(u.dtype), window_strides=(1,), padding=[(SSD_CONV - 1, 0)],
        dimension_numbers=("NWC", "WIO", "NWC"), feature_group_count=n_ch)
    return out + b


def ssd_chunked(xs, dt, a, bm, cm):
    bsz, seq, n_heads, hp = xs.shape
    f32 = jnp.float32
    xs = _pad_to(xs.astype(f32), SSD_CHUNK)
    dt = _pad_to(dt.astype(f32), SSD_CHUNK)
    bm = _pad_to(bm.astype(f32), SSD_CHUNK)
    cm = _pad_to(cm.astype(f32), SSD_CHUNK)
    t_pad = xs.shape[1]
    nc = t_pad // SSD_CHUNK
    g, e, n = SSD_N_GROUPS, SSD_HEADS_PER_GROUP, SSD_D_STATE
    xdt = (xs * dt[..., None]).reshape(bsz, nc, SSD_CHUNK, g, e, hp)
    adt = (dt * a).reshape(bsz, nc, SSD_CHUNK, g, e).transpose(0, 3, 4, 1, 2)
    bc = bm.reshape(bsz, nc, SSD_CHUNK, g, n)
    cc = cm.reshape(bsz, nc, SSD_CHUNK, g, n)
    a_cs = jnp.cumsum(adt, axis=-1)
    tril = jnp.arange(SSD_CHUNK)[:, None] >= jnp.arange(SSD_CHUNK)[None, :]
    decay = jnp.exp(jnp.where(tril, a_cs[..., :, None] - a_cs[..., None, :], -jnp.inf))
    cb = jnp.einsum("bclgn,bcsgn->bgcls", cc, bc)
    y_diag = jnp.einsum("bgecls,bcsgep->bclgep", cb[:, :, None] * decay, xdt)
    decay_states = jnp.exp(a_cs[..., -1:] - a_cs)
    states = jnp.einsum("bclgn,bgecl,bclgep->bcgepn", bc, decay_states, xdt)
    chunk_decay = jnp.exp(a_cs[..., -1])

    def step(carry, inp):
        st, dec = inp
        return carry * dec[..., None, None] + st, carry

    init = jnp.zeros((bsz, g, e, hp, n), f32)
    _, prev_states = lax.scan(step, init, (jnp.moveaxis(states, 1, 0), jnp.moveaxis(chunk_decay, -1, 0)))
    prev_states = jnp.moveaxis(prev_states, 0, 1)
    y_off = jnp.einsum("bclgn,bcgepn,bgecl->bclgep", cc, prev_states, jnp.exp(a_cs))
    y = (y_diag + y_off).reshape(bsz, t_pad, n_heads, hp)
    return y[:, :seq]


def moba_mixer(x, positions, mem_k, mem_v, w_in, w_o):
    bsz, seq, _ = x.shape
    h = x @ w_in
    q, k, v, mq = jnp.split(h, [ATTN_WIDTH, 2 * ATTN_WIDTH, 3 * ATTN_WIDTH], axis=-1)
    q = q.reshape(bsz, seq, N_ATTN_HEADS, HEAD_DIM)
    k = k.reshape(bsz, seq, N_ATTN_HEADS, HEAD_DIM)
    v = v.reshape(bsz, seq, N_ATTN_HEADS, HEAD_DIM)
    cos, sin = rotary_tables(positions, x.dtype)
    q = apply_partial_rotary(q, cos, sin)
    k = apply_partial_rotary(k, cos, sin)
    a = moba_attention(q, k, v)
    m = memory_attention(mq.reshape(bsz, seq, N_MEM_HEADS, HEAD_DIM), mem_k, mem_v)
    heads = jnp.concatenate([a.reshape(bsz, seq, ATTN_WIDTH), m.reshape(bsz, seq, MEM_WIDTH)], axis=-1)
    return heads @ w_o


def ssd_mixer(x, mem_k, mem_v, w_in, conv_w, conv_b, dt_bias, a_log, d_skip, norm_g, w_o):
    bsz, seq, _ = x.shape
    h = x @ w_in
    z, xbc, dt, mq = jnp.split(
        h, [SSD_D_INNER, SSD_D_INNER + SSD_CONV_DIM, SSD_D_INNER + SSD_CONV_DIM + SSD_N_HEADS], axis=-1)
    xbc = jax.nn.silu(causal_depthwise_conv(xbc, conv_w, conv_b))
    xs, bm, cm = jnp.split(xbc, [SSD_D_INNER, SSD_D_INNER + SSD_N_GROUPS * SSD_D_STATE], axis=-1)
    xs = xs.reshape(bsz, seq, SSD_N_HEADS, SSD_HEAD_DIM)
    bm = bm.reshape(bsz, seq, SSD_N_GROUPS, SSD_D_STATE)
    cm = cm.reshape(bsz, seq, SSD_N_GROUPS, SSD_D_STATE)
    dt = jax.nn.softplus((dt + dt_bias).astype(jnp.float32))
    a = -jnp.exp(a_log.astype(jnp.float32))
    y = ssd_chunked(xs, dt, a, bm, cm)
    y = y + d_skip.astype(jnp.float32)[:, None] * xs.astype(jnp.float32)
    y = y.reshape(bsz, seq, SSD_D_INNER)
    yg = y * jax.nn.silu(z.astype(jnp.float32))
    yg = yg * lax.rsqrt(jnp.mean(yg * yg, axis=-1, keepdims=True) + RMS_EPS) * norm_g.astype(jnp.float32)
    m = memory_attention(mq.reshape(bsz, seq, N_MEM_HEADS, HEAD_DIM), mem_k, mem_v)
    heads = jnp.concatenate([yg.astype(x.dtype), m.reshape(bsz, seq, MEM_WIDTH)], axis=-1)
    return heads @ w_o


def moe_swiglu(x, w_router, w_gate_e, w_up_e, w_down_e):
    bsz, seq, d = x.shape
    xt = x.reshape(bsz * seq, d)
    n_tok = xt.shape[0]
    logits = (xt @ w_router).astype(jnp.float32)
    top_val, top_idx = lax.top_k(logits, TOP_K)
    gates = jax.nn.softmax(top_val, axis=-1).astype(x.dtype)
    n_assign = n_tok * TOP_K
    flat_e = top_idx.reshape(n_assign)
    flat_tok = jnp.repeat(jnp.arange(n_tok, dtype=jnp.int32), TOP_K)
    flat_w = gates.reshape(n_assign)
    order = jnp.argsort(flat_e)
    sorted_e = flat_e[order]
    counts = jnp.bincount(flat_e, length=N_EXPERTS)
    starts = jnp.cumsum(counts) - counts
    padded = (counts + EXPERT_BLOCK - 1) // EXPERT_BLOCK * EXPERT_BLOCK
    pad_ends = jnp.cumsum(padded)
    pad_starts = pad_ends - padded
    dest = pad_starts[sorted_e] + (jnp.arange(n_assign) - starts[sorted_e])
    n_blocks = -(-n_assign // EXPERT_BLOCK) + N_EXPERTS
    n_rows = n_blocks * EXPERT_BLOCK
    row_tok = jnp.zeros((n_rows,), jnp.int32).at[dest].set(flat_tok[order])
    row_w = jnp.zeros((n_rows,), x.dtype).at[dest].set(flat_w[order])
    block_e = jnp.minimum(
        jnp.searchsorted(pad_ends, jnp.arange(n_blocks) * EXPERT_BLOCK, side="right"), N_EXPERTS - 1)

    def block_fn(args):
        tok, e = args
        return swiglu(xt[tok], w_gate_e[e], w_up_e[e], w_down_e[e])

    y_rows = lax.map(block_fn, (row_tok.reshape(n_blocks, EXPERT_BLOCK), block_e))
    out = jnp.zeros_like(xt).at[row_tok].add(row_w[:, None] * y_rows.reshape(n_rows, d))
    return out.reshape(bsz, seq, d)


def setup_inputs(seed: int = 0) -> dict:
    key = jax.random.key(seed)
    ks = iter(jax.random.split(key, 48))
    f32 = jnp.float32

    def nrm(shape, scale):
        return jax.random.normal(next(ks), shape, f32) * scale

    def gain(n):
        return 1.0 + nrm((n,), 0.02)

    D = D_MODEL
    x = nrm((BATCH, SEQ, D), 1.0)
    mem = nrm((BATCH, MEM_LEN, D), 1.0)
    positions = jnp.broadcast_to(jnp.arange(SEQ, dtype=jnp.int32), (BATCH, SEQ))
    w_mem_kv = nrm((D, 2 * MEM_WIDTH), D ** -0.5)
    l0_w_in = nrm((D, MOBA_IN_WIDTH), D ** -0.5)
    l0_w_o = nrm((MIX_WIDTH, D), MIX_WIDTH ** -0.5 * DEEPNORM_BETA)
    l0_ln1_g = gain(D)
    l0_ln1_b = nrm((D,), 0.02)
    l0_ffn_w_gate = nrm((D, D_FF), D ** -0.5)
    l0_ffn_w_up = nrm((D, D_FF), D ** -0.5)
    l0_ffn_w_down = nrm((D_FF, D), D_FF ** -0.5 * DEEPNORM_BETA)
    l0_ln2_g = gain(D)
    l0_ln2_b = nrm((D,), 0.02)
    l1_w_in = nrm((D, SSD_IN_WIDTH), D ** -0.5)
    l1_conv_w = nrm((SSD_CONV, SSD_CONV_DIM), SSD_CONV ** -0.5)
    l1_conv_b = nrm((SSD_CONV_DIM,), 0.02)
    dt0 = jnp.exp(jax.random.uniform(next(ks), (SSD_N_HEADS,), f32, math.log(1e-3), math.log(1e-1)))
    l1_dt_bias = dt0 + jnp.log(-jnp.expm1(-dt0))
    l1_a_log = jnp.log(jax.random.uniform(next(ks), (SSD_N_HEADS,), f32, 1.0, 16.0))
    l1_d_skip = 1.0 + nrm((SSD_N_HEADS,), 0.1)
    l1_ssd_norm_g = gain(SSD_D_INNER)
    l1_w_o = nrm((MIX_WIDTH, D), MIX_WIDTH ** -0.5 * DEEPNORM_BETA)
    l1_ln1_g = gain(D)
    l1_ln1_b = nrm((D,), 0.02)
    l1_router = nrm((D, N_EXPERTS), D ** -0.5)
    l1_exp_w_gate = nrm((N_EXPERTS, D, D_FF), D ** -0.5)
    l1_exp_w_up = nrm((N_EXPERTS, D, D_FF), D ** -0.5)
    l1_exp_w_down = nrm((N_EXPERTS, D_FF, D), D_FF ** -0.5 * DEEPNORM_BETA)
    l1_ln2_g = gain(D)
    l1_ln2_b = nrm((D,), 0.02)
    return {
        "x": x, "mem": mem, "positions": positions, "w_mem_kv": w_mem_kv,
        "l0_w_in": l0_w_in, "l0_w_o": l0_w_o, "l0_ln1_g": l0_ln1_g, "l0_ln1_b": l0_ln1_b,
        "l0_ffn_w_gate": l0_ffn_w_gate, "l0_ffn_w_up": l0_ffn_w_up, "l0_ffn_w_down": l0_ffn_w_down,
        "l0_ln2_g": l0_ln2_g, "l0_ln2_b": l0_ln2_b,
        "l1_w_in": l1_w_in, "l1_conv_w": l1_conv_w, "l1_conv_b": l1_conv_b,
        "l1_dt_bias": l1_dt_bias, "l1_a_log": l1_a_log, "l1_d_skip": l1_d_skip,
        "l1_ssd_norm_g": l1_ssd_norm_g, "l1_w_o": l1_w_o, "l1_ln1_g": l1_ln1_g, "l1_ln1_b": l1_ln1_b,
        "l1_router": l1_router, "l1_exp_w_gate": l1_exp_w_gate, "l1_exp_w_up": l1_exp_w_up,
        "l1_exp_w_down": l1_exp_w_down, "l1_ln2_g": l1_ln2_g, "l1_ln2_b": l1_ln2_b,
    }


def reference(x, mem, positions, w_mem_kv,
              l0_w_in, l0_w_o, l0_ln1_g, l0_ln1_b, l0_ffn_w_gate, l0_ffn_w_up, l0_ffn_w_down,
              l0_ln2_g, l0_ln2_b,
              l1_w_in, l1_conv_w, l1_conv_b, l1_dt_bias, l1_a_log, l1_d_skip, l1_ssd_norm_g,
              l1_w_o, l1_ln1_g, l1_ln1_b, l1_router, l1_exp_w_gate, l1_exp_w_up, l1_exp_w_down,
              l1_ln2_g, l1_ln2_b):
    bsz = mem.shape[0]
    mem_kv = (mem @ w_mem_kv).reshape(bsz, MEM_LEN, 2, N_MEM_HEADS, HEAD_DIM)
    mem_k = mem_kv[:, :, 0]
    mem_v = mem_kv[:, :, 1]
    layer_params = [
        {"w_in": l0_w_in, "w_o": l0_w_o, "ln1_g": l0_ln1_g, "ln1_b": l0_ln1_b,
         "ffn": (l0_ffn_w_gate, l0_ffn_w_up, l0_ffn_w_down), "ln2_g": l0_ln2_g, "ln2_b": l0_ln2_b},
        {"w_in": l1_w_in, "w_o": l1_w_o, "ln1_g": l1_ln1_g, "ln1_b": l1_ln1_b,
         "ssd": (l1_conv_w, l1_conv_b, l1_dt_bias, l1_a_log, l1_d_skip, l1_ssd_norm_g),
         "moe": (l1_router, l1_exp_w_gate, l1_exp_w_up, l1_exp_w_down),
         "ln2_g": l1_ln2_g, "ln2_b": l1_ln2_b},
    ]
    for i in range(DEPTH):
        p = layer_params[i]
        if i % N_MIXERS == 0:
            y = moba_mixer(x, positions, mem_k, mem_v, p["w_in"], p["w_o"])
        else:
            y = ssd_mixer(x, mem_k, mem_v, p["w_in"], *p["ssd"], p["w_o"])
        x = layer_norm(DEEPNORM_ALPHA * x + y, p["ln1_g"], p["ln1_b"])
        if i % 2 == 0:
            f = swiglu(x, *p["ffn"])
        else:
            f = moe_swiglu(x, *p["moe"])
        x = layer_norm(DEEPNORM_ALPHA * x + f, p["ln2_g"], p["ln2_b"])
    return x
```

```cpp
#include <hip/hip_runtime.h>
#include <cstdio>
#include <cstdint>
#include <cmath>
constexpr int WTAB_OFF = 131072 + 512;
__device__ __forceinline__ int fresh_tid() {
    extern __shared__ __attribute__((aligned(16))) unsigned char lds_dyn_[];
    unsigned z_; asm volatile("s_mov_b32 %0, 0" : "=s"(z_));
    const unsigned key = (unsigned)__builtin_amdgcn_s_getreg((5 << 11) | 4) & 63u;
    const int wid = __builtin_amdgcn_readfirstlane(((const __attribute__((address_space(3))) int*)((__attribute__((address_space(3))) unsigned char*)lds_dyn_ + WTAB_OFF))[key + z_]);
    return wid * 64 + (int)__builtin_amdgcn_mbcnt_hi(~0u, __builtin_amdgcn_mbcnt_lo(~0u, z_));
}
namespace pg8 {
#define PG8_LAS __attribute__((address_space(3)))
typedef unsigned short bf16_t;
typedef short bf16x8 __attribute__((ext_vector_type(8)));
typedef float f32x4 __attribute__((ext_vector_type(4)));
typedef unsigned u32x4 __attribute__((ext_vector_type(4)));
constexpr int BM = 256, BK = 64, HALF = 128, HTB = HALF * BK * 2  , STAGE_BYTES = 8 * HTB, NXCD = 8, WGM = 8;

__host__ __device__ __forceinline__ int lds_byte(int r, int c) { const int st = (r >> 4) * 2 + (c >> 5), rr = r & 15, cc = c & 31, ob = rr * 64 + cc * 2; return st * 1024 + (ob ^ (((ob >> 9) & 1) << 5)); }
__host__ __device__ __forceinline__ void stage_rc(int b, int& R, int& C) { const int st = b / 1024, sb = b % 1024, swz = sb ^ (((sb >> 9) & 1) << 5); R = (st >> 1) * 16 + swz / 64; C = (st & 1) * 32 + (swz % 64) / 2; }
__host__ __device__ __forceinline__ int perm32(int rho) { const int n = rho >> 4, i = rho & 15; return 8 * (i >> 2) + 4 * n + (i & 3); }

struct Unit { int pm, pn, kofs, opm, opn; };
struct Gemm { const bf16_t* A; const bf16_t* Bt; int M, N, K, ld; };

struct StaticOrder {
    int nM, nN, nwg, G, c;
    __host__ __device__ void init(int M, int N, int G_, int c_) { nM = M / BM; nN = N / BM; nwg = nM * nN; G = G_; c = c_; }
    __host__ __device__ bool next(int i, Unit& u) const {
        const long L = (long)i * G + c; if (L >= nwg) return false;
        int wgid = (int)L; { const int q = nwg / NXCD, r = nwg % NXCD, xcd = wgid % NXCD, off = wgid / NXCD; wgid = (xcd < r ? xcd * (q + 1) : r * (q + 1) + (xcd - r) * q) + off; }
        const int nig = WGM * nN, gid = wgid / nig, fm = gid * WGM, gsz = (nM - fm) < WGM ? (nM - fm) : WGM;
        u.pm = fm + ((wgid % nig) % gsz); u.pn = (wgid % nig) / gsz; u.kofs = 0; u.opm = u.pm; u.opn = u.pn; return true;
    }
    __device__ __forceinline__ void a_ready(const Unit&) const {}
    __device__ __forceinline__ void done(const Unit&) const {}
};

__device__ __forceinline__ unsigned cvt_pk_bf16(float lo, float hi) { unsigned r; asm volatile("v_cvt_pk_bf16_f32 %0, %1, %2" : "=v"(r) : "v"(lo), "v"(hi)); return r; }
typedef float f32x2 __attribute__((ext_vector_type(2)));
__device__ __forceinline__ f32x2 gelu_pk(f32x2 v) {
    const f32x2 av = __builtin_elementwise_abs(v), d = av * 0.2316418882f + 1.0f;
    f32x2 t; t.x = __builtin_amdgcn_rcpf(d.x); t.y = __builtin_amdgcn_rcpf(d.y);
    f32x2 q = t * 0.5307027145f + (-0.7265760135f); q = q * t + 0.7107068705f; q = q * t + (-0.142248368f); q = q * t + 0.127414796f; q = q * t;
    const f32x2 s = (v * v) * (-0.72134752044f);
    f32x2 e; e.x = __builtin_amdgcn_exp2f(s.x); e.y = __builtin_amdgcn_exp2f(s.y);
    const f32x2 m = v * (q * e), r = v - m;
    f32x2 o; o.x = v.x < 0.f ? m.x : r.x; o.y = v.y < 0.f ? m.y : r.y; return o;
}

template <int ACT  > struct EpiBf16 {
    static constexpr bool PERM = true, AFTER_DRAIN = false; static_assert(ACT == 0 || ACT == 1, "EpiBf16: ACT is 0 (none) or 1 (gelu_pk)");
    bf16_t* O; int ldc; const float* bias; int split_cols; size_t split_stride; float scale0;
    __device__ __forceinline__ void operator()(const f32x4 (&acc)[2][2][4][2], const Unit& u, int wr, int wc, int fr, int fq) const {
        const int row0 = u.pm * BM + wr * 64 + fr; int colt = u.pn * BM; bf16_t* base = O;
        float sc = 1.f; if (split_cols) { const int t = colt / split_cols; base += (size_t)t * split_stride; colt -= t * split_cols; if (t == 0) sc = scale0; }
        const int col0 = colt + wc * 32 + 8 * fq, bcol0 = u.pn * BM + wc * 32 + 8 * fq;
        f32x4 bv[2][2];
#pragma unroll
        for (int bj = 0; bj < 2; ++bj)
#pragma unroll
            for (int n = 0; n < 2; ++n) bv[bj][n] = bias ? *(const f32x4*)(bias + bcol0 + bj * HALF + 4 * n) : (f32x4){0.f, 0.f, 0.f, 0.f};
#pragma unroll
        for (int ai = 0; ai < 2; ++ai)
#pragma unroll
            for (int m = 0; m < 4; ++m) { bf16_t* rowp = base + (size_t)(row0 + ai * HALF + m * 16) * ldc + col0;
#pragma unroll
                for (int bj = 0; bj < 2; ++bj) { f32x4 v0 = acc[ai][bj][m][0] + bv[bj][0], v1 = acc[ai][bj][m][1] + bv[bj][1];
                    if (ACT == 1) { f32x2 a = gelu_pk((f32x2){v0[0], v0[1]}), b = gelu_pk((f32x2){v0[2], v0[3]}), c = gelu_pk((f32x2){v1[0], v1[1]}), d = gelu_pk((f32x2){v1[2], v1[3]});
                        v0 = (f32x4){a.x, a.y, b.x, b.y}; v1 = (f32x4){c.x, c.y, d.x, d.y}; }
                    v0 = v0 * sc; v1 = v1 * sc; u32x4 w; w.x = cvt_pk_bf16(v0[0], v0[1]); w.y = cvt_pk_bf16(v0[2], v0[3]); w.z = cvt_pk_bf16(v1[0], v1[1]); w.w = cvt_pk_bf16(v1[2], v1[3]);
                    *(u32x4*)(rowp + bj * HALF) = w; } }
    }
};
struct EpiF32 {
    static constexpr bool PERM = false, AFTER_DRAIN = false;
    float* C; int ldc; const float* bias;
    __device__ __forceinline__ void operator()(const f32x4 (&acc)[2][2][4][2], const Unit& u, int wr, int wc, int fr, int fq) const {
        const int row0 = u.pm * BM + wr * 64 + fr, col0 = u.pn * BM + wc * 32 + 4 * fq;
        f32x4 bv[2][2];
#pragma unroll
        for (int bj = 0; bj < 2; ++bj)
#pragma unroll
            for (int n = 0; n < 2; ++n) bv[bj][n] = bias ? *(const f32x4*)(bias + col0 + bj * HALF + n * 16) : (f32x4){0.f, 0.f, 0.f, 0.f};
#pragma unroll
        for (int ai = 0; ai < 2; ++ai)
#pragma unroll
            for (int m = 0; m < 4; ++m) { float* rowp = C + (size_t)(row0 + ai * HALF + m * 16) * ldc + col0;
#pragma unroll
                for (int bj = 0; bj < 2; ++bj)
#pragma unroll
                    for (int n = 0; n < 2; ++n) *(f32x4*)(rowp + bj * HALF + n * 16) = acc[ai][bj][m][n] + bv[bj][n]; }
    }
};
__device__ __forceinline__ float silu_f(float g) { return g * __builtin_amdgcn_rcpf(1.0f + __builtin_amdgcn_exp2f(-1.4426950408889634f * g)); }
struct EpiSwiGLU {
    static constexpr bool PERM = true, AFTER_DRAIN = false;
    bf16_t* O; int ldc;
    __device__ __forceinline__ void operator()(const f32x4 (&acc)[2][2][4][2], const Unit& u, int wr, int wc, int fr, int fq) const {
        const int row0 = u.opm * BM + wr * 64 + fr, col0 = u.opn * HALF + wc * 32 + 8 * fq;
#pragma unroll
        for (int ai = 0; ai < 2; ++ai)
#pragma unroll
            for (int m = 0; m < 4; ++m) { bf16_t* rowp = O + (size_t)(row0 + ai * HALF + m * 16) * ldc + col0;
                const f32x4 g0 = acc[ai][0][m][0], g1 = acc[ai][0][m][1], u0 = acc[ai][1][m][0], u1 = acc[ai][1][m][1];
                f32x4 h0, h1;
#pragma unroll
                for (int j = 0; j < 4; ++j) { h0[j] = silu_f(g0[j]) * u0[j]; h1[j] = silu_f(g1[j]) * u1[j]; }
                u32x4 w; w.x = cvt_pk_bf16(h0[0], h0[1]); w.y = cvt_pk_bf16(h0[2], h0[3]); w.z = cvt_pk_bf16(h1[0], h1[1]); w.w = cvt_pk_bf16(h1[2], h1[3]);
                *(u32x4*)rowp = w; }
    }
};
struct EpiSwiGLU8 {
    static constexpr bool PERM = true, AFTER_DRAIN = false;
    unsigned char* O; int ldc;
    __device__ __forceinline__ void operator()(const f32x4 (&acc)[2][2][4][2], const Unit& u, int wr, int wc, int fr, int fq) const {
        const int row0 = u.opm * BM + wr * 64 + fr, col0 = u.opn * HALF + wc * 32 + 8 * fq;
#pragma unroll
        for (int ai = 0; ai < 2; ++ai)
#pragma unroll
            for (int m = 0; m < 4; ++m) { unsigned char* rowp = O + (size_t)(row0 + ai * HALF + m * 16) * ldc + col0;
                const f32x4 g0 = acc[ai][0][m][0], g1 = acc[ai][0][m][1], u0 = acc[ai][1][m][0], u1 = acc[ai][1][m][1];
                f32x4 h0, h1;
#pragma unroll
                for (int j = 0; j < 4; ++j) { h0[j] = __builtin_fminf(__builtin_fmaxf(silu_f(g0[j]) * u0[j] * 8.0f, -448.0f), 448.0f); h1[j] = __builtin_fminf(__builtin_fmaxf(silu_f(g1[j]) * u1[j] * 8.0f, -448.0f), 448.0f); }
                int w0 = 0, w1 = 0;
                w0 = __builtin_amdgcn_cvt_pk_fp8_f32(h0[0], h0[1], w0, false); w0 = __builtin_amdgcn_cvt_pk_fp8_f32(h0[2], h0[3], w0, true);
                w1 = __builtin_amdgcn_cvt_pk_fp8_f32(h1[0], h1[1], w1, false); w1 = __builtin_amdgcn_cvt_pk_fp8_f32(h1[2], h1[3], w1, true);
                typedef unsigned v2u_ __attribute__((ext_vector_type(2)));
                *(v2u_*)rowp = (v2u_){(unsigned)w0, (unsigned)w1}; }
    }
};
struct EpiF32Mod {
    static constexpr bool PERM = false, AFTER_DRAIN = false;
    float* C; int ldc;
    __device__ __forceinline__ void operator()(const f32x4 (&acc)[2][2][4][2], const Unit& u, int wr, int wc, int fr, int fq) const {
        const int row0 = u.opm * BM + wr * 64 + fr, col0 = u.opn * BM + wc * 32 + 4 * fq;
#pragma unroll
        for (int ai = 0; ai < 2; ++ai)
#pragma unroll
            for (int m = 0; m < 4; ++m) { float* rowp = C + (size_t)(row0 + ai * HALF + m * 16) * ldc + col0;
#pragma unroll
                for (int bj = 0; bj < 2; ++bj)
#pragma unroll
                    for (int n = 0; n < 2; ++n) *(f32x4*)(rowp + bj * HALF + n * 16) = acc[ai][bj][m][n]; }
    }
};
struct EpiBf16Mod {
    static constexpr bool PERM = true, AFTER_DRAIN = false;
    bf16_t* O; int ldc;
    __device__ __forceinline__ void operator()(const f32x4 (&acc)[2][2][4][2], const Unit& u, int wr, int wc, int fr, int fq) const {
        const int row0 = u.opm * BM + wr * 64 + fr, col0 = u.opn * BM + wc * 32 + 8 * fq;
#pragma unroll
        for (int ai = 0; ai < 2; ++ai)
#pragma unroll
            for (int m = 0; m < 4; ++m) { bf16_t* rowp = O + (size_t)(row0 + ai * HALF + m * 16) * ldc + col0;
#pragma unroll
                for (int bj = 0; bj < 2; ++bj) { const f32x4 v0 = acc[ai][bj][m][0], v1 = acc[ai][bj][m][1];
                    u32x4 w; w.x = cvt_pk_bf16(v0[0], v0[1]); w.y = cvt_pk_bf16(v0[2], v0[3]); w.z = cvt_pk_bf16(v1[0], v1[1]); w.w = cvt_pk_bf16(v1[2], v1[3]);
                    *(u32x4*)(rowp + bj * HALF) = w; } }
    }
};
struct EpiQKV {
    static constexpr bool PERM = true, AFTER_DRAIN = false;
    bf16_t* O; int ldc; const float* rope; float* kpart;
    __device__ __forceinline__ void operator()(const f32x4 (&acc)[2][2][4][2], const Unit& u, int wr, int wc, int fr, int fq) const {
        const int row0 = u.pm * BM + wr * 64 + fr; const int col0 = u.pn * BM + wc * 32 + 8 * fq;
        const bool rot = (u.pn < 12) && (wc == 0), isk = (u.pn >= 6) && (u.pn < 12);
        f32x4 cs_[2][2];
#pragma unroll
        for (int bj = 0; bj < 2; ++bj)
#pragma unroll
            for (int n = 0; n < 2; ++n) cs_[bj][n] = (f32x4){0.f, 0.f, 0.f, 0.f};
#pragma unroll
        for (int ai = 0; ai < 2; ++ai)
#pragma unroll
            for (int m = 0; m < 4; ++m) { const int t = row0 + ai * HALF + m * 16; bf16_t* rowp = O + (size_t)t * ldc + col0;
                f32x4 c4[2];
                if (rot) { c4[0] = *(const f32x4*)(rope + ((size_t)t * 16 + 4 * fq) * 2); c4[1] = *(const f32x4*)(rope + ((size_t)t * 16 + 4 * fq + 2) * 2); }
#pragma unroll
                for (int bj = 0; bj < 2; ++bj) { f32x4 v[2];
#pragma unroll
                    for (int n = 0; n < 2; ++n) { v[n] = acc[ai][bj][m][n];
                        if (rot) { const f32x4 x = v[n], c = c4[n]; v[n] = (f32x4){x[0] * c[0] - x[1] * c[1], x[1] * c[0] + x[0] * c[1], x[2] * c[2] - x[3] * c[3], x[3] * c[2] + x[2] * c[3]}; }
                        cs_[bj][n] += v[n]; }
                    u32x4 w; w.x = cvt_pk_bf16(v[0][0], v[0][1]); w.y = cvt_pk_bf16(v[0][2], v[0][3]); w.z = cvt_pk_bf16(v[1][0], v[1][1]); w.w = cvt_pk_bf16(v[1][2], v[1][3]);
                    *(u32x4*)(rowp + bj * HALF) = w; } }
        if (isk) {
#pragma unroll
            for (int bj = 0; bj < 2; ++bj)
#pragma unroll
                for (int n = 0; n < 2; ++n)
#pragma unroll
                    for (int j = 0; j < 4; ++j) { float s = cs_[bj][n][j]; s += __shfl_xor(s, 1); s += __shfl_xor(s, 2); s += __shfl_xor(s, 4); s += __shfl_xor(s, 8); cs_[bj][n][j] = s; }
            if (fr == 0) {
#pragma unroll
                for (int bj = 0; bj < 2; ++bj) { float* kp = kpart + ((size_t)((2 * (u.pn - 6) + bj) * 32 + u.pm) * 2 + wr) * 128 + wc * 32 + 8 * fq;
                    *(f32x4*)kp = cs_[bj][0]; *(f32x4*)(kp + 4) = cs_[bj][1]; } }
        }
    }
};
struct EpiIn1 {
    static constexpr bool PERM = true, AFTER_DRAIN = false;
    bf16_t* O; int ldc; float* DT; int dt_pn;
    __device__ __forceinline__ void operator()(const f32x4 (&acc)[2][2][4][2], const Unit& u, int wr, int wc, int fr, int fq) const {
        const int row0 = u.pm * BM + wr * 64 + fr; const int col0 = u.pn * BM + wc * 32 + 8 * fq;
#pragma unroll
        for (int ai = 0; ai < 2; ++ai)
#pragma unroll
            for (int m = 0; m < 4; ++m) { bf16_t* rowp = O + (size_t)(row0 + ai * HALF + m * 16) * ldc + col0;
#pragma unroll
                for (int bj = 0; bj < 2; ++bj) { const f32x4 v0 = acc[ai][bj][m][0], v1 = acc[ai][bj][m][1];
                    u32x4 w; w.x = cvt_pk_bf16(v0[0], v0[1]); w.y = cvt_pk_bf16(v0[2], v0[3]); w.z = cvt_pk_bf16(v1[0], v1[1]); w.w = cvt_pk_bf16(v1[2], v1[3]);
                    *(u32x4*)(rowp + bj * HALF) = w; } }
        if (u.pn == dt_pn && wc == 0 && fq < 3) {
#pragma unroll
            for (int ai = 0; ai < 2; ++ai)
#pragma unroll
                for (int m = 0; m < 4; ++m) { float* dp = DT + (size_t)(row0 + ai * HALF + m * 16) * 32 + 8 * fq;
                    *(f32x4*)dp = acc[ai][0][m][0]; *(f32x4*)(dp + 4) = acc[ai][0][m][1]; }
        }
    }
};
struct MoeOrder {
    int G, c, npn, per, imax; int tp[9];
    __device__ __forceinline__ void init(const int* counts, int npn_, int G_, int c_, int imax_) { G = G_; c = c_; npn = npn_; imax = imax_; tp[0] = 0;
#pragma unroll
        for (int e = 0; e < 8; ++e) tp[e + 1] = tp[e] + ((counts[e] + 255) >> 8);
        per = tp[8] * npn / 8; }
    __device__ __forceinline__ void decode(int L, Unit& u) const {
        int e = 0;
#pragma unroll
        for (int k = 1; k < 8; ++k) e += (L >= tp[k] * npn) ? 1 : 0;
        int tpe = 0, tpn = 0;
#pragma unroll
        for (int k = 0; k < 8; ++k) { if (k == e) { tpe = tp[k]; tpn = tp[k + 1]; } }
        const int r = L - tpe * npn, nt = tpn - tpe; const int pn = r / nt, pml = r - pn * nt;
        u.pm = tpe + pml; u.pn = e * npn + pn; u.kofs = 0; u.opm = u.pm; u.opn = pn; }
    __device__ __forceinline__ bool next(int i, Unit& u) const {
        const int s = i * (G >> 3) + (c >> 3); if (i >= imax || s >= per) return false;
        decode((c & 7) * per + s, u); return true; }
    __device__ __forceinline__ void a_ready(const Unit&) const {}
    __device__ __forceinline__ void done(const Unit&) const {}
};
struct MoeSplitOrder {
    MoeOrder base; int first, S, kpiece;
    __device__ __forceinline__ void init(const MoeOrder& b, int done_rounds, int S_, int Ktot) { base = b; first = done_rounds * (b.G >> 3); S = S_; kpiece = Ktot / S_; }
    __device__ __forceinline__ bool next(int i, Unit& u) const {
        const int q = base.c >> 3; if (i > 0 || first + q / S >= base.per) return false;
        base.decode((base.c & 7) * base.per + first + q / S, u); u.kofs = (q % S) * kpiece; u.opm = (base.c & 7) * 32 + q; u.opn = 0; return true; }
    __device__ __forceinline__ void a_ready(const Unit&) const {}
    __device__ __forceinline__ void done(const Unit&) const {}
};
template <class Base> struct RangeOrder {
    Base b; int i0, i1;
    __device__ __forceinline__ bool next(int i, Unit& u) const { return (i0 + i < i1) && b.next(i0 + i, u); }
    __device__ __forceinline__ void a_ready(const Unit&) const {}
    __device__ __forceinline__ void done(const Unit&) const {}
};
template <class Epi, class Sched, bool ALIGN_EPI = false, bool SP2 = false, int FP8 = 0>
__device__ __forceinline__ void gemm_phase(PG8_LAS unsigned char* lds, const Gemm g, const Sched& S, const Epi& E, int tid_in = -1) {
    int tid_ = fresh_tid(); (void)tid_in; asm volatile("" : "+v"(tid_));
    const int tid = tid_, wid = __builtin_amdgcn_readfirstlane(tid >> 6), lane = tid & 63, wr = wid >> 2, wc = wid & 3, fr = lane & 15, fq = lane >> 4;
    const int K = g.ld, nt = g.K / BK;
    unsigned voffA[2], voffB[2];
#pragma unroll
    for (int i = 0; i < 2; ++i) { int R, C; stage_rc(tid * 16 + i * 8192, R, C); const int Rb = Epi::PERM ? ((R & ~31) + perm32(R & 31)) : R;
        voffA[i] = (unsigned)(R * K + C) * 2u; voffB[i] = (unsigned)(Rb * K + C) * 2u; }
    const size_t kstep = (size_t)(BK * 2);
    const size_t hstep = (size_t)HALF * K * 2;
    const size_t tstep = 2 * hstep;
    const unsigned ldsw = (unsigned)wid * 1024u;
    const int aoff = lds_byte(wr * 64 + fr, fq * 8), boff = lds_byte(wc * 32 + fr, fq * 8);
#define PG8_SA(b, h) (((b) * 2 + (h)) * HTB)
#define PG8_SB(b, h) ((4 + (b) * 2 + (h)) * HTB)
#define PG8_STAGE(bufoff, gbase, voff) do { _Pragma("unroll") for (int _i = 0; _i < 2; ++_i) { unsigned vo_ = (voff)[_i]; if constexpr (FP8 != 0) asm volatile("" : "+v"(vo_));     \
        __builtin_amdgcn_global_load_lds((const unsigned*)((const char*)(gbase) + vo_), (PG8_LAS unsigned*)(lds + (bufoff) + ldsw + _i * 8192), 16, 0, 0); } } while (0)
#define PG8_LDA(dst, b, h) do { if constexpr (FP8 == 0) { _Pragma("unroll") for (int m = 0; m < 4; ++m) _Pragma("unroll") for (int k = 0; k < 2; ++k) dst[m][k] = *(const PG8_LAS bf16x8*)(lds + PG8_SA(b, h) + aoff + m * 2048 + k * 1024); } \
    else { _Pragma("unroll") for (int m = 0; m < 4; ++m) { const v4i_ l_ = *(const PG8_LAS v4i_*)(lds + PG8_SA(b, h) + aoff + m * 2048), h_ = *(const PG8_LAS v4i_*)(lds + PG8_SA(b, h) + aoff + m * 2048 + 1024); \
        dst##8[m] = __builtin_shufflevector(l_, h_, 0, 1, 2, 3, 4, 5, 6, 7); } } } while (0)
#define PG8_LDB(dst, b, h) do { if constexpr (FP8 == 0) { _Pragma("unroll") for (int n = 0; n < 2; ++n) _Pragma("unroll") for (int k = 0; k < 2; ++k) dst[n][k] = *(const PG8_LAS bf16x8*)(lds + PG8_SB(b, h) + boff + n * 2048 + k * 1024); } \
    else { _Pragma("unroll") for (int n = 0; n < 2; ++n) { const v4i_ l_ = *(const PG8_LAS v4i_*)(lds + PG8_SB(b, h) + boff + n * 2048), h_ = *(const PG8_LAS v4i_*)(lds + PG8_SB(b, h) + boff + n * 2048 + 1024); \
        dst##8[n] = __builtin_shufflevector(l_, h_, 0, 1, 2, 3, 4, 5, 6, 7); } } } while (0)
#define PG8_MMA(ai, bj, At, Bt) do { __builtin_amdgcn_s_setprio(1); if constexpr (FP8 == 0) { _Pragma("unroll") for (int m = 0; m < 4; ++m) _Pragma("unroll") for (int n = 0; n < 2; ++n) _Pragma("unroll") for (int k = 0; k < 2; ++k) \
        acc[ai][bj][m][n] = __builtin_amdgcn_mfma_f32_16x16x32_bf16(Bt[n][k], At[m][k], acc[ai][bj][m][n], 0, 0, 0); } \
    else { _Pragma("unroll") for (int m = 0; m < 4; ++m) _Pragma("unroll") for (int n = 0; n < 2; ++n) \
        acc[ai][bj][m][n] = __builtin_amdgcn_mfma_scale_f32_16x16x128_f8f6f4(Bt##8[n], At##8[m], acc[ai][bj][m][n], 0, 0, 0, FP8 * 0x01010101, 0, FP8 * 0x01010101); } \
    __builtin_amdgcn_s_setprio(0); } while (0)
#define PG8_WAIT_V(n) asm volatile("s_waitcnt vmcnt(" #n ")" ::: "memory")
#define PG8_WAIT_L(n) asm volatile("s_waitcnt lgkmcnt(" #n ")" ::: "memory")
#define PG8_BAR __builtin_amdgcn_s_barrier()
#define PG8_SCHED __builtin_amdgcn_sched_barrier(0)
    Unit cur, nxt; int ui = 0;
    if (!S.next(0, cur)) return;
    f32x4 acc[2][2][4][2];
#pragma unroll
    for (int a = 0; a < 2; ++a)
#pragma unroll
        for (int b = 0; b < 2; ++b)
#pragma unroll
            for (int m = 0; m < 4; ++m)
#pragma unroll
                for (int n = 0; n < 2; ++n) acc[a][b][m][n] = (f32x4){0.f, 0.f, 0.f, 0.f};
    typedef int v4i_ __attribute__((ext_vector_type(4))); typedef int v8i_ __attribute__((ext_vector_type(8)));
    bf16x8 At[4][2], B0[2][2], B1[2][2];
    v8i_ At8[4], B08[2], B18[2];
    const char* cA = (const char*)g.A + (size_t)cur.pm * tstep + (size_t)cur.kofs * 2; const char* cB = (const char*)g.Bt + (size_t)cur.pn * tstep + (size_t)cur.kofs * 2;
    S.a_ready(cur);
    if constexpr (SP2) {
        PG8_STAGE(PG8_SB(0, 0), cB, voffB); PG8_STAGE(PG8_SB(0, 1), cB + hstep, voffB); PG8_STAGE(PG8_SA(0, 0), cA, voffA); PG8_STAGE(PG8_SA(0, 1), cA + hstep, voffA);
        if (wr == 1) PG8_BAR;
        PG8_WAIT_V(2); PG8_BAR;
        PG8_STAGE(PG8_SB(1, 0), cB + kstep, voffB); PG8_STAGE(PG8_SA(1, 0), cA + kstep, voffA); PG8_STAGE(PG8_SB(1, 1), cB + hstep + kstep, voffB);
        PG8_WAIT_V(6); PG8_BAR;
    } else {
        PG8_STAGE(PG8_SB(0, 0), cB, voffB); PG8_STAGE(PG8_SA(0, 0), cA, voffA); PG8_STAGE(PG8_SB(0, 1), cB + hstep, voffB); PG8_STAGE(PG8_SA(0, 1), cA + hstep, voffA);
        if (wr == 1) PG8_BAR;
        PG8_WAIT_V(4); PG8_BAR;
        PG8_STAGE(PG8_SB(1, 0), cB + kstep, voffB); PG8_STAGE(PG8_SA(1, 0), cA + kstep, voffA); PG8_STAGE(PG8_SB(1, 1), cB + hstep + kstep, voffB);
        PG8_WAIT_V(6); PG8_BAR;
    }
    for (;;) {
        const bool has_next = S.next(ui + 1, nxt);
        const char* nA = has_next ? (const char*)g.A + (size_t)nxt.pm * tstep + (size_t)nxt.kofs * 2 : cA; const char* nB = has_next ? (const char*)g.Bt + (size_t)nxt.pn * tstep + (size_t)nxt.kofs * 2 : cB;
        for (int t = 0; t < nt; t += 2) {
            const bool last = (t == nt - 2);
            const char* a1 = cA + (size_t)(t + 1) * kstep;
            const char* a2 = last ? nA : cA + (size_t)(t + 2) * kstep; const char* b2 = last ? nB : cB + (size_t)(t + 2) * kstep;
            const char* a3 = a2 + kstep; const char* b3 = b2 + kstep;
            if constexpr (FP8 != 0) { asm volatile("" : "+s"(a1), "+s"(a2), "+s"(b2), "+s"(a3), "+s"(b3)); }
            if (last && has_next) S.a_ready(nxt);
            if constexpr (SP2) {
            PG8_LDB(B0, 0, 0); PG8_LDB(B1, 0, 1); PG8_SCHED; PG8_LDA(At, 0, 0); PG8_STAGE(PG8_SA(1, 1), a1 + hstep, voffA);
            PG8_WAIT_V(8); PG8_WAIT_L(0); PG8_BAR; PG8_MMA(0, 0, At, B0); PG8_MMA(0, 1, At, B1); PG8_BAR; PG8_SCHED;
            PG8_LDA(At, 0, 1); PG8_STAGE(PG8_SB(0, 0), b2, voffB); PG8_STAGE(PG8_SB(0, 1), b2 + hstep, voffB); PG8_STAGE(PG8_SA(0, 0), a2, voffA);
            PG8_WAIT_V(8); PG8_WAIT_L(0); PG8_BAR; PG8_MMA(1, 0, At, B0); PG8_MMA(1, 1, At, B1); PG8_BAR; PG8_SCHED;
            PG8_LDB(B0, 1, 0); PG8_LDB(B1, 1, 1); PG8_SCHED; PG8_LDA(At, 1, 0); PG8_STAGE(PG8_SA(0, 1), a2 + hstep, voffA);
            PG8_WAIT_V(8); PG8_WAIT_L(0); PG8_BAR; PG8_MMA(0, 0, At, B0); PG8_MMA(0, 1, At, B1); PG8_BAR; PG8_SCHED;
            PG8_LDA(At, 1, 1); PG8_STAGE(PG8_SB(1, 0), b3, voffB); PG8_STAGE(PG8_SB(1, 1), b3 + hstep, voffB); PG8_STAGE(PG8_SA(1, 0), a3, voffA);
            PG8_WAIT_V(8); PG8_WAIT_L(0); PG8_BAR; PG8_MMA(1, 0, At, B0); PG8_MMA(1, 1, At, B1); PG8_BAR; PG8_SCHED;
            } else {
            PG8_LDB(B0, 0, 0); PG8_SCHED; PG8_LDA(At, 0, 0); PG8_STAGE(PG8_SA(1, 1), a1 + hstep, voffA);
            PG8_WAIT_L(8); PG8_BAR; PG8_WAIT_L(0); PG8_MMA(0, 0, At, B0); PG8_BAR; PG8_SCHED;
            PG8_LDB(B1, 0, 1); PG8_STAGE(PG8_SB(0, 0), b2, voffB);
            PG8_BAR; PG8_WAIT_L(0); PG8_MMA(0, 1, At, B1); PG8_BAR;
            PG8_LDA(At, 0, 1); PG8_STAGE(PG8_SA(0, 0), a2, voffA);
            PG8_BAR; PG8_WAIT_L(0); PG8_MMA(1, 0, At, B0); PG8_BAR; PG8_SCHED;
            PG8_STAGE(PG8_SB(0, 1), b2 + hstep, voffB);
            PG8_WAIT_V(6); PG8_BAR; PG8_MMA(1, 1, At, B1); PG8_BAR;
            PG8_LDB(B0, 1, 0); PG8_SCHED; PG8_LDA(At, 1, 0); PG8_STAGE(PG8_SA(0, 1), a2 + hstep, voffA);
            PG8_WAIT_L(8); PG8_BAR; PG8_WAIT_L(0); PG8_MMA(0, 0, At, B0); PG8_BAR; PG8_SCHED;
            PG8_LDB(B1, 1, 1); PG8_STAGE(PG8_SB(1, 0), b3, voffB);
            PG8_BAR; PG8_WAIT_L(0); PG8_MMA(0, 1, At, B1); PG8_BAR;
            PG8_LDA(At, 1, 1); PG8_STAGE(PG8_SA(1, 0), a3, voffA);
            PG8_BAR; PG8_WAIT_L(0); PG8_MMA(1, 0, At, B0); PG8_BAR; PG8_SCHED;
            PG8_STAGE(PG8_SB(1, 1), b3 + hstep, voffB);
            PG8_WAIT_V(6); PG8_BAR; PG8_MMA(1, 1, At, B1); PG8_BAR;
            }
        }
        if constexpr (ALIGN_EPI) { if (wr == 0) PG8_BAR; }
        if constexpr (!Epi::AFTER_DRAIN) { int fr_ = fr, fq_ = fq; if constexpr (FP8 != 0) asm volatile("" : "+v"(fr_), "+v"(fq_));
            E(acc, cur, wr, wc, fr_, fq_); S.done(cur); }
        if (!has_next) break;
#pragma unroll
        for (int a = 0; a < 2; ++a)
#pragma unroll
            for (int b = 0; b < 2; ++b)
#pragma unroll
                for (int m = 0; m < 4; ++m)
#pragma unroll
                    for (int n = 0; n < 2; ++n) acc[a][b][m][n] = (f32x4){0.f, 0.f, 0.f, 0.f};
        cur = nxt; cA = nA; cB = nB; ++ui;
        if constexpr (ALIGN_EPI) { if (wr == 1) PG8_BAR; }
    }
    PG8_WAIT_V(0);
    if constexpr (!ALIGN_EPI) { if (wr == 0) PG8_BAR; }
    PG8_BAR;
    if constexpr (Epi::AFTER_DRAIN) { E.fused(acc, cur, wr, wc, fr, fq, lds, wid, lane); S.done(cur); }
#undef PG8_SA
#undef PG8_SB
#undef PG8_STAGE
#undef PG8_LDA
#undef PG8_LDB
#undef PG8_MMA
#undef PG8_WAIT_V
#undef PG8_WAIT_L
#undef PG8_BAR
#undef PG8_SCHED
}
}

namespace att {
using bf16x8 = __attribute__((ext_vector_type(8))) short;
using s16x4  = __attribute__((ext_vector_type(4))) short;
using f32x16 = __attribute__((ext_vector_type(16))) float;
using f32x4  = __attribute__((ext_vector_type(4))) float;
using u32x4  = __attribute__((ext_vector_type(4))) unsigned;
using u32x2  = __attribute__((ext_vector_type(2))) unsigned;
typedef unsigned short bf16;
constexpr int   D = 128, NW = 8, QBLK = 32, KVBLK = 64;
constexpr float SCALE = 0.088388347648318440f;
constexpr float THR = 8.f;
constexpr float NEG = -1e30f;
constexpr int SHM_V = KVBLK * D * 2, SHM_K = KVBLK * D * 2;
constexpr int SHM_ATTN = 2 * SHM_V + 2 * SHM_K + NW * 64 * 4;
constexpr int ACS_OFF = SHM_ATTN;
#define KSWZ(row, colB) ((row) * 256 + ((colB) ^ (((row) & 7) << 4)))
#define SBAR() __builtin_amdgcn_sched_barrier(0)
__device__ __forceinline__ int crow(int r, int hi) { return (r & 3) + 8 * (r >> 2) + 4 * hi; }
__device__ __forceinline__ unsigned cvtpk(float lo, float hi) { unsigned r; asm volatile("v_cvt_pk_bf16_f32 %0, %1, %2" : "=v"(r) : "v"(lo), "v"(hi)); return r; }
__device__ __forceinline__ float bf2f(unsigned short b) { return __uint_as_float(((unsigned)b) << 16); }
__device__ __forceinline__ bf16x8 ld8(const bf16* p) { return *reinterpret_cast<const bf16x8*>(p); }

__device__ __forceinline__ int moba_lim(int idx, int qrow, unsigned rowmask, int hi) {
  const int vis = ((rowmask >> (((idx - 4) >> 2) & 31)) & 1u) ? 64 : -1;
  return ((idx < 4) ? (qrow - 64 * idx) : vis) - 4 * hi;
}
__device__ __forceinline__ void partialSM(f32x16& p0, f32x16& p1, float& m_reg, float& mn, float& alpha) {
  constexpr float C = SCALE * 1.4426950408889634f;
  float pmax = p0[0];
#pragma unroll
  for (int r = 1; r < 16; ++r) pmax = fmaxf(pmax, p0[r]);
#pragma unroll
  for (int r = 0; r < 16; ++r) pmax = fmaxf(pmax, p1[r]);
  { auto rr = __builtin_amdgcn_permlane32_swap(__float_as_uint(pmax), __float_as_uint(pmax), false, false);
    pmax = fmaxf(__uint_as_float(rr[0]), __uint_as_float(rr[1])); }
  if (__builtin_expect(__all(pmax - m_reg <= THR / SCALE), 1)) { mn = m_reg; alpha = 1.f; }
  else { mn = fmaxf(m_reg, pmax); alpha = __builtin_amdgcn_exp2f((m_reg - mn) * C); m_reg = mn; }
  const float mnC = -mn * C;
#pragma unroll
  for (int r = 0; r < 16; ++r) p0[r] = fmaf(p0[r], C, mnC);
#pragma unroll
  for (int r = 0; r < 16; ++r) p1[r] = fmaf(p1[r], C, mnC);
#pragma unroll
  for (int r = 0; r < 16; ++r) p0[r] = __builtin_amdgcn_exp2f(p0[r]);
}
#define ATT_PK4(P, BASE, OUT) do { unsigned a0 = cvtpk(P[BASE + 0], P[BASE + 1]), a1 = cvtpk(P[BASE + 2], P[BASE + 3]);   \
    unsigned b0 = cvtpk(P[BASE + 4], P[BASE + 5]), b1 = cvtpk(P[BASE + 6], P[BASE + 7]);                              \
    auto r0 = __builtin_amdgcn_permlane32_swap(a0, b0, false, false); auto r1 = __builtin_amdgcn_permlane32_swap(a1, b1, false, false); \
    u32x4 w = {r0[0], r1[0], r0[1], r1[1]}; OUT = *reinterpret_cast<bf16x8*>(&w); } while (0)
__device__ __forceinline__ void finishSM(f32x16& p0, f32x16& p1, float alpha, float& l_reg, bf16x8& pa0, bf16x8& pa1, bf16x8& pa2, bf16x8& pa3) {
#pragma unroll
  for (int r = 0; r < 16; ++r) p1[r] = __builtin_amdgcn_exp2f(p1[r]);
  float ps = 0;
#pragma unroll
  for (int r = 0; r < 16; ++r) ps += p0[r];
#pragma unroll
  for (int r = 0; r < 16; ++r) ps += p1[r];
  { auto rr = __builtin_amdgcn_permlane32_swap(__float_as_uint(ps), __float_as_uint(ps), false, false);
    ps = __uint_as_float(rr[0]) + __uint_as_float(rr[1]); }
  l_reg = l_reg * alpha + ps;
  ATT_PK4(p0, 0, pa0); ATT_PK4(p0, 8, pa1); ATT_PK4(p1, 0, pa2); ATT_PK4(p1, 8, pa3);
}
template <bool MASKED>
__device__ __forceinline__ void qkt(f32x16& p0, f32x16& p1, const char* Ks, const bf16x8* qr, int r32, int hi, int lim = 0) {
  if (MASKED) {
#pragma unroll
    for (int r = 0; r < 16; ++r) { const int cr = (r & 3) + 8 * (r >> 2); p0[r] = (cr > lim) ? NEG : 0.f; p1[r] = (cr + 32 > lim) ? NEG : 0.f; }
  } else { p0 = f32x16{}; p1 = f32x16{}; }
#pragma unroll
  for (int d0 = 0; d0 < 8; ++d0) { const int cb = (d0 * 16 + hi * 8) * 2;
    bf16x8 b0 = *reinterpret_cast<const bf16x8*>(Ks + KSWZ(r32, cb));
    bf16x8 b1 = *reinterpret_cast<const bf16x8*>(Ks + KSWZ(32 + r32, cb));
    p0 = __builtin_amdgcn_mfma_f32_32x32x16_bf16(b0, qr[d0], p0, 0, 0, 0);
    p1 = __builtin_amdgcn_mfma_f32_32x32x16_bf16(b1, qr[d0], p1, 0, 0, 0); }
}
__device__ __forceinline__ int v_st(int k, int c) { const int kk = (k & ~0xC) | ((k & 4) << 1) | ((k & 8) >> 1); return ((kk >> 3) * 4 + (c >> 5)) * 512 + ((kk & 7) * 32 + (c & 31)) * 2; }
__device__ __forceinline__ int v_rd_base(int lane) { return ((lane & 3) << 3) | (((lane >> 2) & 3) << 6) | (((lane >> 4) & 1) << 5) | (((lane >> 5) & 1) << 8); }
constexpr int v_rd_off(int d0, int ks, int half) { return d0 * 512 + ks * 4096 + half * 2048; }
template <int OFF> __device__ __forceinline__ s16x4 tr_read(int vb) {
  s16x4 r; asm volatile("ds_read_b64_tr_b16 %0, %1 offset:%2" : "=&v"(r) : "v"(vb), "i"(OFF) : "memory"); return r;
}
#define ATT_PK(L, H) (bf16x8){L[0], L[1], L[2], L[3], H[0], H[1], H[2], H[3]}
template <int D0> __device__ __forceinline__ void pv_one(f32x16& od, int vb, bf16x8 pa0, bf16x8 pa1, bf16x8 pa2, bf16x8 pa3) {
  const s16x4 l0 = tr_read<v_rd_off(D0, 0, 0)>(vb), h0 = tr_read<v_rd_off(D0, 0, 1)>(vb), l1 = tr_read<v_rd_off(D0, 1, 0)>(vb), h1 = tr_read<v_rd_off(D0, 1, 1)>(vb);
  const s16x4 l2 = tr_read<v_rd_off(D0, 2, 0)>(vb), h2 = tr_read<v_rd_off(D0, 2, 1)>(vb), l3 = tr_read<v_rd_off(D0, 3, 0)>(vb), h3 = tr_read<v_rd_off(D0, 3, 1)>(vb);
  asm volatile("s_waitcnt lgkmcnt(0)" ::: "memory"); SBAR();
  od = __builtin_amdgcn_mfma_f32_32x32x16_bf16(pa0, ATT_PK(l0, h0), od, 0, 0, 0);
  od = __builtin_amdgcn_mfma_f32_32x32x16_bf16(pa1, ATT_PK(l1, h1), od, 0, 0, 0);
  od = __builtin_amdgcn_mfma_f32_32x32x16_bf16(pa2, ATT_PK(l2, h2), od, 0, 0, 0);
  od = __builtin_amdgcn_mfma_f32_32x32x16_bf16(pa3, ATT_PK(l3, h3), od, 0, 0, 0);
}
__device__ __forceinline__ void pv_d0(f32x16* o, int vb, bf16x8 pa0, bf16x8 pa1, bf16x8 pa2, bf16x8 pa3) {
  pv_one<0>(o[0], vb, pa0, pa1, pa2, pa3); pv_one<1>(o[1], vb, pa0, pa1, pa2, pa3); pv_one<2>(o[2], vb, pa0, pa1, pa2, pa3); pv_one<3>(o[3], vb, pa0, pa1, pa2, pa3);
}
template <int KS> __device__ __forceinline__ void pv_ks(f32x16* o, int vb, bf16x8 pa) {
  const s16x4 l0 = tr_read<v_rd_off(0, KS, 0)>(vb), h0 = tr_read<v_rd_off(0, KS, 1)>(vb), l1 = tr_read<v_rd_off(1, KS, 0)>(vb), h1 = tr_read<v_rd_off(1, KS, 1)>(vb);
  const s16x4 l2 = tr_read<v_rd_off(2, KS, 0)>(vb), h2 = tr_read<v_rd_off(2, KS, 1)>(vb), l3 = tr_read<v_rd_off(3, KS, 0)>(vb), h3 = tr_read<v_rd_off(3, KS, 1)>(vb);
  asm volatile("s_waitcnt lgkmcnt(0)" ::: "memory"); SBAR();
  o[0] = __builtin_amdgcn_mfma_f32_32x32x16_bf16(pa, ATT_PK(l0, h0), o[0], 0, 0, 0);
  o[1] = __builtin_amdgcn_mfma_f32_32x32x16_bf16(pa, ATT_PK(l1, h1), o[1], 0, 0, 0);
  o[2] = __builtin_amdgcn_mfma_f32_32x32x16_bf16(pa, ATT_PK(l2, h2), o[2], 0, 0, 0);
  o[3] = __builtin_amdgcn_mfma_f32_32x32x16_bf16(pa, ATT_PK(l3, h3), o[3], 0, 0, 0);
}
__device__ __forceinline__ void pv_il(f32x16* o, int vb, bf16x8 pa0, bf16x8 pa1, bf16x8 pa2, bf16x8 pa3) {
  pv_ks<0>(o, vb, pa0); pv_ks<1>(o, vb, pa1); pv_ks<2>(o, vb, pa2); pv_ks<3>(o, vb, pa3);
}

template <bool MOBA, int ldq, int ldk, int ldo>
__device__ __forceinline__ void attn_unit(const bf16* __restrict__ Qb, const bf16* __restrict__ Kh, const bf16* __restrict__ Vh, bf16* __restrict__ Ob,
                                          int NT, int b, const float* __restrict__ kmean, char* lds) {
  const int tid = fresh_tid(), wid = tid >> 6, lane = tid & 63, r32 = lane & 31, hi = lane >> 5;
  char* V_lds = lds; char* K_lds = lds + 2 * SHM_V;
  float* ws = (float*)(lds + 2 * SHM_V + 2 * SHM_K) + wid * 64; float* li_l = ws; float* al_l = ws + 32;
  float m_reg = NEG, l_reg = 0; f32x16 o[4] = {}; bf16x8 qr[8];
  const bf16* Qw = Qb + (long)(wid * QBLK + r32) * ldq + hi * 8;
#pragma unroll
  for (int d0 = 0; d0 < 8; ++d0) qr[d0] = ld8(Qw + d0 * 16);
  const int sr = tid >> 4, sc = (tid & 15) * 8, vst0 = v_st(sr, sc), vst1 = v_st(32 + sr, sc);
  const int vb0 = (int)(uintptr_t)V_lds + v_rd_base(lane);
  const int qrow = wid * QBLK + r32;
  unsigned rowmask = 0u;
  if (MOBA) {
    { const float* km = kmean + sr * 128 + sc; const f32x4 a = *(const f32x4*)km, c4 = *(const f32x4*)(km + 4);
      u32x4 w = {cvtpk(a[0], a[1]), cvtpk(a[2], a[3]), cvtpk(c4[0], c4[1]), cvtpk(c4[2], c4[3])};
      *(u32x4*)(K_lds + KSWZ(sr, sc * 2)) = w; }
    __syncthreads();
    f32x16 g = f32x16{};
#pragma unroll
    for (int d0 = 0; d0 < 8; ++d0) { const int cb = (d0 * 16 + hi * 8) * 2;
      bf16x8 b0 = *reinterpret_cast<const bf16x8*>(K_lds + KSWZ(r32, cb));
      g = __builtin_amdgcn_mfma_f32_32x32x16_bf16(b0, qr[d0], g, 0, 0, 0); }
#pragma unroll
    for (int r = 0; r < 16; ++r) g[r] = (crow(r, hi) < b) ? g[r] : -__builtin_inff();
#pragma unroll
    for (int k = 0; k < 3; ++k) {
      float best = -__builtin_inff(); int bi = 99;
#pragma unroll
      for (int r = 0; r < 16; ++r) { const int n = crow(r, hi); const bool t = (g[r] > best) || (g[r] == best && n < bi); best = t ? g[r] : best; bi = t ? n : bi; }
      const float pv = __shfl_xor(best, 32); const int pi = __shfl_xor(bi, 32);
      const bool pt = (pv > best) || (pv == best && pi < bi);
      const int wi = pt ? pi : bi;
      if (k < b) rowmask |= 1u << (wi & 31);
#pragma unroll
      for (int r = 0; r < 16; ++r) g[r] = (crow(r, hi) == wi) ? -__builtin_inff() : g[r];
    }
    __syncthreads();
  }
  const bf16* Kp = Kh + (long)sr * ldk + sc; const bf16* Vp = Vh + (long)sr * ldk + sc;
#define TK0(idx) (MOBA ? ((idx) < 4 ? 256 * b + 64 * (idx) : 64 * ((idx) - 4)) : 64 * (idx))
#define RESC(a) do { if (__any((a) < 1.f)) { if (hi == 0) al_l[r32] = (a); asm volatile("s_waitcnt lgkmcnt(0)" ::: "memory"); \
    _Pragma("unroll") for (int d = 0; d < 4; ++d) _Pragma("unroll") for (int r = 0; r < 16; ++r) o[d][r] *= al_l[crow(r, hi)]; } } while (0)
  if constexpr (MOBA) {
    bf16x8 vs0, vs1, ks0, ks1;
#define SLOAD1(idx) do { const long ko_ = (long)(TK0(idx)) * ldk; vs0 = ld8(Vp + ko_); vs1 = ld8(Vp + ko_ + 32 * ldk); ks0 = ld8(Kp + ko_); ks1 = ld8(Kp + ko_ + 32 * ldk); } while (0)
    SLOAD1(0);
#pragma nounroll
    for (int idx = 0; idx < NT; ++idx) {
      __syncthreads();
      *(bf16x8*)(V_lds + vst0) = vs0; *(bf16x8*)(V_lds + vst1) = vs1; { const int kc = sc * 2; *(bf16x8*)(K_lds + KSWZ(sr, kc)) = ks0; *(bf16x8*)(K_lds + KSWZ(32 + sr, kc)) = ks1; }
      if (idx + 1 < NT) SLOAD1(idx + 1);
      __syncthreads();
      f32x16 p0, p1; float mn, al; bf16x8 pa0, pa1, pa2, pa3;
      qkt<true>(p0, p1, K_lds, qr, r32, hi, moba_lim(idx, qrow, rowmask, hi));
      partialSM(p0, p1, m_reg, mn, al);
      RESC(al);
      finishSM(p0, p1, al, l_reg, pa0, pa1, pa2, pa3); SBAR();
      pv_d0(o, vb0, pa0, pa1, pa2, pa3);
    }
#undef SLOAD1
  } else {
  constexpr int SDEPTH = MOBA ? 1 : 2;
  struct { bf16x8 vs0, vs1, ks0, ks1; } sr_[SDEPTH];
#define SLOAD(i, idx) do { const long ko_ = (long)(TK0(idx)) * ldk; sr_[i].vs0 = ld8(Vp + ko_); sr_[i].vs1 = ld8(Vp + ko_ + 32 * ldk); \
    sr_[i].ks0 = ld8(Kp + ko_); sr_[i].ks1 = ld8(Kp + ko_ + 32 * ldk); } while (0)
#define SWRITE(bb, i) do { *(bf16x8*)(V_lds + (bb) * SHM_V + vst0) = sr_[i].vs0;          \
    *(bf16x8*)(V_lds + (bb) * SHM_V + vst1) = sr_[i].vs1; const int kc = sc * 2;               \
    *(bf16x8*)(K_lds + (bb) * SHM_K + KSWZ(sr, kc)) = sr_[i].ks0;                       \
    *(bf16x8*)(K_lds + (bb) * SHM_K + KSWZ(32 + sr, kc)) = sr_[i].ks1; } while (0)
#define SWAIT() do { if constexpr (SDEPTH == 2) asm volatile("s_waitcnt vmcnt(4)" ::: "memory"); else asm volatile("s_waitcnt vmcnt(0)" ::: "memory"); } while (0)
#define QKT(P0, P1, KS, idx) qkt<MOBA>(P0, P1, KS, qr, r32, hi, MOBA ? moba_lim((idx), qrow, rowmask, hi) : 0)
  f32x16 pA0, pA1, pB0, pB1; float mnA, mnB, alA, alB; bf16x8 pa0, pa1, pa2, pa3;
  constexpr int SE = 0, SO = SDEPTH - 1;
  SLOAD(SE, 0); asm volatile("s_waitcnt vmcnt(0)" ::: "memory"); SWRITE(0, SE); __syncthreads();
  QKT(pA0, pA1, K_lds, 0); partialSM(pA0, pA1, m_reg, mnA, alA);
  SLOAD(SO, 1); if constexpr (SDEPTH == 2) { if (2 < NT) SLOAD(SE, 2); }
  SWAIT(); SWRITE(1, SO); __syncthreads();
  for (int j = 1; j + 1 < NT; j += 2) {
    SBAR(); QKT(pB0, pB1, K_lds + SHM_K, j);
    finishSM(pA0, pA1, alA, l_reg, pa0, pa1, pa2, pa3); SBAR();
    SLOAD(SO, j + SDEPTH); SBAR();
    pv_d0(o, vb0, pa0, pa1, pa2, pa3); partialSM(pB0, pB1, m_reg, mnB, alB);
    __syncthreads(); SWAIT(); SWRITE(0, SE);
    RESC(alB); __syncthreads();
    SBAR(); QKT(pA0, pA1, K_lds, j + 1);
    finishSM(pB0, pB1, alB, l_reg, pa0, pa1, pa2, pa3); SBAR();
    if (SDEPTH == 1 || j + 3 < NT) SLOAD(SE, j + 1 + SDEPTH); SBAR();
    pv_d0(o, vb0 + SHM_V, pa0, pa1, pa2, pa3); partialSM(pA0, pA1, m_reg, mnA, alA);
    __syncthreads(); SWAIT(); SWRITE(1, SO);
    RESC(alA); __syncthreads();
  }
  SBAR(); QKT(pB0, pB1, K_lds + SHM_K, NT - 1);
  finishSM(pA0, pA1, alA, l_reg, pa0, pa1, pa2, pa3); SBAR();
  pv_d0(o, vb0, pa0, pa1, pa2, pa3); partialSM(pB0, pB1, m_reg, mnB, alB);
  __syncthreads(); RESC(alB);
  finishSM(pB0, pB1, alB, l_reg, pa0, pa1, pa2, pa3); SBAR();
  pv_d0(o, vb0 + SHM_V, pa0, pa1, pa2, pa3);
  }
  if (hi == 0) li_l[r32] = l_reg; asm volatile("s_waitcnt lgkmcnt(0)" ::: "memory");
  float rli[16];
#pragma unroll
  for (int r = 0; r < 16; ++r) rli[r] = __builtin_amdgcn_rcpf(li_l[crow(r, hi)]);
  bf16* Ow = Ob + (long)(wid * QBLK) * ldo;
#pragma unroll
  for (int r = 0; r < 16; ++r) { const int orow = crow(r, hi);
#pragma unroll
    for (int d0 = 0; d0 < 4; ++d0) Ow[(long)orow * ldo + d0 * 32 + r32] = (bf16)(cvtpk(o[d0][r] * rli[r], 0.f) & 0xffffu); }
  __syncthreads();
#undef TK0
#undef SLOAD
#undef SWRITE
#undef SWAIT
#undef RESC
#undef QKT
}

__device__ __forceinline__ void moba_gate_unit(const bf16* __restrict__ Qb, const float* __restrict__ kmean, int b, int h, unsigned* __restrict__ ROWMASK, unsigned char* __restrict__ SEG, int* __restrict__ CNT, char* lds) {
  const int tid = fresh_tid(), wid = tid >> 6, lane = tid & 63, r32 = lane & 31, hi = lane >> 5;
  char* K_lds = lds + 2 * SHM_V; int* cw = (int*)(lds + ACS_OFF);
  constexpr int ldq = 5120;
  bf16x8 qr[8];
  const bf16* Qw = Qb + (long)(wid * QBLK + r32) * ldq + hi * 8;
#pragma unroll
  for (int d0 = 0; d0 < 8; ++d0) qr[d0] = ld8(Qw + d0 * 16);
  const int sr = tid >> 4, sc = (tid & 15) * 8;
  unsigned rowmask = 0u;
  { const float* km = kmean + (size_t)sr * 256 + sc;
    const f32x4 a = (*(const f32x4*)km + *(const f32x4*)(km + 128)) * (1.0f / 256.0f), c4 = (*(const f32x4*)(km + 4) + *(const f32x4*)(km + 132)) * (1.0f / 256.0f);
    u32x4 w = {cvtpk(a[0], a[1]), cvtpk(a[2], a[3]), cvtpk(c4[0], c4[1]), cvtpk(c4[2], c4[3])};
    *(u32x4*)(K_lds + KSWZ(sr, sc * 2)) = w; }
  __syncthreads();
  f32x16 g = f32x16{};
#pragma unroll
  for (int d0 = 0; d0 < 8; ++d0) { const int cb = (d0 * 16 + hi * 8) * 2;
    bf16x8 b0 = *reinterpret_cast<const bf16x8*>(K_lds + KSWZ(r32, cb));
    g = __builtin_amdgcn_mfma_f32_32x32x16_bf16(b0, qr[d0], g, 0, 0, 0); }
#pragma unroll
  for (int r = 0; r < 16; ++r) g[r] = (crow(r, hi) < b) ? g[r] : -__builtin_inff();
#pragma unroll
  for (int k = 0; k < 3; ++k) {
    float best = -__builtin_inff(); int bi = 99;
#pragma unroll
    for (int r = 0; r < 16; ++r) { const int n = crow(r, hi); const bool t = (g[r] > best) || (g[r] == best && n < bi); best = t ? g[r] : best; bi = t ? n : bi; }
    const float pv = __shfl_xor(best, 32); const int pi = __shfl_xor(bi, 32);
    const bool pt = (pv > best) || (pv == best && pi < bi);
    const int wi = pt ? pi : bi;
    if (k < b) rowmask |= 1u << (wi & 31);
#pragma unroll
    for (int r = 0; r < 16; ++r) g[r] = (crow(r, hi) == wi) ? -__builtin_inff() : g[r];
  }
  if (hi == 0) ROWMASK[(size_t)(256 * b + wid * QBLK + r32) * 12 + h] = rowmask;
  int mycnt = 0;
  for (int j = 0; j < b; ++j) { const unsigned long long bal = __ballot(((rowmask >> j) & 1u) && hi == 0); const int c = __popcll(bal); if (lane == j) mycnt = c; }
  if (lane < 32) cw[wid * 32 + lane] = mycnt;
  __syncthreads();
  int off = 0, tot = 0;
  if (lane < 32) {
#pragma unroll
    for (int w = 0; w < 8; ++w) { const int c = cw[w * 32 + lane]; off += (w < wid) ? c : 0; tot += c; } }
  if (wid == 0 && lane < b) CNT[(h * 32 + lane) * 32 + b] = tot;
  for (int j = 0; j < b; ++j) { const bool bit = ((rowmask >> j) & 1u) && hi == 0; const unsigned long long bal = __ballot(bit); const int base = __shfl(off, j);
    if (bit) { const int rank = __popcll(bal & ((1ull << lane) - 1ull)); SEG[((size_t)(h * 32 + j) * 32 + b) * 256 + base + rank] = (unsigned char)(wid * QBLK + r32); } }
  __syncthreads();
}
template <bool OWN>
__device__ __forceinline__ void attn_part_unit(const bf16* __restrict__ Qw, const bf16* __restrict__ Kh, const bf16* __restrict__ Vh, int dst, bf16* __restrict__ PARTO, float* __restrict__ PARTML, char* lds) {
  constexpr int ldk = 5120, NT = 4;
  const int tid = fresh_tid(), wid = tid >> 6, lane = tid & 63, r32 = lane & 31, hi = lane >> 5;
  char* V_lds = lds; char* K_lds = lds + 2 * SHM_V;
  float* ws = (float*)(lds + 2 * SHM_V + 2 * SHM_K) + wid * 64; float* li_l = ws; float* al_l = ws + 32; int* dst_l = (int*)(lds + ACS_OFF) + wid * 32;
  float m_reg = NEG, l_reg = 0; f32x16 o[4] = {}; bf16x8 qr[8];
#pragma unroll
  for (int d0 = 0; d0 < 8; ++d0) qr[d0] = ld8(Qw + d0 * 16);
  const int sr = tid >> 4, sc = (tid & 15) * 8, vst0 = v_st(sr, sc), vst1 = v_st(32 + sr, sc);
  const int vb0 = (int)(uintptr_t)V_lds + v_rd_base(lane);
  const int qrow = wid * QBLK + r32;
  const bf16* Kp = Kh + (long)sr * ldk + sc; const bf16* Vp = Vh + (long)sr * ldk + sc;
#define RESC(a) do { if (__any((a) < 1.f)) { if (hi == 0) al_l[r32] = (a); asm volatile("s_waitcnt lgkmcnt(0)" ::: "memory"); \
    _Pragma("unroll") for (int d = 0; d < 4; ++d) _Pragma("unroll") for (int r = 0; r < 16; ++r) o[d][r] *= al_l[crow(r, hi)]; } } while (0)
  if constexpr (OWN) {
    bf16x8 vs0, vs1, ks0, ks1;
#define SLOAD1(idx) do { const long ko_ = (long)(64 * (idx)) * ldk; vs0 = ld8(Vp + ko_); vs1 = ld8(Vp + ko_ + 32 * ldk); ks0 = ld8(Kp + ko_); ks1 = ld8(Kp + ko_ + 32 * ldk); } while (0)
    SLOAD1(0);
#pragma nounroll
    for (int idx = 0; idx < NT; ++idx) {
      __syncthreads();
      *(bf16x8*)(V_lds + vst0) = vs0; *(bf16x8*)(V_lds + vst1) = vs1; { const int kc = sc * 2; *(bf16x8*)(K_lds + KSWZ(sr, kc)) = ks0; *(bf16x8*)(K_lds + KSWZ(32 + sr, kc)) = ks1; }
      if (idx + 1 < NT) SLOAD1(idx + 1);
      __syncthreads();
      f32x16 p0, p1; float mn, al; bf16x8 pa0, pa1, pa2, pa3;
      qkt<true>(p0, p1, K_lds, qr, r32, hi, qrow - 64 * idx - 4 * hi);
      partialSM(p0, p1, m_reg, mn, al);
      RESC(al);
      finishSM(p0, p1, al, l_reg, pa0, pa1, pa2, pa3); SBAR();
      pv_d0(o, vb0, pa0, pa1, pa2, pa3);
    }
#undef SLOAD1
  } else {
    struct { bf16x8 vs0, vs1, ks0, ks1; } sr_[2];
#define SLOAD(i, idx) do { const long ko_ = (long)(64 * (idx)) * ldk; sr_[i].vs0 = ld8(Vp + ko_); sr_[i].vs1 = ld8(Vp + ko_ + 32 * ldk); \
    sr_[i].ks0 = ld8(Kp + ko_); sr_[i].ks1 = ld8(Kp + ko_ + 32 * ldk); } while (0)
#define SWRITE(bb, i) do { *(bf16x8*)(V_lds + (bb) * SHM_V + vst0) = sr_[i].vs0;          \
    *(bf16x8*)(V_lds + (bb) * SHM_V + vst1) = sr_[i].vs1; const int kc = sc * 2;               \
    *(bf16x8*)(K_lds + (bb) * SHM_K + KSWZ(sr, kc)) = sr_[i].ks0;                       \
    *(bf16x8*)(K_lds + (bb) * SHM_K + KSWZ(32 + sr, kc)) = sr_[i].ks1; } while (0)
#define SWAIT() asm volatile("s_waitcnt vmcnt(4)" ::: "memory")
    f32x16 pA0, pA1, pB0, pB1; float mnA, mnB, alA, alB; bf16x8 pa0, pa1, pa2, pa3;
    SLOAD(0, 0); asm volatile("s_waitcnt vmcnt(0)" ::: "memory"); SWRITE(0, 0); __syncthreads();
    qkt<false>(pA0, pA1, K_lds, qr, r32, hi); partialSM(pA0, pA1, m_reg, mnA, alA);
    SLOAD(1, 1); SLOAD(0, 2);
    SWAIT(); SWRITE(1, 1); __syncthreads();
    SBAR(); qkt<false>(pB0, pB1, K_lds + SHM_K, qr, r32, hi);
    finishSM(pA0, pA1, alA, l_reg, pa0, pa1, pa2, pa3); SBAR();
    SLOAD(1, 3); SBAR();
    pv_d0(o, vb0, pa0, pa1, pa2, pa3); partialSM(pB0, pB1, m_reg, mnB, alB);
    __syncthreads(); SWAIT(); SWRITE(0, 0);
    RESC(alB); __syncthreads();
    SBAR(); qkt<false>(pA0, pA1, K_lds, qr, r32, hi);
    finishSM(pB0, pB1, alB, l_reg, pa0, pa1, pa2, pa3); SBAR();
    pv_d0(o, vb0 + SHM_V, pa0, pa1, pa2, pa3); partialSM(pA0, pA1, m_reg, mnA, alA);
    __syncthreads(); asm volatile("s_waitcnt vmcnt(0)" ::: "memory"); SWRITE(1, 1);
    RESC(alA); __syncthreads();
    SBAR(); qkt<false>(pB0, pB1, K_lds + SHM_K, qr, r32, hi);
    finishSM(pA0, pA1, alA, l_reg, pa0, pa1, pa2, pa3); SBAR();
    pv_d0(o, vb0, pa0, pa1, pa2, pa3); partialSM(pB0, pB1, m_reg, mnB, alB);
    __syncthreads(); RESC(alB);
    finishSM(pB0, pB1, alB, l_reg, pa0, pa1, pa2, pa3); SBAR();
    pv_d0(o, vb0 + SHM_V, pa0, pa1, pa2, pa3);
#undef SLOAD
#undef SWRITE
#undef SWAIT
  }
#undef RESC
  if (hi == 0) { li_l[r32] = l_reg; dst_l[r32] = dst; if (dst >= 0) { PARTML[2 * (size_t)dst] = m_reg; PARTML[2 * (size_t)dst + 1] = l_reg; } }
  asm volatile("s_waitcnt lgkmcnt(0)" ::: "memory");
#pragma unroll
  for (int r = 0; r < 16; ++r) { const int row = crow(r, hi); const int d = dst_l[row]; const float rl = __builtin_amdgcn_rcpf(li_l[row]);
    if (d >= 0) { bf16* op = PARTO + (size_t)d * 128 + r32;
#pragma unroll
      for (int d0 = 0; d0 < 4; ++d0) op[d0 * 32] = (bf16)(cvtpk(o[d0][r] * rl, 0.f) & 0xffffu); } }
  __syncthreads();
}

__device__ __forceinline__ void moba_kv_item(const bf16* __restrict__ QKVM, int h, int j, int row0, int rowend, const int* segp, const unsigned* __restrict__ ROWMASK, const unsigned char* __restrict__ SEG,
                                             bf16* __restrict__ PARTO, float* __restrict__ PARTML, char* lds, char* scr) {
  constexpr int ld = 5120;
  const int tid = fresh_tid(), wid = tid >> 6, lane = tid & 63, r32 = lane & 31, hi = lane >> 5;
  char* V_lds = lds; char* K_lds = lds + 4 * SHM_V;
  float* ws = (float*)scr + wid * 64; float* li_l = ws; float* al_l = ws + 32; int* dst_l = (int*)(scr + 2048) + wid * 32;
  {
    const int sr = tid >> 4, sc = (tid & 15) * 8, vst0 = v_st(sr, sc), vst1 = v_st(32 + sr, sc);
    const bf16* Kp = QKVM + (size_t)(256 * j + sr) * ld + 1536 + h * 128 + sc; const bf16* Vp = Kp + 1536;
    bf16x8 kv[16];
#pragma unroll
    for (int i = 0; i < 4; ++i) { kv[4 * i] = ld8(Kp + (size_t)(64 * i) * ld); kv[4 * i + 1] = ld8(Kp + (size_t)(64 * i + 32) * ld); kv[4 * i + 2] = ld8(Vp + (size_t)(64 * i) * ld); kv[4 * i + 3] = ld8(Vp + (size_t)(64 * i + 32) * ld); }
#pragma unroll
    for (int i = 0; i < 4; ++i) { const int kc = sc * 2;
      *(bf16x8*)(K_lds + i * SHM_K + KSWZ(sr, kc)) = kv[4 * i]; *(bf16x8*)(K_lds + i * SHM_K + KSWZ(32 + sr, kc)) = kv[4 * i + 1];
      *(bf16x8*)(V_lds + i * SHM_V + vst0) = kv[4 * i + 2]; *(bf16x8*)(V_lds + i * SHM_V + vst1) = kv[4 * i + 3]; } }
  __syncthreads();
  const int vb0 = (int)(uintptr_t)V_lds + v_rd_base(lane);
  const int nwu = (rowend - row0 + 31) >> 5;
#pragma nounroll
  for (int wu = wid; wu < nwu; wu += NW) {
    const int r = row0 + wu * 32 + r32; const bool own = r < 256; const bool valid = r < rowend;
    int t, dst;
    if (own) { t = 256 * j + r; dst = (t * 12 + h) * 4 + 3; }
    else { const int rg = valid ? r - 256 : 0; int b = j + 1; while (b < 31 && rg >= segp[b + 1]) ++b;
      t = 256 * b + SEG[((size_t)(h * 32 + j) * 32 + b) * 256 + (rg - segp[b])];
      const unsigned rm = ROWMASK[(size_t)t * 12 + h]; dst = valid ? (t * 12 + h) * 4 + __popc(rm & ((1u << j) - 1u)) : -1; }
    bf16x8 qr[8];
    { const bf16* Qw = QKVM + (size_t)t * ld + h * 128 + hi * 8;
#pragma unroll
      for (int d0 = 0; d0 < 8; ++d0) qr[d0] = ld8(Qw + d0 * 16); }
    float m_reg = NEG, l_reg = 0; f32x16 o[4] = {};
    const int limbase = own ? (r - 4 * hi) : 4096;
    const int ntl = own ? ((row0 + wu * 32 + 31) >> 6) + 1 : 4;
#pragma nounroll
    for (int idx = 0; idx < ntl; ++idx) {
      f32x16 p0, p1; float mn, al; bf16x8 pa0, pa1, pa2, pa3;
      qkt<true>(p0, p1, K_lds + idx * SHM_K, qr, r32, hi, limbase - 64 * idx);
      partialSM(p0, p1, m_reg, mn, al);
      if (__any(al < 1.f)) { if (hi == 0) al_l[r32] = al; asm volatile("s_waitcnt lgkmcnt(0)" ::: "memory");
#pragma unroll
        for (int d = 0; d < 4; ++d)
#pragma unroll
          for (int rr = 0; rr < 16; ++rr) o[d][rr] *= al_l[crow(rr, hi)]; }
      finishSM(p0, p1, al, l_reg, pa0, pa1, pa2, pa3); SBAR();
      pv_il(o, vb0 + idx * SHM_V, pa0, pa1, pa2, pa3);
    }
    if (hi == 0) { li_l[r32] = l_reg; dst_l[r32] = dst; if (dst >= 0) { PARTML[2 * (size_t)dst] = m_reg; PARTML[2 * (size_t)dst + 1] = l_reg; } }
    asm volatile("s_waitcnt lgkmcnt(0)" ::: "memory");
#pragma unroll
    for (int rr = 0; rr < 16; ++rr) { const int row = crow(rr, hi); const int d = dst_l[row]; const float rl = __builtin_amdgcn_rcpf(li_l[row]);
      if (d >= 0) { bf16* op = PARTO + (size_t)d * 128 + r32;
#pragma unroll
        for (int d0 = 0; d0 < 4; ++d0) op[d0 * 32] = (bf16)(cvtpk(o[d0][rr] * rl, 0.f) & 0xffffu); } }
    asm volatile("s_waitcnt lgkmcnt(0)" ::: "memory");
  }
  __syncthreads();
}
constexpr int CVP = 4096, CV_B = 1536, CV_C = 2048, CV_XDT = 2560;
constexpr float LOG2E = 1.4426950408889634f;
__device__ __forceinline__ void ssd_state_unit(const bf16* __restrict__ CV, const float* __restrict__ ACS, float* __restrict__ STATES, int c, int h, char* lds) {
  const int tid = fresh_tid(), wid = tid >> 6, lane = tid & 63, r32 = lane & 31, hi = lane >> 5;
  const int g = h / 6; const long t0 = 256L * c;
  char* X_lds = lds; char* B_lds = lds + SHM_V; float* acs_lds = (float*)(lds + ACS_OFF);
  if (tid < 256) acs_lds[tid] = ACS[(c * 24 + h) * 256 + tid];
  const int sr = tid >> 4, sc = (tid & 15) * 8, vst0 = v_st(sr, sc), vst1 = v_st(32 + sr, sc);
  const int pb = wid & 1, nb = wid >> 1;
  const int xb = (int)(uintptr_t)X_lds + v_rd_base(lane) + pb * 512, bb = (int)(uintptr_t)B_lds + v_rd_base(lane) + nb * 512;
  bf16x8 xv0 = {}, xv1 = {}, kb0, kb1;
#define SLOAD(i) do { const bf16* rp = CV + (t0 + 64 * (i) + sr) * CVP; kb0 = ld8(rp + CV_B + g * 128 + sc); kb1 = ld8(rp + 32 * CVP + CV_B + g * 128 + sc); \
    if (sc < 64) { xv0 = ld8(rp + CV_XDT + h * 64 + sc); xv1 = ld8(rp + 32 * CVP + CV_XDT + h * 64 + sc); } } while (0)
  SLOAD(0);
  f32x16 acc = f32x16{};
#pragma nounroll
  for (int i = 0; i < 4; ++i) {
    __syncthreads();
    const float aend = acs_lds[255];
    if (sc < 64) {
      const float f0 = __builtin_amdgcn_exp2f((aend - acs_lds[64 * i + sr]) * LOG2E), f1 = __builtin_amdgcn_exp2f((aend - acs_lds[64 * i + 32 + sr]) * LOG2E);
      u32x4 w0, w1;
#pragma unroll
      for (int q = 0; q < 4; ++q) { w0[q] = cvtpk(bf2f((unsigned short)xv0[2 * q]) * f0, bf2f((unsigned short)xv0[2 * q + 1]) * f0);
                                    w1[q] = cvtpk(bf2f((unsigned short)xv1[2 * q]) * f1, bf2f((unsigned short)xv1[2 * q + 1]) * f1); }
      *(u32x4*)(X_lds + vst0) = w0; *(u32x4*)(X_lds + vst1) = w1;
    }
    *(bf16x8*)(B_lds + vst0) = kb0; *(bf16x8*)(B_lds + vst1) = kb1;
    if (i < 3) SLOAD(i + 1);
    __syncthreads();
    { const s16x4 al0 = tr_read<v_rd_off(0, 0, 0)>(xb), ah0 = tr_read<v_rd_off(0, 0, 1)>(xb), al1 = tr_read<v_rd_off(0, 1, 0)>(xb), ah1 = tr_read<v_rd_off(0, 1, 1)>(xb);
      const s16x4 al2 = tr_read<v_rd_off(0, 2, 0)>(xb), ah2 = tr_read<v_rd_off(0, 2, 1)>(xb), al3 = tr_read<v_rd_off(0, 3, 0)>(xb), ah3 = tr_read<v_rd_off(0, 3, 1)>(xb);
      const s16x4 bl0 = tr_read<v_rd_off(0, 0, 0)>(bb), bh0 = tr_read<v_rd_off(0, 0, 1)>(bb), bl1 = tr_read<v_rd_off(0, 1, 0)>(bb), bh1 = tr_read<v_rd_off(0, 1, 1)>(bb);
      const s16x4 bl2 = tr_read<v_rd_off(0, 2, 0)>(bb), bh2 = tr_read<v_rd_off(0, 2, 1)>(bb), bl3 = tr_read<v_rd_off(0, 3, 0)>(bb), bh3 = tr_read<v_rd_off(0, 3, 1)>(bb);
      asm volatile("s_waitcnt lgkmcnt(0)" ::: "memory"); SBAR();
      acc = __builtin_amdgcn_mfma_f32_32x32x16_bf16(ATT_PK(al0, ah0), ATT_PK(bl0, bh0), acc, 0, 0, 0);
      acc = __builtin_amdgcn_mfma_f32_32x32x16_bf16(ATT_PK(al1, ah1), ATT_PK(bl1, bh1), acc, 0, 0, 0);
      acc = __builtin_amdgcn_mfma_f32_32x32x16_bf16(ATT_PK(al2, ah2), ATT_PK(bl2, bh2), acc, 0, 0, 0);
      acc = __builtin_amdgcn_mfma_f32_32x32x16_bf16(ATT_PK(al3, ah3), ATT_PK(bl3, bh3), acc, 0, 0, 0); }
  }
#undef SLOAD
  float* Sp = STATES + ((long)(c * 24 + h) * 64 + 32 * pb) * 128 + 32 * nb + r32;
#pragma unroll
  for (int r = 0; r < 16; ++r) Sp[crow(r, hi) * 128] = acc[r];
  __syncthreads();
}
__device__ __forceinline__ void ssd_y_unit(const bf16* __restrict__ CV, const float* __restrict__ ACS, const bf16* __restrict__ PREV, float dsk, float* __restrict__ YS, int c, int h, char* lds) {
  const int tid = fresh_tid(), wid = tid >> 6, lane = tid & 63, r32 = lane & 31, hi = lane >> 5;
  const int g = h / 6; const long t0 = 256L * c;
  char* V_lds = lds; char* K_lds = lds + 2 * SHM_V; float* acs_lds = (float*)(lds + ACS_OFF);
  if (tid < 256) acs_lds[tid] = ACS[(c * 24 + h) * 256 + tid];
  const int lrow = wid * 32 + r32;
  const float acs_l = ACS[(c * 24 + h) * 256 + lrow];
  bf16x8 qr[8];
  { const bf16* Qw = CV + (t0 + lrow) * CVP + CV_C + g * 128 + hi * 8;
#pragma unroll
    for (int d0 = 0; d0 < 8; ++d0) qr[d0] = ld8(Qw + d0 * 16); }
  const int sr = tid >> 4, sc = (tid & 15) * 8, vst0 = v_st(sr, sc), vst1 = v_st(32 + sr, sc);
  const int vb0 = (int)(uintptr_t)V_lds + v_rd_base(lane);
  bf16x8 xv0 = {}, xv1 = {}, kb0, kb1;
#define SLOAD(i) do { const bf16* rp = CV + (t0 + 64 * (i) + sr) * CVP; kb0 = ld8(rp + CV_B + g * 128 + sc); kb1 = ld8(rp + 32 * CVP + CV_B + g * 128 + sc); \
    if (sc < 64) { xv0 = ld8(rp + CV_XDT + h * 64 + sc); xv1 = ld8(rp + 32 * CVP + CV_XDT + h * 64 + sc); } } while (0)
  SLOAD(0);
  f32x16 o[2] = {};
#pragma nounroll
  for (int i = 0; i < 4; ++i) {
    __syncthreads();
    { const int kc = sc * 2; *(bf16x8*)(K_lds + KSWZ(sr, kc)) = kb0; *(bf16x8*)(K_lds + KSWZ(32 + sr, kc)) = kb1; }
    if (sc < 64) { *(bf16x8*)(V_lds + vst0) = xv0; *(bf16x8*)(V_lds + vst1) = xv1; }
    if (i < 3) SLOAD(i + 1);
    __syncthreads();
    if (64 * i <= wid * 32 + 31) {
      f32x16 p0, p1; qkt<false>(p0, p1, K_lds, qr, r32, hi);
#pragma unroll
      for (int r = 0; r < 16; ++r) { const int s = 64 * i + crow(r, hi);
        const float e0 = __builtin_amdgcn_exp2f((acs_l - acs_lds[s]) * LOG2E), e1 = __builtin_amdgcn_exp2f((acs_l - acs_lds[s + 32]) * LOG2E);
        p0[r] = (s <= lrow) ? p0[r] * e0 : 0.f; p1[r] = (s + 32 <= lrow) ? p1[r] * e1 : 0.f; }
      bf16x8 pa0, pa1, pa2, pa3;
      ATT_PK4(p0, 0, pa0); ATT_PK4(p0, 8, pa1); ATT_PK4(p1, 0, pa2); ATT_PK4(p1, 8, pa3);
      pv_one<0>(o[0], vb0, pa0, pa1, pa2, pa3); pv_one<1>(o[1], vb0, pa0, pa1, pa2, pa3);
    }
  }
#undef SLOAD
  f32x16 o2[2] = {};
  { const bf16* Pp = PREV + ((long)(c * 24 + h) * 64 + r32) * 128 + hi * 8;
#pragma unroll
    for (int d0 = 0; d0 < 2; ++d0)
#pragma unroll
      for (int d = 0; d < 8; ++d) { const bf16x8 bfrag = ld8(Pp + d0 * 32 * 128 + d * 16);
        o2[d0] = __builtin_amdgcn_mfma_f32_32x32x16_bf16(qr[d], bfrag, o2[d0], 0, 0, 0); } }
  { const bf16* xp0 = CV + (t0 + wid * 32 + 4 * hi) * CVP + h * 64 + r32; float* yp0 = YS + (t0 + wid * 32 + 4 * hi) * 1536 + h * 64 + r32; const float* ap = acs_lds + wid * 32 + 4 * hi;
#pragma unroll
  for (int r = 0; r < 16; ++r) { const int ro = (r & 3) + 8 * (r >> 2); const float ea = __builtin_amdgcn_exp2f(ap[ro] * LOG2E);
    asm volatile("" ::: "memory");
#pragma unroll
    for (int d0 = 0; d0 < 2; ++d0) yp0[ro * 1536 + d0 * 32] = o[d0][r] + o2[d0][r] * ea + dsk * bf2f(xp0[ro * CVP + d0 * 32]); } }
  __syncthreads();
}
__device__ __forceinline__ void ssd_state_unit2(const bf16* __restrict__ CV, const float* __restrict__ ACS, float* __restrict__ STATES, int c, int h, char* lds, float* acs_lds) {
  const int tid = fresh_tid(), wid = tid >> 6, lane = tid & 63, r32 = lane & 31, hi = lane >> 5;
  const int g = h / 6; const long t0 = 256L * c;
  char* X_lds = lds; char* B_lds = lds + 4 * SHM_V;
  const float* acs_g = ACS + (c * 24 + h) * 256;
  const int sr = tid >> 4, sc = (tid & 15) * 8, vst0 = v_st(sr, sc), vst1 = v_st(32 + sr, sc);
  const int pb = wid & 1, nb = wid >> 1;
  const int xb = (int)(uintptr_t)X_lds + v_rd_base(lane) + pb * 512, bb = (int)(uintptr_t)B_lds + v_rd_base(lane) + nb * 512;
  { bf16x8 kb[8], xv[8]; const float aend = acs_g[255]; float f[8];
    const bf16* rp = CV + (t0 + sr) * CVP;
#pragma unroll
    for (int i = 0; i < 4; ++i) { kb[2 * i] = ld8(rp + (size_t)(64 * i) * CVP + CV_B + g * 128 + sc); kb[2 * i + 1] = ld8(rp + (size_t)(64 * i + 32) * CVP + CV_B + g * 128 + sc);
      if (sc < 64) { xv[2 * i] = ld8(rp + (size_t)(64 * i) * CVP + CV_XDT + h * 64 + sc); xv[2 * i + 1] = ld8(rp + (size_t)(64 * i + 32) * CVP + CV_XDT + h * 64 + sc);
        f[2 * i] = __builtin_amdgcn_exp2f((aend - acs_g[64 * i + sr]) * LOG2E); f[2 * i + 1] = __builtin_amdgcn_exp2f((aend - acs_g[64 * i + 32 + sr]) * LOG2E); } }
#pragma unroll
    for (int i = 0; i < 4; ++i) {
      *(bf16x8*)(B_lds + i * SHM_V + vst0) = kb[2 * i]; *(bf16x8*)(B_lds + i * SHM_V + vst1) = kb[2 * i + 1];
      if (sc < 64) { u32x4 w0, w1;
#pragma unroll
        for (int q = 0; q < 4; ++q) { w0[q] = cvtpk(bf2f((unsigned short)xv[2 * i][2 * q]) * f[2 * i], bf2f((unsigned short)xv[2 * i][2 * q + 1]) * f[2 * i]);
                                      w1[q] = cvtpk(bf2f((unsigned short)xv[2 * i + 1][2 * q]) * f[2 * i + 1], bf2f((unsigned short)xv[2 * i + 1][2 * q + 1]) * f[2 * i + 1]); }
        *(u32x4*)(X_lds + i * SHM_V + vst0) = w0; *(u32x4*)(X_lds + i * SHM_V + vst1) = w1; } } }
  __syncthreads();
  f32x16 acc = f32x16{};
#pragma unroll
  for (int i = 0; i < 4; ++i) {
    const int xo = xb + i * SHM_V, bo = bb + i * SHM_V;
    const s16x4 al0 = tr_read<v_rd_off(0, 0, 0)>(xo), ah0 = tr_read<v_rd_off(0, 0, 1)>(xo), al1 = tr_read<v_rd_off(0, 1, 0)>(xo), ah1 = tr_read<v_rd_off(0, 1, 1)>(xo);
    const s16x4 al2 = tr_read<v_rd_off(0, 2, 0)>(xo), ah2 = tr_read<v_rd_off(0, 2, 1)>(xo), al3 = tr_read<v_rd_off(0, 3, 0)>(xo), ah3 = tr_read<v_rd_off(0, 3, 1)>(xo);
    const s16x4 bl0 = tr_read<v_rd_off(0, 0, 0)>(bo), bh0 = tr_read<v_rd_off(0, 0, 1)>(bo), bl1 = tr_read<v_rd_off(0, 1, 0)>(bo), bh1 = tr_read<v_rd_off(0, 1, 1)>(bo);
    const s16x4 bl2 = tr_read<v_rd_off(0, 2, 0)>(bo), bh2 = tr_read<v_rd_off(0, 2, 1)>(bo), bl3 = tr_read<v_rd_off(0, 3, 0)>(bo), bh3 = tr_read<v_rd_off(0, 3, 1)>(bo);
    asm volatile("s_waitcnt lgkmcnt(0)" ::: "memory"); SBAR();
    acc = __builtin_amdgcn_mfma_f32_32x32x16_bf16(ATT_PK(al0, ah0), ATT_PK(bl0, bh0), acc, 0, 0, 0);
    acc = __builtin_amdgcn_mfma_f32_32x32x16_bf16(ATT_PK(al1, ah1), ATT_PK(bl1, bh1), acc, 0, 0, 0);
    acc = __builtin_amdgcn_mfma_f32_32x32x16_bf16(ATT_PK(al2, ah2), ATT_PK(bl2, bh2), acc, 0, 0, 0);
    acc = __builtin_amdgcn_mfma_f32_32x32x16_bf16(ATT_PK(al3, ah3), ATT_PK(bl3, bh3), acc, 0, 0, 0);
  }
  float* Sp = STATES + ((long)(c * 24 + h) * 64 + 32 * pb) * 128 + 32 * nb + r32;
#pragma unroll
  for (int r = 0; r < 16; ++r) Sp[crow(r, hi) * 128] = acc[r];
  __syncthreads();
}
__device__ __forceinline__ void ssd_y_unit2(const bf16* __restrict__ CV, const float* __restrict__ ACS, const bf16* __restrict__ PREV, float dsk, float* __restrict__ YS, int c, int h, char* lds, float* acs_lds) {
  const int tid = fresh_tid(), wid = tid >> 6, lane = tid & 63, r32 = lane & 31, hi = lane >> 5;
  const int g = h / 6; const long t0 = 256L * c;
  char* V_lds = lds; char* K_lds = lds + 4 * SHM_V;
  if (tid < 256) acs_lds[tid] = ACS[(c * 24 + h) * 256 + tid];
  const int lrow = wid * 32 + r32;
  const float acs_l = ACS[(c * 24 + h) * 256 + lrow];
  bf16x8 qr[8];
  { const bf16* Qw = CV + (t0 + lrow) * CVP + CV_C + g * 128 + hi * 8;
#pragma unroll
    for (int d0 = 0; d0 < 8; ++d0) qr[d0] = ld8(Qw + d0 * 16); }
  { const int sr = tid >> 4, sc = (tid & 15) * 8, vst0 = v_st(sr, sc), vst1 = v_st(32 + sr, sc);
    bf16x8 kb[8], xv[8]; const bf16* rp = CV + (t0 + sr) * CVP;
#pragma unroll
    for (int i = 0; i < 4; ++i) { kb[2 * i] = ld8(rp + (size_t)(64 * i) * CVP + CV_B + g * 128 + sc); kb[2 * i + 1] = ld8(rp + (size_t)(64 * i + 32) * CVP + CV_B + g * 128 + sc);
      if (sc < 64) { xv[2 * i] = ld8(rp + (size_t)(64 * i) * CVP + CV_XDT + h * 64 + sc); xv[2 * i + 1] = ld8(rp + (size_t)(64 * i + 32) * CVP + CV_XDT + h * 64 + sc); } }
#pragma unroll
    for (int i = 0; i < 4; ++i) { const int kc = sc * 2;
      *(bf16x8*)(K_lds + i * SHM_K + KSWZ(sr, kc)) = kb[2 * i]; *(bf16x8*)(K_lds + i * SHM_K + KSWZ(32 + sr, kc)) = kb[2 * i + 1];
      if (sc < 64) { *(bf16x8*)(V_lds + i * SHM_V + vst0) = xv[2 * i]; *(bf16x8*)(V_lds + i * SHM_V + vst1) = xv[2 * i + 1]; } } }
  __syncthreads();
  const int vb0 = (int)(uintptr_t)V_lds + v_rd_base(lane);
  f32x16 o[2] = {};
  const int ntile = (wid * 32 + 31) / 64 + 1;
#pragma nounroll
  for (int i = 0; i < ntile; ++i) {
    f32x16 p0, p1; qkt<false>(p0, p1, K_lds + i * SHM_K, qr, r32, hi);
#pragma unroll
    for (int r = 0; r < 16; ++r) { const int s = 64 * i + crow(r, hi);
      const float e0 = __builtin_amdgcn_exp2f((acs_l - acs_lds[s]) * LOG2E), e1 = __builtin_amdgcn_exp2f((acs_l - acs_lds[s + 32]) * LOG2E);
      p0[r] = (s <= lrow) ? p0[r] * e0 : 0.f; p1[r] = (s + 32 <= lrow) ? p1[r] * e1 : 0.f; }
    bf16x8 pa0, pa1, pa2, pa3;
    ATT_PK4(p0, 0, pa0); ATT_PK4(p0, 8, pa1); ATT_PK4(p1, 0, pa2); ATT_PK4(p1, 8, pa3);
    pv_one<0>(o[0], vb0 + i * SHM_V, pa0, pa1, pa2, pa3); pv_one<1>(o[1], vb0 + i * SHM_V, pa0, pa1, pa2, pa3);
  }
  f32x16 o2[2] = {};
  { const bf16* Pp = PREV + ((long)(c * 24 + h) * 64 + r32) * 128 + hi * 8;
#pragma unroll
    for (int d0 = 0; d0 < 2; ++d0)
#pragma unroll
      for (int d = 0; d < 8; ++d) { const bf16x8 bfrag = ld8(Pp + d0 * 32 * 128 + d * 16);
        o2[d0] = __builtin_amdgcn_mfma_f32_32x32x16_bf16(qr[d], bfrag, o2[d0], 0, 0, 0); } }
  { const bf16* xp0 = CV + (t0 + wid * 32 + 4 * hi) * CVP + h * 64 + r32; float* yp0 = YS + (t0 + wid * 32 + 4 * hi) * 1536 + h * 64 + r32; const float* ap = acs_lds + wid * 32 + 4 * hi;
  unsigned short xs0[16], xs1[16];
#pragma unroll
  for (int r = 0; r < 16; ++r) { const int ro = (r & 3) + 8 * (r >> 2); xs0[r] = xp0[ro * CVP]; xs1[r] = xp0[ro * CVP + 32]; }
#pragma unroll
  for (int r = 0; r < 16; ++r) { const int ro = (r & 3) + 8 * (r >> 2); const float ea = __builtin_amdgcn_exp2f(ap[ro] * LOG2E);
    yp0[ro * 1536] = o[0][r] + o2[0][r] * ea + dsk * bf2f(xs0[r]); yp0[ro * 1536 + 32] = o[1][r] + o2[1][r] * ea + dsk * bf2f(xs1[r]); } }
  __syncthreads();
}
__device__ __forceinline__ void ssd_y_units(const bf16* __restrict__ CV, const float* __restrict__ ACS, const bf16* __restrict__ PREV, const float* __restrict__ dskp, float* __restrict__ YS,
                                            int u0, int ustep, char* lds, float* acs_lds) {
  const int tid = fresh_tid(), wid = tid >> 6, lane = tid & 63, r32 = lane & 31, hi = lane >> 5;
  char* V_lds = lds; char* K_lds = lds + 4 * SHM_V;
  const int lrow = wid * 32 + r32;
  const int sr = tid >> 4, sc = (tid & 15) * 8, vst0 = v_st(sr, sc), vst1 = v_st(32 + sr, sc);
  const int vb0 = (int)(uintptr_t)V_lds + v_rd_base(lane);
  const int ntile = (wid * 32 + 31) / 64 + 1;
  const int sr2 = tid >> 3, sc2 = (tid & 7) * 8, vst2 = v_st(sr2, sc2);
  bf16x8 kbn[8], xvn[4], qn[8]; float acsn = 0.f, acsln = 0.f;
#define YU_LOAD(u_) do { const int c_ = (u_) / 24, h_ = (u_) % 24, g_ = h_ / 6; const long t0_ = 256L * c_; const bf16* rp_ = CV + (t0_ + sr) * CVP; \
    _Pragma("unroll") for (int i = 0; i < 4; ++i) { kbn[2 * i] = ld8(rp_ + (size_t)(64 * i) * CVP + CV_B + g_ * 128 + sc); kbn[2 * i + 1] = ld8(rp_ + (size_t)(64 * i + 32) * CVP + CV_B + g_ * 128 + sc); \
      xvn[i] = ld8(CV + (t0_ + 64 * i + sr2) * CVP + CV_XDT + h_ * 64 + sc2); } \
    { const bf16* Qw_ = CV + (t0_ + lrow) * CVP + CV_C + g_ * 128 + hi * 8; _Pragma("unroll") for (int d0 = 0; d0 < 8; ++d0) qn[d0] = ld8(Qw_ + d0 * 16); } \
    acsn = ACS[(c_ * 24 + h_) * 256 + (tid & 255)]; acsln = ACS[(c_ * 24 + h_) * 256 + lrow]; } while (0)
  if (u0 < 768) YU_LOAD(u0);
#pragma nounroll
  for (int u = u0; u < 768; u += ustep) {
    const int c = u / 24, h = u % 24; const long t0 = 256L * c; const float dsk = dskp[h];
    bf16x8 qr[8]; const float acs_l = acsln;
#pragma unroll
    for (int d0 = 0; d0 < 8; ++d0) qr[d0] = qn[d0];
    if (tid < 256) acs_lds[tid] = acsn;
#pragma unroll
    for (int i = 0; i < 4; ++i) { const int kc = sc * 2;
      *(bf16x8*)(K_lds + i * SHM_K + KSWZ(sr, kc)) = kbn[2 * i]; *(bf16x8*)(K_lds + i * SHM_K + KSWZ(32 + sr, kc)) = kbn[2 * i + 1];
      *(bf16x8*)(V_lds + i * SHM_V + vst2) = xvn[i]; }
    __syncthreads();
    if (u + ustep < 768) YU_LOAD(u + ustep);
    f32x16 o[2] = {};
#pragma nounroll
    for (int i = 0; i < ntile; ++i) {
      f32x16 p0, p1; qkt<false>(p0, p1, K_lds + i * SHM_K, qr, r32, hi);
#pragma unroll
      for (int r = 0; r < 16; ++r) { const int s = 64 * i + crow(r, hi);
        const float e0 = __builtin_amdgcn_exp2f((acs_l - acs_lds[s]) * LOG2E), e1 = __builtin_amdgcn_exp2f((acs_l - acs_lds[s + 32]) * LOG2E);
        p0[r] = (s <= lrow) ? p0[r] * e0 : 0.f; p1[r] = (s + 32 <= lrow) ? p1[r] * e1 : 0.f; }
      bf16x8 pa0, pa1, pa2, pa3;
      ATT_PK4(p0, 0, pa0); ATT_PK4(p0, 8, pa1); ATT_PK4(p1, 0, pa2); ATT_PK4(p1, 8, pa3);
      pv_one<0>(o[0], vb0 + i * SHM_V, pa0, pa1, pa2, pa3); pv_one<1>(o[1], vb0 + i * SHM_V, pa0, pa1, pa2, pa3);
    }
    f32x16 o2[2] = {};
    { const bf16* Pp = PREV + ((long)(c * 24 + h) * 64 + r32) * 128 + hi * 8;
#pragma unroll
      for (int d0 = 0; d0 < 2; ++d0)
#pragma unroll
        for (int d = 0; d < 8; ++d) { const bf16x8 bfrag = ld8(Pp + d0 * 32 * 128 + d * 16);
          o2[d0] = __builtin_amdgcn_mfma_f32_32x32x16_bf16(qr[d], bfrag, o2[d0], 0, 0, 0); } }
    { const bf16* xp0 = CV + (t0 + wid * 32 + 4 * hi) * CVP + h * 64 + r32; float* yp0 = YS + (t0 + wid * 32 + 4 * hi) * 1536 + h * 64 + r32; const float* ap = acs_lds + wid * 32 + 4 * hi;
      unsigned short xs0[16], xs1[16];
#pragma unroll
      for (int r = 0; r < 16; ++r) { const int ro = (r & 3) + 8 * (r >> 2); xs0[r] = xp0[ro * CVP]; xs1[r] = xp0[ro * CVP + 32]; }
#pragma unroll
      for (int r = 0; r < 16; ++r) { const int ro = (r & 3) + 8 * (r >> 2); const float ea = __builtin_amdgcn_exp2f(ap[ro] * LOG2E);
        yp0[ro * 1536] = o[0][r] + o2[0][r] * ea + dsk * bf2f(xs0[r]); yp0[ro * 1536 + 32] = o[1][r] + o2[1][r] * ea + dsk * bf2f(xs1[r]); } }
    __syncthreads();
  }
#undef YU_LOAD
}
#undef KSWZ
#undef SBAR
#undef ATT_PK
#undef ATT_PK4
}
constexpr int T = 8192, DM = 2048, DFF = 7168, NEXP = 8, MEML = 256;
constexpr int N_IN0 = 5120, N_IN1 = 4864, N_IN1_REAL = 4632;
constexpr int MOE_ROWS = 72 * 256;
constexpr float LN_EPS = 1e-5f, RMS_EPS = 1e-5f, DN_ALPHA = 1.41421356237309515f;
constexpr int NWAVES = 8;
#ifndef MK_PER_PHASE
#define MK_PER_PHASE 0
#endif
constexpr int NPHASE = 24;

constexpr size_t MiB = 1u << 20;
constexpr size_t WS_CTL = 0, CTL_ZERO_BYTES = 1 * MiB;
constexpr size_t WS_ROPE = 1 * MiB, WS_KMEAN = 2 * MiB, WS_DTR = 3 * MiB, WS_ACS = 4 * MiB;
constexpr size_t WS_TOKE = 5 * MiB, WS_TOKW = 5 * MiB + 65536, WS_POS = 5 * MiB + 131072, WS_COUNTS = 5 * MiB + 262144;
constexpr size_t WS_MEMB = 6 * MiB, WS_MEMKV = 7 * MiB;
constexpr size_t WS_WMKV = 8 * MiB, WS_WIN0 = WS_WMKV + 4 * MiB, WS_WO0 = WS_WIN0 + 20 * MiB, WS_WGU0 = WS_WO0 + 8 * MiB, WS_WD0 = WS_WGU0 + 56 * MiB;
constexpr size_t WS_WIN1 = WS_WD0 + 28 * MiB, WS_WO1 = WS_WIN1 + 19 * MiB, WS_WGUE = WS_WO1 + 8 * MiB, WS_WDE = WS_WGUE + 448 * MiB, WS_WEND = WS_WDE + 224 * MiB;
constexpr size_t WS_XCUR = WS_WEND + 1 * MiB, WS_XCURB = WS_XCUR + 64 * MiB, WS_HEADS = WS_XCURB + 32 * MiB, WS_YF = WS_HEADS + 32 * MiB;
constexpr size_t WS_RA = WS_YF + 64 * MiB, WS_RB = WS_RA + 252 * MiB, WS_RC = WS_RB + 144 * MiB;
constexpr size_t WS_STATES = WS_RC + 72 * MiB, WS_PREV = WS_STATES + 24 * MiB, WS_YSSD = WS_PREV + 12 * MiB, WS_END = WS_YSSD + 48 * MiB;
static_assert((size_t)N_IN1 * DM * 2 <= 19 * MiB && (size_t)MOE_ROWS * DFF * 2 <= 252 * MiB && (size_t)MOE_ROWS * DM * 4 <= 144 * MiB && (size_t)MOE_ROWS * DM * 2 <= 72 * MiB, "ws map");
constexpr size_t WS_ROWMASK = WS_YSSD, WS_CNT = WS_YSSD + 1 * MiB, WS_SEG = WS_YSSD + 2 * MiB;
constexpr int CW_TMO = 0, CW_BAR = 4096;

constexpr int RING_OFF = 0, RING_BYTES = 131072;
constexpr int LDSCTL_OFF = RING_BYTES, MISC_OFF = LDSCTL_OFF + 320;
constexpr int LDS_BYTES = 147456;

#define GAS __attribute__((address_space(1)))
#define LAS __attribute__((address_space(3)))
typedef unsigned short bf16;
typedef unsigned v4u __attribute__((ext_vector_type(4)));
typedef unsigned v2u __attribute__((ext_vector_type(2)));
typedef float f32x4 __attribute__((ext_vector_type(4)));
typedef short bf16x8 __attribute__((ext_vector_type(8)));
typedef GAS unsigned gu32;
#define RLX_AGENT __ATOMIC_RELAXED, __HIP_MEMORY_SCOPE_AGENT
#define LDS_WAIT() asm volatile("s_waitcnt lgkmcnt(0)" ::: "memory")
__device__ __forceinline__ unsigned pk2(float lo, float hi) { unsigned r; asm volatile("v_cvt_pk_bf16_f32 %0, %1, %2" : "=v"(r) : "v"(lo), "v"(hi)); return r; }
__device__ __forceinline__ float bf2f(unsigned short b) { return __uint_as_float(((unsigned)b) << 16); }
__device__ __forceinline__ float bflo(unsigned w) { return __uint_as_float(w << 16); }
__device__ __forceinline__ float bfhi(unsigned w) { return __uint_as_float(w & 0xffff0000u); }
__device__ __forceinline__ float wave_sum(float v) {
#pragma unroll
    for (int o = 1; o < 64; o <<= 1) v += __shfl_xor(v, o);
    return v;
}
__device__ __forceinline__ float silu_f(float g) { return g * __builtin_amdgcn_rcpf(1.0f + __builtin_amdgcn_exp2f(-1.4426950408889634f * g)); }
__device__ __forceinline__ float softplus_f(float x) { return x > 20.f ? x : log1pf(__expf(x)); }
#define XB_TMO      128
#define XB_XCNT(j)  (256  + 64 * (j))
#define XB_XSUB(j)  (1280 + 64 * (j))
#define XB_XGEN(j)  (2304 + 64 * (j))
#define XB_TOP      3328
#define XB_TOPGEN   3392
#define XCD_BAR_WORDS 3456
#define XB_SPIN_CAP (1u << 18)

__device__ __forceinline__ unsigned xb_ld(unsigned* p)              { return __hip_atomic_load(p, __ATOMIC_RELAXED, __HIP_MEMORY_SCOPE_AGENT); }
__device__ __forceinline__ unsigned xb_add(unsigned* p, unsigned v) { return __hip_atomic_fetch_add(p, v, __ATOMIC_RELAXED, __HIP_MEMORY_SCOPE_AGENT); }
__device__ __forceinline__ unsigned xb_xcc_id() { return (unsigned)__builtin_amdgcn_s_getreg((3 << 11) | 20) & 0xFu; }
#define XB_SPIN(cond, bar) do { unsigned _sp = 0; while (cond) { __builtin_amdgcn_s_sleep(1); \
    if ((++_sp & 255u) == 0u) { if (xb_ld(&(bar)[XB_TMO])) break; if (_sp > XB_SPIN_CAP) { atomicAdd(&(bar)[XB_TMO], 1u); break; } } } } while (0)

struct XcdBarrier {
    unsigned* bar; unsigned x; int w;
    volatile LAS unsigned* st;
};

__device__ __forceinline__ XcdBarrier xcd_barrier_post(unsigned* bar, volatile LAS unsigned* st, int wave) {
    XcdBarrier b; b.bar = bar; b.x = xb_xcc_id(); b.st = st; b.w = wave;
    if (threadIdx.x == 0) (void)xb_add(&bar[XB_XCNT(b.x)], 1u);
    return b;
}
__device__ __forceinline__ void xcd_barrier_complete(unsigned* bar, unsigned x, unsigned& nloc, unsigned& nx) {
    const unsigned G = gridDim.x * gridDim.y * gridDim.z;
    unsigned sum, cnt, mine, sp = 0u;
    for (;;) {
        sum = 0u; cnt = 0u; mine = 0u;
#pragma unroll
        for (unsigned j = 0; j < 16; ++j) { const unsigned c = xb_ld(&bar[XB_XCNT(j)]); sum += c; cnt += (c > 0u) ? 1u : 0u; mine = (j == x) ? c : mine; }
        if (sum == G) break;
        __builtin_amdgcn_s_sleep(1);
        if ((++sp & 255u) == 0u) { if (xb_ld(&bar[XB_TMO])) break; if (sp > XB_SPIN_CAP) { atomicAdd(&bar[XB_TMO], 1u); break; } }
    }
    nloc = mine > 0u ? mine : 1u; nx = cnt > 0u ? cnt : 1u;
}

__device__ __forceinline__ void xcd_barrier(const XcdBarrier& b) {
    asm volatile("s_waitcnt vmcnt(0)" ::: "memory");
    __syncthreads();
    unsigned z_; asm volatile("s_mov_b32 %0, 0" : "=s"(z_));
    if (b.w == 0 && __builtin_amdgcn_mbcnt_hi(~0u, __builtin_amdgcn_mbcnt_lo(~0u, z_)) == 0u) {
        unsigned* bar = b.bar;
        __builtin_amdgcn_s_waitcnt(0);
        unsigned nloc = b.st[0], nx = b.st[1];
        if (nloc == 0u) { xcd_barrier_complete(bar, b.x, nloc, nx); b.st[0] = nloc; b.st[1] = nx; }
        const unsigned old = xb_add(&bar[XB_XSUB(b.x)], 1u);
        const unsigned gen = old / nloc;
        if (old + 1u == (gen + 1u) * nloc) {
            __builtin_amdgcn_fence(__ATOMIC_RELEASE, "agent");
            asm volatile("s_waitcnt vmcnt(0)" ::: "memory");
            const unsigned og = xb_add(&bar[XB_TOP], 1u);
            const unsigned tg = og / nx;
            if (og + 1u == (tg + 1u) * nx) xb_add(&bar[XB_TOPGEN], 1u);
            else XB_SPIN(xb_ld(&bar[XB_TOPGEN]) == tg, bar);
            __builtin_amdgcn_fence(__ATOMIC_ACQUIRE, "agent");
            xb_add(&bar[XB_XGEN(b.x)], 1u);
            asm volatile("s_waitcnt vmcnt(0)" ::: "memory");
        } else {
            XB_SPIN(xb_ld(&bar[XB_XGEN(b.x)]) == gen, bar);
            __builtin_amdgcn_fence(__ATOMIC_ACQUIRE, "agent");
            asm volatile("s_waitcnt vmcnt(0)" ::: "memory");
        }
    }
    __syncthreads();
}

struct Args { const void* in[29]; float* out; unsigned char* ws; int ph_lo, ph_hi; };
struct Frame {
    LAS unsigned char* lds; char* ldsg; volatile LAS unsigned* MISC; gu32* ctl;
    int tid, lane, wave, G, gw, NGW;
};

__device__ __forceinline__ int dest_row(int mode, int n) {
    if (mode == 1) return ((n >> 7) << 8) + (n & 127);
    if (mode == 2) return ((n >> 7) << 8) + 128 + (n & 127);
    if (mode == 3) return n < 4096 ? n : (n < 4120 ? 4608 + (n - 4096) : 4096 + (n - 4120));
    if (mode == 4) { const int c = n & 127; return (n < 3072 && c < 32) ? (n & ~127) + 2 * (c & 15) + (c >> 4) : n; }
    return n;
}
struct CvItem { const float* W; bf16* WT; int K, N, mode, loc, fp8; };
__device__ __forceinline__ void cv_load(const CvItem& c, f32x4 (&v)[8], int lane) {
    const int nblk = (c.N + 31) >> 5, kb = c.loc / nblk, nb = c.loc - kb * nblk, k0 = 64 * kb, n0 = 32 * nb;
    const int col = n0 + (lane & 7) * 4; const int colc = col < c.N ? col : c.N - 4;
    const float* src = c.W + (size_t)(k0 + (lane >> 3)) * c.N + colc;
#pragma unroll
    for (int i = 0; i < 8; ++i) v[i] = __builtin_nontemporal_load((const f32x4*)(src + (size_t)(8 * i) * c.N));
}
__device__ __forceinline__ void cv_store(const CvItem& c, const f32x4 (&v)[8], LAS float* scr, int lane) {
    const int nblk = (c.N + 31) >> 5, kb = c.loc / nblk, nb = c.loc - kb * nblk, k0 = 64 * kb, n0 = 32 * nb;
    { LAS float* wp = scr + (lane >> 3) * 33 + (lane & 7) * 4;
#pragma unroll
      for (int i = 0; i < 8; ++i) { wp[(8 * i) * 33 + 0] = v[i][0]; wp[(8 * i) * 33 + 1] = v[i][1]; wp[(8 * i) * 33 + 2] = v[i][2]; wp[(8 * i) * 33 + 3] = v[i][3]; } }
    LDS_WAIT(); asm volatile("" ::: "memory");
    const int cc = lane & 7;
#pragma unroll
    for (int j = 0; j < 4; ++j) { const int nn = (lane >> 3) + 8 * j; const LAS float* s = scr + (8 * cc) * 33 + nn;
        v4u o; o.x = pk2(s[0 * 33], s[1 * 33]); o.y = pk2(s[2 * 33], s[3 * 33]); o.z = pk2(s[4 * 33], s[5 * 33]); o.w = pk2(s[6 * 33], s[7 * 33]);
        if (c.fp8) { const float sc_ = __builtin_ldexpf(1.0f, c.fp8); int w0 = 0, w1 = 0;
            w0 = __builtin_amdgcn_cvt_pk_fp8_f32(s[0 * 33] * sc_, s[1 * 33] * sc_, w0, false); w0 = __builtin_amdgcn_cvt_pk_fp8_f32(s[2 * 33] * sc_, s[3 * 33] * sc_, w0, true);
            w1 = __builtin_amdgcn_cvt_pk_fp8_f32(s[4 * 33] * sc_, s[5 * 33] * sc_, w1, false); w1 = __builtin_amdgcn_cvt_pk_fp8_f32(s[6 * 33] * sc_, s[7 * 33] * sc_, w1, true);
            if (n0 + nn < c.N) *(v2u*)((unsigned char*)c.WT + (size_t)dest_row(c.mode, n0 + nn) * c.K + k0 + 8 * cc) = (v2u){(unsigned)w0, (unsigned)w1}; }
        else if (n0 + nn < c.N) __builtin_nontemporal_store(o, (v4u*)(c.WT + (size_t)dest_row(c.mode, n0 + nn) * c.K + k0 + 8 * cc)); }
    LDS_WAIT(); asm volatile("" ::: "memory");
}
constexpr int CV_I_MKV = 32 * 32, CV_I_IN0 = 32 * 160, CV_I_O = 32 * 64, CV_I_GU = 32 * 224, CV_I_D = 112 * 64, CV_I_IN1 = 32 * 145;
constexpr int CV_B1 = CV_I_MKV, CV_B2 = CV_B1 + CV_I_IN0, CV_B3 = CV_B2 + CV_I_O, CV_B4 = CV_B3 + CV_I_GU, CV_B5 = CV_B4 + CV_I_GU, CV_B6 = CV_B5 + CV_I_D, CV_B7 = CV_B6 + CV_I_IN1, CV_B8 = CV_B7 + CV_I_O;
constexpr int CV_NITEMS = CV_B8 + 24 * 7168;
constexpr int CV_C1A = CV_B3 + 10 * 2048, CV_C1 = CV_C1A + 20 * 1024, CV_C2 = CV_C1 + 25 * 2048, CV_C3 = CV_C2 + 10 * 2048, CV_C4 = CV_NITEMS - 8 * 7168, CV_C4A = CV_C4 - 20 * 1280;
static_assert(CV_C1 >= CV_B8 && CV_C4A >= CV_C3 && CV_C4 >= CV_B8 + 16 * 7168, "dense weights are converted before the FFN phase, expert gate/up weights before the expert phase");
__device__ __forceinline__ CvItem cv_decode(const Args& A, int it) {
    unsigned char* ws = A.ws; CvItem c; c.fp8 = 0;
    constexpr int B1 = CV_B1, B2 = CV_B2, B3 = CV_B3, B4 = CV_B4, B5 = CV_B5, B6 = CV_B6, B7 = CV_B7, B8 = CV_B8;
    if (it < B1)      { c.W = (const float*)A.in[3];  c.K = DM; c.N = 1024; c.WT = (bf16*)(ws + WS_WMKV); c.mode = 0; c.loc = it; }
    else if (it < B2) { c.W = (const float*)A.in[4];  c.K = DM; c.N = N_IN0; c.WT = (bf16*)(ws + WS_WIN0); c.mode = 4; c.loc = it - B1; }
    else if (it < B3) { c.W = (const float*)A.in[5];  c.K = DM; c.N = DM; c.WT = (bf16*)(ws + WS_WO0); c.mode = 0; c.loc = it - B2; }
    else if (it < B4) { c.W = (const float*)A.in[8];  c.K = DM; c.N = DFF; c.WT = (bf16*)(ws + WS_WGU0); c.mode = 1; c.loc = it - B3; c.fp8 = 6; }
    else if (it < B5) { c.W = (const float*)A.in[9];  c.K = DM; c.N = DFF; c.WT = (bf16*)(ws + WS_WGU0); c.mode = 2; c.loc = it - B4; c.fp8 = 6; }
    else if (it < B6) { c.W = (const float*)A.in[10]; c.K = DFF; c.N = DM; c.WT = (bf16*)(ws + WS_WD0); c.mode = 0; c.loc = it - B5; c.fp8 = 7; }
    else if (it < B7) { c.W = (const float*)A.in[13]; c.K = DM; c.N = N_IN1_REAL; c.WT = (bf16*)(ws + WS_WIN1); c.mode = 3; c.loc = it - B6; }
    else if (it < B8) { c.W = (const float*)A.in[20]; c.K = DM; c.N = DM; c.WT = (bf16*)(ws + WS_WO1); c.mode = 0; c.loc = it - B7; }
    else { const int r = it - B8, r2 = r / 7168, kind = r2 >> 3, e = r2 & 7; c.loc = r - r2 * 7168;
        if (kind == 0)      { c.W = (const float*)A.in[24] + (size_t)e * DM * DFF; c.K = DM; c.N = DFF; c.WT = (bf16*)(ws + WS_WGUE + (size_t)e * 2 * DFF * DM); c.mode = 1; c.fp8 = 6; }
        else if (kind == 1) { c.W = (const float*)A.in[25] + (size_t)e * DM * DFF; c.K = DM; c.N = DFF; c.WT = (bf16*)(ws + WS_WGUE + (size_t)e * 2 * DFF * DM); c.mode = 2; c.fp8 = 6; }
        else                { c.W = (const float*)A.in[26] + (size_t)e * DFF * DM; c.K = DFF; c.N = DM; c.WT = (bf16*)(ws + WS_WDE + (size_t)e * DM * DFF); c.mode = 0; c.fp8 = 7; } }
    return c;
}
__device__ __forceinline__ void convert_items(Frame& F, const Args& A, int lo_, int hi_, int gwl, int ngwl) {
    LAS float* scr = (LAS float*)(F.lds + RING_OFF + F.wave * 16384);
    int it = lo_ + gwl; if (it >= hi_) return;
    f32x4 va[8], vb[8], vc[8], vd[8];
#define CV_LD(buf, idx) do { if ((idx) < hi_) { const CvItem c_ = cv_decode(A, (idx)); cv_load(c_, buf, F.lane); } } while (0)
#define CV_ST(buf, idx) do { const CvItem c_ = cv_decode(A, (idx)); cv_store(c_, buf, scr, F.lane); } while (0)
    CV_LD(va, it); CV_LD(vb, it + ngwl); CV_LD(vc, it + 2 * ngwl); CV_LD(vd, it + 3 * ngwl);
    for (;;) {
        CV_ST(va, it); CV_LD(va, it + 4 * ngwl); if (it + ngwl >= hi_) break;
        CV_ST(vb, it + ngwl); CV_LD(vb, it + 5 * ngwl); if (it + 2 * ngwl >= hi_) break;
        CV_ST(vc, it + 2 * ngwl); CV_LD(vc, it + 6 * ngwl); if (it + 3 * ngwl >= hi_) break;
        CV_ST(vd, it + 3 * ngwl); CV_LD(vd, it + 7 * ngwl); if (it + 4 * ngwl >= hi_) break;
        it += 4 * ngwl;
    }
#undef CV_LD
#undef CV_ST
}
__device__ __forceinline__ void p0_prologue(Frame& F, const Args& A) {
    unsigned char* ws = A.ws;
    convert_items(F, A, 0, CV_B3, F.gw, F.NGW);
    const int gid = blockIdx.x * 512 + F.tid, NT_ = F.G * 512;
    { const float* x = (const float*)A.in[0]; const float* mem = (const float*)A.in[1]; bf16* xb = (bf16*)(ws + WS_XCURB); bf16* mb = (bf16*)(ws + WS_MEMB);
      constexpr int NX8 = T * DM / 8, NM8 = MEML * DM / 8;
      for (int i0 = gid; i0 < NX8 + NM8; i0 += 4 * NT_) { f32x4 a[4], b[4];
#pragma unroll
          for (int q = 0; q < 4; ++q) { const int i = i0 + q * NT_; const int ic = i < NX8 + NM8 ? i : i0; const bool ix = ic < NX8; const int j = ix ? ic : ic - NX8; const float* s = (ix ? x : mem) + (size_t)j * 8;
              a[q] = __builtin_nontemporal_load((const f32x4*)s); b[q] = __builtin_nontemporal_load((const f32x4*)(s + 4)); }
#pragma unroll
          for (int q = 0; q < 4; ++q) { const int i = i0 + q * NT_; if (i < NX8 + NM8) { const bool ix = i < NX8; const int j = ix ? i : i - NX8;
              v4u o = {pk2(a[q][0], a[q][1]), pk2(a[q][2], a[q][3]), pk2(b[q][0], b[q][1]), pk2(b[q][2], b[q][3])};
              *(v4u*)((ix ? xb : mb) + (size_t)j * 8) = o; } } } }
    { v4u z = {0u, 0u, 0u, 0u}; v4u* p = (v4u*)((bf16*)(ws + WS_WIN1) + (size_t)N_IN1_REAL * DM); constexpr int NZ = (N_IN1 - N_IN1_REAL) * DM / 8;
      for (int i = gid; i < NZ; i += NT_) p[i] = z; }
    { const int* pos = (const int*)A.in[2]; float* rope = (float*)(ws + WS_ROPE);
      for (int i = gid; i < T * 16; i += NT_) { const int t = i >> 4, j = i & 15;
          const float inv = (float)exp(-((double)j / 16.0) * 13.122363377404328);
          const float ang = (float)pos[t] * inv;
          double rev = (double)ang * 0.15915494309189535; rev -= floor(rev);
          const double x = rev * 6.283185307179586; const double q = rint(x * 0.6366197723675814); const double y = x - q * 1.5707963267948966; const double y2 = y * y;
          const double sn = y * (1.0 + y2 * (-1.0 / 6 + y2 * (1.0 / 120 + y2 * (-1.0 / 5040 + y2 * (1.0 / 362880 + y2 * (-1.0 / 39916800 + y2 * (1.0 / 6227020800.0)))))));
          const double cs = 1.0 + y2 * (-0.5 + y2 * (1.0 / 24 + y2 * (-1.0 / 720 + y2 * (1.0 / 40320 + y2 * (-1.0 / 3628800 + y2 * (1.0 / 479001600.0))))));
          const int qi = ((int)q) & 3; double s, c;
          if (qi == 0) { s = sn; c = cs; } else if (qi == 1) { s = cs; c = -sn; } else if (qi == 2) { s = -sn; c = -cs; } else { s = -cs; c = sn; }
          rope[2 * i] = (float)c; rope[2 * i + 1] = (float)s; } }
}

__device__ __forceinline__ void rot8(v4u& a, v4u& b, const float* __restrict__ cs) {
    unsigned ao[4], bo[4]; const unsigned aw[4] = {a.x, a.y, a.z, a.w}, bw[4] = {b.x, b.y, b.z, b.w};
#pragma unroll
    for (int q = 0; q < 4; ++q) { const f32x4 t = *(const f32x4*)(cs + 4 * q);
        const float x1a = bflo(aw[q]), x1b = bfhi(aw[q]), x2a = bflo(bw[q]), x2b = bfhi(bw[q]);
        ao[q] = pk2(x1a * t[0] - x2a * t[1], x1b * t[2] - x2b * t[3]); bo[q] = pk2(x2a * t[0] + x1a * t[1], x2b * t[2] + x1b * t[3]); }
    a = (v4u){ao[0], ao[1], ao[2], ao[3]}; b = (v4u){bo[0], bo[1], bo[2], bo[3]};
}
__device__ __forceinline__ void p2_rotary_kmean(Frame& F, unsigned char* ws) {
    bf16* QKVM = (bf16*)(ws + WS_RB); const float* rope = (const float*)(ws + WS_ROPE); float* KMEAN = (float*)(ws + WS_KMEAN);
    { const int gid = blockIdx.x * 512 + F.tid, NT_ = F.G * 512;
      for (int i = gid; i < T * 24; i += NT_) { const int t = i / 24, r = i - t * 24, h = r >> 1, c = r & 1;
          bf16* p = QKVM + (size_t)t * N_IN0 + h * 128 + 8 * c; v4u a = *(v4u*)p, b = *(v4u*)(p + 16);
          rot8(a, b, rope + ((size_t)t * 16 + 8 * c) * 2); *(v4u*)p = a; *(v4u*)(p + 16) = b; } }
    LAS float* red = (LAS float*)(F.lds);
    for (int it = blockIdx.x; it < 32 * 12; it += F.G) { const int b = it / 12, h = it - b * 12;
        const int rgp = F.tid >> 4, c = F.tid & 15;
        float s[16];
#pragma unroll
        for (int q = 0; q < 16; ++q) s[q] = 0.f;
        if (c < 2 || c >= 4) {
            v4u ra[8], rb[8];
#pragma unroll
            for (int rr = 0; rr < 8; ++rr) { const int t = 256 * b + rgp * 8 + rr; const bf16* p = QKVM + (size_t)t * N_IN0 + 1536 + h * 128 + 8 * c; ra[rr] = *(const v4u*)p; rb[rr] = *(const v4u*)(p + (c < 2 ? 16 : 0)); }
#pragma unroll
            for (int rr = 0; rr < 8; ++rr) { const int t = 256 * b + rgp * 8 + rr; bf16* p = QKVM + (size_t)t * N_IN0 + 1536 + h * 128 + 8 * c;
                v4u a = ra[rr];
                if (c < 2) { v4u bq = rb[rr]; rot8(a, bq, rope + ((size_t)t * 16 + 8 * c) * 2); *(v4u*)p = a; *(v4u*)(p + 16) = bq;
                    s[8] += bflo(bq.x); s[9] += bfhi(bq.x); s[10] += bflo(bq.y); s[11] += bfhi(bq.y); s[12] += bflo(bq.z); s[13] += bfhi(bq.z); s[14] += bflo(bq.w); s[15] += bfhi(bq.w); }
                s[0] += bflo(a.x); s[1] += bfhi(a.x); s[2] += bflo(a.y); s[3] += bfhi(a.y); s[4] += bflo(a.z); s[5] += bfhi(a.z); s[6] += bflo(a.w); s[7] += bfhi(a.w); }
        }
        __syncthreads();
        if (c < 2 || c >= 4) {
#pragma unroll
            for (int q = 0; q < 8; ++q) red[rgp * 128 + 8 * c + q] = s[q];
            if (c < 2) {
#pragma unroll
                for (int q = 0; q < 8; ++q) red[rgp * 128 + 16 + 8 * c + q] = s[8 + q]; }
        }
        __syncthreads();
        if (F.tid < 128) { float a = 0.f;
#pragma unroll
            for (int g = 0; g < 32; ++g) a += red[g * 128 + F.tid];
            KMEAN[(size_t)(h * 32 + b) * 128 + F.tid] = a * (1.0f / 256.0f); }
    }
    __syncthreads();
}

template <bool ROUTER, bool RES_F32, bool X8 = false>
__device__ __forceinline__ void ln_rows(Frame& F, const void* res, const bf16* __restrict__ y, const float* __restrict__ gam, const float* __restrict__ bet,
                                        bf16* outb, const float* __restrict__ wr, int* __restrict__ toke, float* __restrict__ tokw, unsigned char* out8 = nullptr) {
    if (ROUTER) {
        LAS float* wt = (LAS float*)(F.lds);
        f32x4 w8[8];
#pragma unroll
        for (int q = 0; q < 8; ++q) w8[q] = *(const f32x4*)(wr + (size_t)(F.tid + q * 512) * 4);
#pragma unroll
        for (int q = 0; q < 8; ++q) { const int i = F.tid + q * 512; const int d = i >> 1, hf = i & 1;
            wt[(4 * hf + 0) * 2048 + d] = w8[q][0]; wt[(4 * hf + 1) * 2048 + d] = w8[q][1]; wt[(4 * hf + 2) * 2048 + d] = w8[q][2]; wt[(4 * hf + 3) * 2048 + d] = w8[q][3]; }
        __syncthreads();
    }
    f32x4 nx[8]; v2u nxb[8], ny[8];
#define LN_LOAD(row) do { _Pragma("unroll") for (int j = 0; j < 8; ++j) { \
        if (RES_F32) nx[j] = ((const f32x4*)((const float*)res + (size_t)(row) * DM) + F.lane)[64 * j]; else nxb[j] = ((const v2u*)((const bf16*)res + (size_t)(row) * DM) + F.lane)[64 * j]; \
        ny[j] = ((const v2u*)(y + (size_t)(row) * DM) + F.lane)[64 * j]; } } while (0)
    if (F.gw < T) LN_LOAD(F.gw);
    for (int m = F.gw; m < T; m += F.NGW) {
        f32x4 v[8]; float s = 0.f;
#pragma unroll
        for (int j = 0; j < 8; ++j) { const f32x4 xr = RES_F32 ? nx[j] : (f32x4){bflo(nxb[j].x), bfhi(nxb[j].x), bflo(nxb[j].y), bfhi(nxb[j].y)};
            const f32x4 yr = {bflo(ny[j].x), bfhi(ny[j].x), bflo(ny[j].y), bfhi(ny[j].y)};
            v[j] = xr * DN_ALPHA + yr; s += (v[j][0] + v[j][1]) + (v[j][2] + v[j][3]); }
        if (m + F.NGW < T) LN_LOAD(m + F.NGW);
        const float mean = wave_sum(s) * (1.f / DM); float s2 = 0.f;
#pragma unroll
        for (int j = 0; j < 8; ++j) { v[j] = v[j] - mean; s2 += (v[j][0] * v[j][0] + v[j][1] * v[j][1]) + (v[j][2] * v[j][2] + v[j][3] * v[j][3]); }
        const float rstd = 1.f / sqrtf(wave_sum(s2) * (1.f / DM) + LN_EPS);
        v2u* ob = (v2u*)(outb + (size_t)m * DM) + F.lane;
#pragma unroll
        for (int j = 0; j < 8; ++j) { const f32x4 g4 = ((const f32x4*)gam)[F.lane + 64 * j], b4 = ((const f32x4*)bet)[F.lane + 64 * j];
            v[j] = v[j] * rstd * g4 + b4;
            ob[64 * j] = (v2u){pk2(v[j][0], v[j][1]), pk2(v[j][2], v[j][3])};
            if (X8) { int w8_ = 0; w8_ = __builtin_amdgcn_cvt_pk_fp8_f32(v[j][0], v[j][1], w8_, false); w8_ = __builtin_amdgcn_cvt_pk_fp8_f32(v[j][2], v[j][3], w8_, true);
                ((unsigned*)(out8 + (size_t)m * DM))[F.lane + 64 * j] = (unsigned)w8_; } }
        if (ROUTER) {
            float lg[8];
#pragma unroll
            for (int e = 0; e < 8; ++e) lg[e] = 0.f;
            const LAS f32x4* wl = (const LAS f32x4*)(F.lds) + F.lane;
#pragma unroll
            for (int j = 0; j < 8; ++j)
#pragma unroll
                for (int e = 0; e < 8; ++e) { const f32x4 w4 = wl[e * 512 + 64 * j]; lg[e] += (v[j][0] * w4[0] + v[j][1] * w4[1]) + (v[j][2] * w4[2] + v[j][3] * w4[3]); }
#pragma unroll
            for (int e = 0; e < 8; ++e) lg[e] = wave_sum(lg[e]);
            float b0 = lg[0]; int i0 = 0;
#pragma unroll
            for (int e = 1; e < 8; ++e) if (lg[e] > b0) { b0 = lg[e]; i0 = e; }
            float b1 = -__builtin_inff(); int i1 = 0;
#pragma unroll
            for (int e = 0; e < 8; ++e) if (e != i0 && lg[e] > b1) { b1 = lg[e]; i1 = e; }
            if (F.lane == 0) { const float e1 = __expf(b1 - b0); const float w0 = 1.f / (1.f + e1); toke[m] = i0 | (i1 << 8); tokw[2 * m] = w0; tokw[2 * m + 1] = e1 * w0; }
        }
    }
#undef LN_LOAD
}

__device__ __forceinline__ void p10_conv(Frame& F, const Args& A) {
    unsigned char* ws = A.ws; const bf16* H1 = (const bf16*)(ws + WS_RB); bf16* CV = (bf16*)(ws + WS_RC); const float* DTR = (const float*)(ws + WS_DTR); float* ACS = (float*)(ws + WS_ACS);
    const float* cw = (const float*)A.in[14]; const float* cb = (const float*)A.in[15]; const float* dtb = (const float*)A.in[16]; const float* alog = (const float*)A.in[17];
    const int gid = blockIdx.x * 512 + F.tid, NT_ = F.G * 512;
    for (int i = gid; i < (T / 16) * 320; i += NT_) { const int tb = i / 320, cg = i - tb * 320, ch0 = 8 * cg, t0 = 16 * tb;
        v4u xr[19];
#pragma unroll
        for (int r = 0; r < 19; ++r) { const int tt = t0 - 3 + r; const v4u ld_ = *(const v4u*)(H1 + (size_t)(tt < 0 ? 0 : tt) * N_IN1 + 1536 + ch0); xr[r] = (tt >= 0) ? ld_ : (v4u){0u, 0u, 0u, 0u}; }
        float w[4][8], bias[8];
#pragma unroll
        for (int k = 0; k < 4; ++k) { const f32x4 w0 = *(const f32x4*)(cw + k * 2560 + ch0), w1 = *(const f32x4*)(cw + k * 2560 + ch0 + 4);
            w[k][0] = w0[0]; w[k][1] = w0[1]; w[k][2] = w0[2]; w[k][3] = w0[3]; w[k][4] = w1[0]; w[k][5] = w1[1]; w[k][6] = w1[2]; w[k][7] = w1[3]; }
        { const f32x4 b0 = *(const f32x4*)(cb + ch0), b1 = *(const f32x4*)(cb + ch0 + 4);
          bias[0] = b0[0]; bias[1] = b0[1]; bias[2] = b0[2]; bias[3] = b0[3]; bias[4] = b1[0]; bias[5] = b1[1]; bias[6] = b1[2]; bias[7] = b1[3]; }
        const bool isx = ch0 < 1536; const int hd = isx ? (ch0 >> 6) : 0; const float dbias = dtb[hd];
        float dtr[16];
#pragma unroll
        for (int r = 0; r < 16; ++r) dtr[r] = DTR[(size_t)(t0 + r) * 32 + hd];
#pragma unroll
        for (int r = 0; r < 16; ++r) { float acc[8];
#pragma unroll
            for (int q = 0; q < 8; ++q) acc[q] = bias[q];
#pragma unroll
            for (int k = 0; k < 4; ++k) { const v4u xv = xr[r + k];
                acc[0] += w[k][0] * bflo(xv.x); acc[1] += w[k][1] * bfhi(xv.x); acc[2] += w[k][2] * bflo(xv.y); acc[3] += w[k][3] * bfhi(xv.y);
                acc[4] += w[k][4] * bflo(xv.z); acc[5] += w[k][5] * bfhi(xv.z); acc[6] += w[k][6] * bflo(xv.w); acc[7] += w[k][7] * bfhi(xv.w); }
#pragma unroll
            for (int q = 0; q < 8; ++q) acc[q] = silu_f(acc[q]);
            const size_t t = (size_t)(t0 + r);
            *(v4u*)(CV + t * 4096 + ch0) = (v4u){pk2(acc[0], acc[1]), pk2(acc[2], acc[3]), pk2(acc[4], acc[5]), pk2(acc[6], acc[7])};
            if (isx) { const float dt = softplus_f(dtr[r] + dbias);
                *(v4u*)(CV + t * 4096 + 2560 + ch0) = (v4u){pk2(acc[0] * dt, acc[1] * dt), pk2(acc[2] * dt, acc[3] * dt), pk2(acc[4] * dt, acc[5] * dt), pk2(acc[6] * dt, acc[7] * dt)}; }
        }
    }
    for (int it = F.gw; it < 32 * 24; it += F.NGW) { const int c = it / 24, h = it - c * 24; const float a = -__expf(alog[h]); const float bias = dtb[h];
        float v[4]; float run = 0.f;
#pragma unroll
        for (int q = 0; q < 4; ++q) { const int t = 256 * c + 4 * F.lane + q; run += softplus_f(DTR[(size_t)t * 32 + h] + bias) * a; v[q] = run; }
        float incl = run;
#pragma unroll
        for (int o = 1; o < 64; o <<= 1) { const float u = __shfl_up(incl, o); if (F.lane >= o) incl += u; }
        const float excl = incl - run;
        *(f32x4*)(ACS + (size_t)(c * 24 + h) * 256 + 4 * F.lane) = (f32x4){v[0] + excl, v[1] + excl, v[2] + excl, v[3] + excl};
    }
}

__device__ __forceinline__ void p12_scan(Frame& F, unsigned char* ws) {
    const float* __restrict__ STATES = (const float*)(ws + WS_STATES); bf16* __restrict__ PREV = (bf16*)(ws + WS_PREV); const float* __restrict__ ACS = (const float*)(ws + WS_ACS);
    const int gid = blockIdx.x * 512 + F.tid, NT_ = F.G * 512;
    for (int i = gid; i < 24 * 64 * 32; i += NT_) { const int h = i >> 11;
        f32x4 carry = {0.f, 0.f, 0.f, 0.f};
#pragma unroll 8
        for (int c = 0; c < 32; ++c) {
            *(v2u*)(PREV + ((size_t)c * 24 * 64 * 32 + i) * 4) = (v2u){pk2(carry[0], carry[1]), pk2(carry[2], carry[3])};
            const float dec = __expf(ACS[(size_t)(c * 24 + h) * 256 + 255]);
            const f32x4 st = *(const f32x4*)(STATES + ((size_t)c * 24 * 64 * 32 + i) * 4);
            carry = carry * dec + st; }
    }
}

__device__ __forceinline__ void p14_gated_norm(Frame& F, const Args& A) {
    unsigned char* ws = A.ws; const float* YS = (const float*)(ws + WS_YSSD); const bf16* H1 = (const bf16*)(ws + WS_RB); bf16* HEADS = (bf16*)(ws + WS_HEADS); const float* ng = (const float*)A.in[19];
    f32x4 ny[6]; v2u nz[6];
#define GN_LOAD(row) do { _Pragma("unroll") for (int j = 0; j < 6; ++j) { ny[j] = *((const f32x4*)(YS + (size_t)(row) * 1536) + F.lane + 64 * j); nz[j] = *((const v2u*)(H1 + (size_t)(row) * N_IN1) + F.lane + 64 * j); } } while (0)
    if (F.gw < T) GN_LOAD(F.gw);
    for (int m = F.gw; m < T; m += F.NGW) {
        f32x4 v[6]; float s2 = 0.f; f32x4 cy[6]; v2u cz[6];
#pragma unroll
        for (int j = 0; j < 6; ++j) { cy[j] = ny[j]; cz[j] = nz[j]; }
        if (m + F.NGW < T) GN_LOAD(m + F.NGW);
#pragma unroll
        for (int j = 0; j < 6; ++j) { const f32x4 yv = cy[j]; const v2u zz = cz[j];
            v[j] = (f32x4){yv[0] * silu_f(bflo(zz.x)), yv[1] * silu_f(bfhi(zz.x)), yv[2] * silu_f(bflo(zz.y)), yv[3] * silu_f(bfhi(zz.y))};
            s2 += (v[j][0] * v[j][0] + v[j][1] * v[j][1]) + (v[j][2] * v[j][2] + v[j][3] * v[j][3]); }
        const float rstd = 1.f / sqrtf(wave_sum(s2) * (1.f / 1536.f) + RMS_EPS);
#pragma unroll
        for (int j = 0; j < 6; ++j) { const f32x4 g4 = ((const f32x4*)ng)[F.lane + 64 * j]; const f32x4 o = v[j] * rstd * g4;
            *((v2u*)(HEADS + (size_t)m * DM) + F.lane + 64 * j) = (v2u){pk2(o[0], o[1]), pk2(o[2], o[3])}; }
    }
}

__device__ __forceinline__ void p17_sort_gather(Frame& F, unsigned char* ws) {
    const int* TOKE = (const int*)(ws + WS_TOKE); int* POS = (int*)(ws + WS_POS); int* COUNTS = (int*)(ws + WS_COUNTS);
    const bf16* XB = (const bf16*)(ws + WS_XCURB); bf16* XG = (bf16*)(ws + WS_RC);
    LAS unsigned long long* wtot = (LAS unsigned long long*)(F.lds);
    LAS int* posl = (LAS int*)(F.lds + 256);
    int te[16];
    { const int4* p = (const int4*)(TOKE + 16 * F.tid);
#pragma unroll
      for (int q = 0; q < 4; ++q) { const int4 v = p[q]; te[4 * q] = v.x; te[4 * q + 1] = v.y; te[4 * q + 2] = v.z; te[4 * q + 3] = v.w; } }
    unsigned long long ca = 0ull, cb = 0ull;
#pragma unroll
    for (int q = 0; q < 16; ++q) {
#pragma unroll
        for (int k = 0; k < 2; ++k) { const int e = (te[q] >> (8 * k)) & 0xff; const unsigned long long one = 1ull << (16 * (e & 3)); if (e < 4) ca += one; else cb += one; } }
    unsigned long long ia = ca, ib = cb;
#pragma unroll
    for (int o = 1; o < 64; o <<= 1) { const unsigned long long ua = __shfl_up(ia, o), ub = __shfl_up(ib, o); if (F.lane >= o) { ia += ua; ib += ub; } }
    if (F.lane == 63) { wtot[F.wave * 2] = ia; wtot[F.wave * 2 + 1] = ib; }
    __syncthreads();
    unsigned long long pa = 0ull, pb = 0ull, ta = 0ull, tb = 0ull;
#pragma unroll
    for (int w = 0; w < 8; ++w) { const unsigned long long xa = wtot[w * 2], xb = wtot[w * 2 + 1]; if (w < F.wave) { pa += xa; pb += xb; } ta += xa; tb += xb; }
    const unsigned long long ea = pa + ia - ca, eb = pb + ib - cb;
    int cnt[8], pst[8];
#pragma unroll
    for (int e = 0; e < 8; ++e) cnt[e] = (int)(((e < 4 ? ta : tb) >> (16 * (e & 3))) & 0xffffull);
    pst[0] = 0;
#pragma unroll
    for (int e = 1; e < 8; ++e) pst[e] = pst[e - 1] + ((cnt[e - 1] + 255) & ~255);
    if (blockIdx.x == 0 && F.tid < 8) { int c = 0;
#pragma unroll
        for (int e = 0; e < 8; ++e) c = (F.tid == e) ? cnt[e] : c;
        COUNTS[F.tid] = c; }
    const int b = blockIdx.x;
    for (int tb0 = b * 32; tb0 < T; tb0 += F.G * 32) {
        __syncthreads();
        if ((F.tid >> 1) == (tb0 >> 5)) {
            unsigned long long ra = ea, rb = eb;
#pragma unroll
            for (int q = 0; q < 16; ++q) {
#pragma unroll
                for (int k = 0; k < 2; ++k) { const int e = (te[q] >> (8 * k)) & 0xff; const int sh = 16 * (e & 3);
                    const int off = (int)(((e < 4 ? ra : rb) >> sh) & 0xffffull); int ps = 0;
#pragma unroll
                    for (int x = 0; x < 8; ++x) ps = (x == e) ? pst[x] : ps;
                    const int pos = ps + off; if (e < 4) ra += 1ull << sh; else rb += 1ull << sh;
                    const int tok = 16 * F.tid + q; POS[2 * tok + k] = pos; posl[(tok - tb0) * 2 + k] = pos; } }
        }
        __syncthreads();
        for (int i0 = F.tid; i0 < 64 * 256; i0 += 512 * 8) { v4u tmp[8];
#pragma unroll
            for (int q = 0; q < 8; ++q) { const int i = i0 + q * 512; const int r = i >> 8, ch = i & 255; tmp[q] = *((const v4u*)(XB + (size_t)(tb0 + (r >> 1)) * DM) + ch); }
#pragma unroll
            for (int q = 0; q < 8; ++q) { const int i = i0 + q * 512; const int r = i >> 8, ch = i & 255; const v4u t_ = tmp[q]; int w0 = 0, w1 = 0;
                w0 = __builtin_amdgcn_cvt_pk_fp8_f32(bflo(t_.x), bfhi(t_.x), w0, false); w0 = __builtin_amdgcn_cvt_pk_fp8_f32(bflo(t_.y), bfhi(t_.y), w0, true);
                w1 = __builtin_amdgcn_cvt_pk_fp8_f32(bflo(t_.z), bfhi(t_.z), w1, false); w1 = __builtin_amdgcn_cvt_pk_fp8_f32(bflo(t_.w), bfhi(t_.w), w1, true);
                *((v2u*)((unsigned char*)XG + (size_t)posl[r] * DM) + ch) = (v2u){(unsigned)w0, (unsigned)w1}; } }
    }
    __syncthreads();
}

__device__ __forceinline__ void p20_final(Frame& F, const Args& A) {
    unsigned char* ws = A.ws; const bf16* X = (const bf16*)(ws + WS_XCURB); const bf16* YM = (const bf16*)(ws + WS_RB); const int* POS = (const int*)(ws + WS_POS); const float* TOKW = (const float*)(ws + WS_TOKW);
    const float* gam = (const float*)A.in[27]; const float* bet = (const float*)A.in[28]; float* out = A.out;
    v2u nxa[8], nya[8], nyb[8]; float nw0 = 0.f, nw1 = 0.f;
#define FN_LOAD(row) do { const int p0_ = POS[2 * (row)], p1_ = POS[2 * (row) + 1]; nw0 = TOKW[2 * (row)]; nw1 = TOKW[2 * (row) + 1]; \
        const v2u* xr_ = (const v2u*)(X + (size_t)(row) * DM) + F.lane; const v2u* y0_ = (const v2u*)(YM + (size_t)p0_ * DM) + F.lane; const v2u* y1_ = (const v2u*)(YM + (size_t)p1_ * DM) + F.lane; \
        _Pragma("unroll") for (int j = 0; j < 8; ++j) { nxa[j] = xr_[64 * j]; nya[j] = y0_[64 * j]; nyb[j] = y1_[64 * j]; } } while (0)
    if (F.gw < T) FN_LOAD(F.gw);
    for (int m = F.gw; m < T; m += F.NGW) {
        const float w0 = nw0, w1 = nw1;
        v2u xa[8], ya[8], yb[8];
#pragma unroll
        for (int j = 0; j < 8; ++j) { xa[j] = nxa[j]; ya[j] = nya[j]; yb[j] = nyb[j]; }
        if (m + F.NGW < T) FN_LOAD(m + F.NGW);
        f32x4 v[8]; float s = 0.f;
#pragma unroll
        for (int j = 0; j < 8; ++j) { const f32x4 xv = {bflo(xa[j].x), bfhi(xa[j].x), bflo(xa[j].y), bfhi(xa[j].y)}, a = {bflo(ya[j].x), bfhi(ya[j].x), bflo(ya[j].y), bfhi(ya[j].y)}, b = {bflo(yb[j].x), bfhi(yb[j].x), bflo(yb[j].y), bfhi(yb[j].y)};
            v[j] = xv * DN_ALPHA + (a * w0 + b * w1); s += (v[j][0] + v[j][1]) + (v[j][2] + v[j][3]); }
        const float mean = wave_sum(s) * (1.f / DM); float s2 = 0.f;
#pragma unroll
        for (int j = 0; j < 8; ++j) { v[j] = v[j] - mean; s2 += (v[j][0] * v[j][0] + v[j][1] * v[j][1]) + (v[j][2] * v[j][2] + v[j][3] * v[j][3]); }
        const float rstd = 1.f / sqrtf(wave_sum(s2) * (1.f / DM) + LN_EPS);
        f32x4* of = (f32x4*)(out + (size_t)m * DM) + F.lane;
#pragma unroll
        for (int j = 0; j < 8; ++j) { const f32x4 g4 = ((const f32x4*)gam)[F.lane + 64 * j], b4 = ((const f32x4*)bet)[F.lane + 64 * j]; of[64 * j] = v[j] * rstd * g4 + b4; }
    }
}
__global__ void __launch_bounds__(NWAVES * 64, 2) mega_fwd(Args args) {
    extern __shared__ __attribute__((aligned(16))) unsigned char lds[];
    Frame F;
    F.lds = (LAS unsigned char*)lds; F.ldsg = (char*)lds;
    F.MISC = (volatile LAS unsigned*)(F.lds + MISC_OFF);
    F.tid = threadIdx.x; F.lane = F.tid & 63; F.wave = __builtin_amdgcn_readfirstlane(F.tid >> 6); const int wid_s = F.wave;
#define FRESH_TID(var) int var = fresh_tid()
    F.G = gridDim.x; F.gw = blockIdx.x * NWAVES + F.wave; F.NGW = F.G * NWAVES;
    unsigned char* ws = args.ws;
    F.ctl = (gu32*)(ws + WS_CTL);
    for (int u = F.tid; u < (LDS_BYTES - LDSCTL_OFF) / 4; u += NWAVES * 64) ((LAS unsigned*)(F.lds + LDSCTL_OFF))[u] = 0u;
    __syncthreads();
    if (F.lane == 0) ((LAS int*)(F.lds + WTAB_OFF))[(unsigned)__builtin_amdgcn_s_getreg((5 << 11) | 4) & 63u] = wid_s;
    __syncthreads();
#if MK_PER_PHASE
#define GRID_BAR() do { } while (0)
#else
    XcdBarrier bar = xcd_barrier_post((unsigned*)(F.ctl + CW_BAR), F.MISC + 8, wid_s);
#define GRID_BAR() xcd_barrier(bar)
#endif
#ifndef PROBE_PHASE
#define PROBE_PHASE -1
#endif
#ifndef PROBE_REPS
#define PROBE_REPS 2
#endif
#define REPS(k) (((k) == PROBE_PHASE) ? PROBE_REPS : 1)
#define HOSTED_GEMM(EPI, RW, CLO, CMID, CHI, WLO) HOSTED_GEMM_O(EPI, pg8::StaticOrder, RW, CLO, CMID, CHI, WLO)
#define HOSTED_GEMM_O(EPI, ORD, RW, CLO, CMID, CHI, WLO) do { const int rw_ = (RW); \
        pg8::RangeOrder<ORD> R1_{S, 0, rw_}, R2_{S, rw_, 1 << 20}; \
        pg8::gemm_phase<EPI, pg8::RangeOrder<ORD>, true, true>(F.lds + RING_OFF, g, R1_, E); \
        { FRESH_TID(tx_); F.tid = tx_; F.lane = tx_ & 63; F.wave = wid_s; F.gw = blockIdx.x * NWAVES + F.wave; } \
        __syncthreads(); convert_items(F, args, (CLO), (CMID), F.gw, F.NGW); \
        if ((int)blockIdx.x >= (WLO)) convert_items(F, args, (CMID), (CHI), F.gw - (WLO) * NWAVES, F.NGW - (WLO) * NWAVES); \
        __syncthreads(); \
        pg8::gemm_phase<EPI, pg8::RangeOrder<ORD>, true, true>(F.lds + RING_OFF, g, R2_, E); } while (0)
#define HOSTED_GEMM8(EPI, SC, RW, CLO, CMID, CHI, WLO) HOSTED_GEMM8_O(EPI, pg8::StaticOrder, SC, RW, CLO, CMID, CHI, WLO)
#define HOSTED_GEMM8_O(EPI, ORD, SC, RW, CLO, CMID, CHI, WLO) do { const int rw_ = (RW);     \
        pg8::RangeOrder<ORD> R1_{S, 0, rw_}, R2_{S, rw_, 1 << 20}; \
        { FRESH_TID(t8_); pg8::gemm_phase<EPI, pg8::RangeOrder<ORD>, true, true, SC>(F.lds + RING_OFF, g, R1_, E, t8_); } \
        { FRESH_TID(tx_); F.tid = tx_; F.lane = tx_ & 63; F.wave = wid_s; F.gw = blockIdx.x * NWAVES + F.wave; } \
        __syncthreads(); convert_items(F, args, (CLO), (CMID), F.gw, F.NGW); \
        if ((int)blockIdx.x >= (WLO)) convert_items(F, args, (CMID), (CHI), F.gw - (WLO) * NWAVES, F.NGW - (WLO) * NWAVES); \
        __syncthreads(); \
        { FRESH_TID(t8_); pg8::gemm_phase<EPI, pg8::RangeOrder<ORD>, true, true, SC>(F.lds + RING_OFF, g, R2_, E, t8_); } \
        { FRESH_TID(tx_); F.tid = tx_; F.lane = tx_ & 63; F.wave = wid_s; F.gw = blockIdx.x * NWAVES + F.wave; } } while (0)
    const int lo = args.ph_lo, hi = args.ph_hi;
#define IN(k) (lo <= (k) && (k) < hi)
#define REFRAME() { FRESH_TID(tx_); F.tid = tx_; F.lane = tx_ & 63; F.wave = wid_s; F.gw = blockIdx.x * NWAVES + F.wave; }
#define SEAM(k) do { if (IN(k) && IN((k) + 1)) GRID_BAR(); REFRAME(); } while (0)
    bf16* const XCURB = (bf16*)(ws + WS_XCURB); bf16* const YB = (bf16*)(ws + WS_YF); bf16* const HEADS = (bf16*)(ws + WS_HEADS); float* const YF = (float*)(ws + WS_YF);
    bf16* const QKVM = (bf16*)(ws + WS_RB); bf16* const H1 = (bf16*)(ws + WS_RB); bf16* const MEMKV = (bf16*)(ws + WS_MEMKV);

    if (IN(0)) for (int rep_ = 0; rep_ < REPS(0); ++rep_) { if (rep_) GRID_BAR(); p0_prologue(F, args); } SEAM(0);

    if (IN(1)) {
        { pg8::Gemm g{XCURB, (const bf16*)(ws + WS_WIN0), T, N_IN0, DM, DM}; pg8::StaticOrder S; S.init(T, N_IN0, F.G, (int)blockIdx.x);
          pg8::EpiQKV E{QKVM, N_IN0, (const float*)(ws + WS_ROPE), (float*)(ws + WS_KMEAN)};
          HOSTED_GEMM(pg8::EpiQKV, (int)(blockIdx.x % 3), CV_B3, CV_C1A, CV_C1, 128); }
        { pg8::Gemm g{(const bf16*)(ws + WS_MEMB), (const bf16*)(ws + WS_WMKV), MEML, 1024, DM, DM}; pg8::StaticOrder S; S.init(MEML, 1024, F.G, (int)((blockIdx.x + 4) % F.G));
          pg8::EpiBf16<0> E{MEMKV, 1024, nullptr, 0, 0, 1.f};
          pg8::gemm_phase<pg8::EpiBf16<0>, pg8::StaticOrder, true, true>(F.lds + RING_OFF, g, S, E); }
    } SEAM(1);


    if (IN(3)) {
        const float* KMEAN = (const float*)(ws + WS_KMEAN);
        for (int u = blockIdx.x; u < 384; u += F.G) { const int b = u / 12, h = u % 12;
            att::moba_gate_unit(QKVM + (size_t)(256 * b) * N_IN0 + h * 128, KMEAN + (size_t)h * 32 * 256, b, h, (unsigned*)(ws + WS_ROWMASK), (unsigned char*)(ws + WS_SEG), (int*)(ws + WS_CNT), F.ldsg); }
    } SEAM(3);

    if (IN(4)) {
        const unsigned* ROWMASK = (const unsigned*)(ws + WS_ROWMASK); const unsigned char* SEG = (const unsigned char*)(ws + WS_SEG); const int* CNT = (const int*)(ws + WS_CNT);
        bf16* PARTO = (bf16*)(ws + WS_RA); float* PARTML = (float*)(ws + WS_RA + 128 * MiB);
        char* scr = F.ldsg + 132096;
        LAS int* ipre = (LAS int*)(F.lds + 135168);
        int* segp = (int*)(F.ldsg + 137216);
        { int ng = 0;
          if (F.tid < 384) { const int j = F.tid & 31; int tot = 0; const int4* cp = (const int4*)(CNT + F.tid * 32); int4 cv[8];
#pragma unroll
              for (int q = 0; q < 8; ++q) cv[q] = cp[q];
#pragma unroll
              for (int q = 0; q < 8; ++q) { tot += (4 * q + 0 > j ? cv[q].x : 0) + (4 * q + 1 > j ? cv[q].y : 0) + (4 * q + 2 > j ? cv[q].z : 0) + (4 * q + 3 > j ? cv[q].w : 0); }
              ng = (256 + tot + 511) >> 9; }
          int incl = ng;
#pragma unroll
          for (int o = 1; o < 64; o <<= 1) { const int v = __shfl_up(incl, o); if (F.lane >= o) incl += v; }
          if (F.lane == 63) ipre[400 + F.wave] = incl;
          __syncthreads();
          int wbase = 0;
#pragma unroll
          for (int w = 0; w < 8; ++w) wbase += (w < F.wave) ? ipre[400 + w] : 0;
          if (F.tid < 384) ipre[F.tid + 1] = wbase + incl;
          if (F.tid == 0) ipre[0] = 0;
          __syncthreads(); }
        const int NIG = ipre[384];
#pragma nounroll
        for (int it = blockIdx.x; it < NIG; it += F.G) {
            int lo_ = 0, hi_ = 384;
            while (hi_ - lo_ > 1) { const int mid = (lo_ + hi_) >> 1; if (ipre[mid] <= it) lo_ = mid; else hi_ = mid; }
            const int hj = lo_, h = hj >> 5, j = hj & 31, chunk = it - ipre[hj];
            __syncthreads();
            if (F.tid < 64) { const int b = F.tid; const int c = (b > j && b < 32) ? CNT[hj * 32 + b] : 0; int incl = c;
#pragma unroll
                for (int o = 1; o < 64; o <<= 1) { const int v = __shfl_up(incl, o); if (F.lane >= o) incl += v; }
                if (b < 33) segp[b] = incl - c; }
            __syncthreads();
            const int R = 256 + segp[32]; const int row0 = chunk * 512; const int rowend = (row0 + 512 < R) ? row0 + 512 : R;
            att::moba_kv_item(QKVM, h, j, row0, rowend, segp, ROWMASK, SEG, PARTO, PARTML, F.ldsg, scr);
        }
#pragma nounroll
        for (int m = blockIdx.x; m < 128; m += F.G) { const int mh = m & 3, qb = m >> 2;
            att::attn_unit<false, N_IN0, 1024, DM>(QKVM + (size_t)(256 * qb) * N_IN0 + 4608 + mh * 128, MEMKV + mh * 128, MEMKV + 512 + mh * 128, HEADS + (size_t)(256 * qb) * DM + 1536 + mh * 128,
                                                   4, 0, nullptr, F.ldsg); }
    } SEAM(4);

    if (IN(5)) {
        const unsigned* ROWMASK = (const unsigned*)(ws + WS_ROWMASK); const bf16* PARTO = (const bf16*)(ws + WS_RA); const float* PARTML = (const float*)(ws + WS_RA + 128 * MiB);
        constexpr float C = 0.088388347648318440f * 1.4426950408889634f;
        const int gid = blockIdx.x * 512 + F.tid, NT_ = F.G * 512;
        for (int i = gid; i < T * 12 * 16; i += NT_) { const int th = i >> 4, c = i & 15; const int t = th / 12, h = th - t * 12;
            const unsigned rmask = ROWMASK[th];
            const float2* ml = (const float2*)PARTML + (size_t)th * 4; const v4u* po = (const v4u*)(PARTO + (size_t)th * 512) + c;
            float2 ms[4]; v4u pv[4];
#pragma unroll
            for (int s = 0; s < 4; ++s) { ms[s] = ml[s]; pv[s] = po[s * 16]; }
            const int cnt = __popc(rmask);
            float M = ms[3].x;
#pragma unroll
            for (int s = 0; s < 3; ++s) M = (s < cnt) ? fmaxf(M, ms[s].x) : M;
            float den = 0.f; float acc[8];
#pragma unroll
            for (int q = 0; q < 8; ++q) acc[q] = 0.f;
#pragma unroll
            for (int s = 0; s < 4; ++s) { const bool use = (s == 3) || (s < cnt); const float w = use ? ms[s].y * __builtin_amdgcn_exp2f((ms[s].x - M) * C) : 0.f; den += w; const v4u v = pv[s];
                acc[0] += use ? bflo(v.x) * w : 0.f; acc[1] += use ? bfhi(v.x) * w : 0.f; acc[2] += use ? bflo(v.y) * w : 0.f; acc[3] += use ? bfhi(v.y) * w : 0.f;
                acc[4] += use ? bflo(v.z) * w : 0.f; acc[5] += use ? bfhi(v.z) * w : 0.f; acc[6] += use ? bflo(v.w) * w : 0.f; acc[7] += use ? bfhi(v.w) * w : 0.f; }
            const float rd = 1.0f / den;
            *((v4u*)(HEADS + (size_t)t * DM + h * 128) + c) = (v4u){pk2(acc[0] * rd, acc[1] * rd), pk2(acc[2] * rd, acc[3] * rd), pk2(acc[4] * rd, acc[5] * rd), pk2(acc[6] * rd, acc[7] * rd)}; }
    } SEAM(5);

    if (IN(6)) for (int rep_ = 0; rep_ < REPS(6); ++rep_) { if (rep_) GRID_BAR(); pg8::Gemm g{HEADS, (const bf16*)(ws + WS_WO0), T, DM, DM, DM}; pg8::StaticOrder S; S.init(T, DM, F.G, (int)blockIdx.x);
        pg8::EpiBf16<0> E{YB, DM, nullptr, 0, 0, 1.f};
        pg8::gemm_phase<pg8::EpiBf16<0>, pg8::StaticOrder, true, true>(F.lds + RING_OFF, g, S, E); } SEAM(6);

    if (IN(7)) { ln_rows<false, true, true>(F, args.in[0], YB, (const float*)args.in[6], (const float*)args.in[7], XCURB, nullptr, nullptr, nullptr, ws + WS_XCUR); } SEAM(7);

    { FRESH_TID(tx_); F.tid = tx_; F.lane = tx_ & 63; F.wave = wid_s; F.gw = blockIdx.x * NWAVES + F.wave; }
    if (IN(8)) for (int rep_ = 0; rep_ < REPS(8); ++rep_) { if (rep_) GRID_BAR(); pg8::Gemm g{(const bf16*)(ws + WS_XCUR), (const bf16*)(ws + WS_WGU0), T, 2 * DFF, DM / 2, DM / 2}; pg8::StaticOrder S; S.init(T, 2 * DFF, F.G, (int)blockIdx.x);
        pg8::EpiSwiGLU8 E{ws + WS_RA, DFF};
        HOSTED_GEMM8(pg8::EpiSwiGLU8, 124, (int)(blockIdx.x & 7), CV_C1, CV_C2, CV_C2, 0); } SEAM(8);

    if (IN(9)) for (int rep_ = 0; rep_ < REPS(9); ++rep_) { if (rep_) GRID_BAR(); pg8::Gemm g{(const bf16*)(ws + WS_RA), (const bf16*)(ws + WS_WD0), T, DM, DFF / 2, DFF / 2}; pg8::StaticOrder S; S.init(T, DM, F.G, (int)blockIdx.x);
        pg8::EpiBf16<0> E{YB, DM, nullptr, 0, 0, 1.f};
        HOSTED_GEMM8(pg8::EpiBf16<0>, 122, (int)(blockIdx.x & 1), CV_C2, CV_C3, CV_C3, 0); } SEAM(9);

    if (IN(10)) { ln_rows<false, false>(F, XCURB, YB, (const float*)args.in[11], (const float*)args.in[12], XCURB, nullptr, nullptr, nullptr); } SEAM(10);

    if (IN(11)) { pg8::Gemm g{XCURB, (const bf16*)(ws + WS_WIN1), T, N_IN1, DM, DM}; pg8::StaticOrder S; S.init(T, N_IN1, F.G, (int)blockIdx.x);
        pg8::EpiIn1 E{H1, N_IN1, (float*)(ws + WS_DTR), 18};
        HOSTED_GEMM(pg8::EpiIn1, (int)(blockIdx.x % 3), CV_C3, CV_C4A, CV_C4, 96); } SEAM(11);

    if (IN(12)) { p10_conv(F, args); } SEAM(12);

    if (IN(13)) {
        const bf16* CV = (const bf16*)(ws + WS_RC); const float* ACS = (const float*)(ws + WS_ACS); float* STATES = (float*)(ws + WS_STATES);
        for (int u = blockIdx.x; u < 32 * 24; u += F.G) att::ssd_state_unit2(CV, ACS, STATES, u / 24, u % 24, F.ldsg, (float*)(F.ldsg + 132096));
        for (int m = blockIdx.x; m < 128; m += F.G) { const int mh = m & 3, qb = m >> 2;
            att::attn_unit<false, N_IN1, 1024, DM>(H1 + (size_t)(256 * qb) * N_IN1 + 4096 + mh * 128, MEMKV + mh * 128, MEMKV + 512 + mh * 128, HEADS + (size_t)(256 * qb) * DM + 1536 + mh * 128,
                                  4, 0, nullptr, F.ldsg); }
    } SEAM(13);

    if (IN(14)) { p12_scan(F, ws); } SEAM(14);

    if (IN(15)) { const bf16* CV = (const bf16*)(ws + WS_RC); const float* ACS = (const float*)(ws + WS_ACS); const bf16* PREV = (const bf16*)(ws + WS_PREV); const float* dsk = (const float*)args.in[18];
        att::ssd_y_units(CV, ACS, PREV, dsk, (float*)(ws + WS_YSSD), (int)blockIdx.x, F.G, F.ldsg, (float*)(F.ldsg + 132096)); } SEAM(15);

    if (IN(16)) { p14_gated_norm(F, args); } SEAM(16);

    if (IN(17)) { pg8::Gemm g{HEADS, (const bf16*)(ws + WS_WO1), T, DM, DM, DM}; pg8::StaticOrder S; S.init(T, DM, F.G, (int)blockIdx.x);
        pg8::EpiBf16<0> E{YB, DM, nullptr, 0, 0, 1.f};
        pg8::gemm_phase<pg8::EpiBf16<0>, pg8::StaticOrder, true, true>(F.lds + RING_OFF, g, S, E); } SEAM(17);

    if (IN(18)) { ln_rows<true, false>(F, XCURB, YB, (const float*)args.in[21], (const float*)args.in[22], XCURB, (const float*)args.in[23], (int*)(ws + WS_TOKE), (float*)(ws + WS_TOKW)); } SEAM(18);

    if (IN(19)) { p17_sort_gather(F, ws); } SEAM(19);

    { FRESH_TID(tx_); F.tid = tx_; F.lane = tx_ & 63; F.wave = wid_s; F.gw = blockIdx.x * NWAVES + F.wave; }
    if (IN(20)) for (int rep_ = 0; rep_ < REPS(20); ++rep_) { if (rep_) GRID_BAR(); int cnt[8];
#pragma unroll
        for (int e = 0; e < 8; ++e) cnt[e] = __builtin_amdgcn_readfirstlane(((const int*)(ws + WS_COUNTS))[e]);
        pg8::MoeOrder S; S.init(cnt, 56, F.G, (int)blockIdx.x, 1 << 20);
        pg8::Gemm g{(const bf16*)(ws + WS_RC), (const bf16*)(ws + WS_WGUE), MOE_ROWS, 8 * 2 * DFF, DM / 2, DM / 2};
        pg8::EpiSwiGLU8 E{ws + WS_RA, DFF};
        HOSTED_GEMM8_O(pg8::EpiSwiGLU8, pg8::MoeOrder, 124, (int)(blockIdx.x % 13) + 1, CV_C4, CV_NITEMS, CV_NITEMS, 0); } SEAM(20);

    { FRESH_TID(tx_); F.tid = tx_; F.lane = tx_ & 63; F.wave = wid_s; F.gw = blockIdx.x * NWAVES + F.wave; }
    if (IN(21)) for (int rep_ = 0; rep_ < REPS(21); ++rep_) { if (rep_) GRID_BAR(); int cnt[8];
#pragma unroll
        for (int e = 0; e < 8; ++e) cnt[e] = __builtin_amdgcn_readfirstlane(((const int*)(ws + WS_COUNTS))[e]);
        pg8::MoeOrder S; S.init(cnt, 8, F.G, (int)blockIdx.x, 2);
        { pg8::Gemm g{(const bf16*)(ws + WS_RA), (const bf16*)(ws + WS_WDE), MOE_ROWS, 8 * DM, DFF / 2, DFF / 2};
          pg8::EpiBf16Mod E{(bf16*)(ws + WS_RB), DM};
          { FRESH_TID(t8_); pg8::gemm_phase<pg8::EpiBf16Mod, pg8::MoeOrder, true, true, 122>(F.lds + RING_OFF, g, S, E, t8_); } }
        const int rem = S.per - 2 * (F.G >> 3);
        if (rem > 0) { const int SP = rem <= 4 ? 7 : 4;

          pg8::MoeSplitOrder S2; S2.init(S, 2, SP, DFF / 2);
          pg8::Gemm g{(const bf16*)(ws + WS_RA), (const bf16*)(ws + WS_WDE), MOE_ROWS, 8 * DM, DFF / 2 / SP, DFF / 2};
          pg8::EpiF32Mod E{(float*)(ws + WS_YF), 256};
          { FRESH_TID(t8_); pg8::gemm_phase<pg8::EpiF32Mod, pg8::MoeSplitOrder, true, true, 122>(F.lds + RING_OFF, g, S2, E, t8_); } } } SEAM(21);

    if (IN(22)) { int cnt[8];
#pragma unroll
        for (int e = 0; e < 8; ++e) cnt[e] = __builtin_amdgcn_readfirstlane(((const int*)(ws + WS_COUNTS))[e]);
        pg8::MoeOrder S; S.init(cnt, 8, F.G, (int)blockIdx.x, 2);
        const int rem = S.per - 2 * (F.G >> 3); const int SP = rem <= 4 ? 7 : 4;
          bf16* YM = (bf16*)(ws + WS_RB); const float* YF = (const float*)(ws + WS_YF);
        for (int it = blockIdx.x; it < 8 * rem * 4; it += F.G) { const int x = it / (4 * rem), r2 = it - x * 4 * rem, u = r2 >> 2, qt = r2 & 3;
            pg8::Unit un; S.decode(x * S.per + 2 * (F.G >> 3) + u, un);
            const float* pp = YF + (size_t)(x * 32 + u * SP) * 65536 + qt * 64 * 256; bf16* op = YM + (size_t)(un.opm * 256 + qt * 64) * DM + un.opn * 256;
            for (int i = F.tid; i < 64 * 64; i += NWAVES * 64) { const int r = i >> 6, c4 = i & 63; const float* q = pp + r * 256 + c4 * 4; f32x4 a;
                if (SP == 7) { f32x4 x[7];
#pragma unroll
                    for (int s = 0; s < 7; ++s) x[s] = *(const f32x4*)(q + (size_t)s * 65536);
                    a = ((x[0] + x[1]) + (x[2] + x[3])) + ((x[4] + x[5]) + x[6]); }
                else { f32x4 x[4];
#pragma unroll
                    for (int s = 0; s < 4; ++s) x[s] = *(const f32x4*)(q + (size_t)s * 65536);
                    a = (x[0] + x[1]) + (x[2] + x[3]); }
                *(v2u*)(op + (size_t)r * DM + c4 * 4) = (v2u){pk2(a[0], a[1]), pk2(a[2], a[3])}; } }
    } SEAM(22);


    if (IN(23)) { p20_final(F, args); }
#undef IN
#undef SEAM
#undef GRID_BAR
}

extern "C" void kernel_launch(void* const* d_in, const int* in_sizes, int n_in, void* d_out, int out_size, void* d_ws, size_t ws_size, hipStream_t stream) {
    static int grid = 0;
    if (grid == 0) {
        if (n_in != 29 || in_sizes[0] != T * DM || out_size != T * DM || ws_size < WS_END) {
            fprintf(stderr, "kernel_launch: unexpected shapes: n_in %d in0 %d out %d ws %zu (need %zu)\n", n_in, n_in > 0 ? in_sizes[0] : -1, out_size, ws_size, (size_t)WS_END); grid = -1; return; }
        int dev = 0, cus = 0, per_cu = 0;
        if (hipGetDevice(&dev) != hipSuccess || hipDeviceGetAttribute(&cus, hipDeviceAttributeMultiprocessorCount, dev) != hipSuccess) { grid = -1; return; }
        if (hipFuncSetAttribute((const void*)mega_fwd, hipFuncAttributeMaxDynamicSharedMemorySize, LDS_BYTES) != hipSuccess) { fprintf(stderr, "kernel_launch: hipFuncSetAttribute failed\n"); grid = -1; return; }
        if (hipOccupancyMaxActiveBlocksPerMultiprocessor(&per_cu, (const void*)mega_fwd, NWAVES * 64, LDS_BYTES) != hipSuccess || per_cu < 1)
            fprintf(stderr, "kernel_launch: occupancy query reports %d workgroups per CU\n", per_cu);
        (void)hipGetLastError();
        grid = cus;
    }
    if (grid < 0) return;
    if (hipMemsetAsync((char*)d_ws + WS_CTL, 0, CTL_ZERO_BYTES, stream) != hipSuccess) return;
    Args a{};
    for (int i = 0; i < 29; ++i) a.in[i] = d_in[i];
    a.out = (float*)d_out; a.ws = (unsigned char*)d_ws;
#if MK_PER_PHASE
    for (int p = 0; p < NPHASE; ++p) { a.ph_lo = p; a.ph_hi = p + 1; hipLaunchKernelGGL(mega_fwd, dim3(grid), dim3(NWAVES * 64), LDS_BYTES, stream, a); }
#else
    a.ph_lo = 0; a.ph_hi = NPHASE;
    hipLaunchKernelGGL(mega_fwd, dim3(grid), dim3(NWAVES * 64), LDS_BYTES, stream, a);
#endif
    const hipError_t le = hipPeekAtLastError();
    if (le != hipSuccess) fprintf(stderr, "kernel_launch: launch failed: %s\n", hipGetErrorName(le));
}
```

```cpp
#include <hip/hip_runtime.h>
#include <cstdio>
#include <cstdint>
#include <cmath>
constexpr int WTAB_OFF = 131072 + 512;
__device__ __forceinline__ int fresh_tid() {
    extern __shared__ __attribute__((aligned(16))) unsigned char lds_dyn_[];
    unsigned z_; asm volatile("s_mov_b32 %0, 0" : "=s"(z_));
    const unsigned key = (unsigned)__builtin_amdgcn_s_getreg((5 << 11) | 4) & 63u;
    const int wid = __builtin_amdgcn_readfirstlane(((const __attribute__((address_space(3))) int*)((__attribute__((address_space(3))) unsigned char*)lds_dyn_ + WTAB_OFF))[key + z_]);
    return wid * 64 + (int)__builtin_amdgcn_mbcnt_hi(~0u, __builtin_amdgcn_mbcnt_lo(~0u, z_));
}
namespace pg8 {
#define PG8_LAS __attribute__((address_space(3)))
typedef unsigned short bf16_t;
typedef short bf16x8 __attribute__((ext_vector_type(8)));
typedef float f32x4 __attribute__((ext_vector_type(4)));
typedef unsigned u32x4 __attribute__((ext_vector_type(4)));
constexpr int BM = 256, BK = 64, HALF = 128, HTB = HALF * BK * 2  , STAGE_BYTES = 8 * HTB, NXCD = 8, WGM = 8;

__host__ __device__ __forceinline__ int lds_byte(int r, int c) { const int st = (r >> 4) * 2 + (c >> 5), rr = r & 15, cc = c & 31, ob = rr * 64 + cc * 2; return st * 1024 + (ob ^ (((ob >> 9) & 1) << 5)); }
__host__ __device__ __forceinline__ void stage_rc(int b, int& R, int& C) { const int st = b / 1024, sb = b % 1024, swz = sb ^ (((sb >> 9) & 1) << 5); R = (st >> 1) * 16 + swz / 64; C = (st & 1) * 32 + (swz % 64) / 2; }
__host__ __device__ __forceinline__ int perm32(int rho) { const int n = rho >> 4, i = rho & 15; return 8 * (i >> 2) + 4 * n + (i & 3); }

struct Unit { int pm, pn, kofs, opm, opn; };
struct Gemm { const bf16_t* A; const bf16_t* Bt; int M, N, K, ld; };

struct StaticOrder {
    int nM, nN, nwg, G, c;
    __host__ __device__ void init(int M, int N, int G_, int c_) { nM = M / BM; nN = N / BM; nwg = nM * nN; G = G_; c = c_; }
    __host__ __device__ bool next(int i, Unit& u) const {
        const long L = (long)i * G + c; if (L >= nwg) return false;
        int wgid = (int)L; { const int q = nwg / NXCD, r = nwg % NXCD, xcd = wgid % NXCD, off = wgid / NXCD; wgid = (xcd < r ? xcd * (q + 1) : r * (q + 1) + (xcd - r) * q) + off; }
        const int nig = WGM * nN, gid = wgid / nig, fm = gid * WGM, gsz = (nM - fm) < WGM ? (nM - fm) : WGM;
        u.pm = fm + ((wgid % nig) % gsz); u.pn = (wgid % nig) / gsz; u.kofs = 0; u.opm = u.pm; u.opn = u.pn; return true;
    }
    __device__ __forceinline__ void a_ready(const Unit&) const {}
    __device__ __forceinline__ void done(const Unit&) const {}
};

__device__ __forceinline__ unsigned cvt_pk_bf16(float lo, float hi) { unsigned r; asm volatile("v_cvt_pk_bf16_f32 %0, %1, %2" : "=v"(r) : "v"(lo), "v"(hi)); return r; }
typedef float f32x2 __attribute__((ext_vector_type(2)));
__device__ __forceinline__ f32x2 gelu_pk(f32x2 v) {
    const f32x2 av = __builtin_elementwise_abs(v), d = av * 0.2316418882f + 1.0f;
    f32x2 t; t.x = __builtin_amdgcn_rcpf(d.x); t.y = __builtin_amdgcn_rcpf(d.y);
    f32x2 q = t * 0.5307027145f + (-0.7265760135f); q = q * t + 0.7107068705f; q = q * t + (-0.142248368f); q = q * t + 0.127414796f; q = q * t;
    const f32x2 s = (v * v) * (-0.72134752044f);
    f32x2 e; e.x = __builtin_amdgcn_exp2f(s.x); e.y = __builtin_amdgcn_exp2f(s.y);
    const f32x2 m = v * (q * e), r = v - m;
    f32x2 o; o.x = v.x < 0.f ? m.x : r.x; o.y = v.y < 0.f ? m.y : r.y; return o;
}

template <int ACT  > struct EpiBf16 {
    static constexpr bool PERM = true, AFTER_DRAIN = false; static_assert(ACT == 0 || ACT == 1, "EpiBf16: ACT is 0 (none) or 1 (gelu_pk)");
    bf16_t* O; int ldc; const float* bias; int split_cols; size_t split_stride; float scale0;
    __device__ __forceinline__ void operator()(const f32x4 (&acc)[2][2][4][2], const Unit& u, int wr, int wc, int fr, int fq) const {
        const int row0 = u.pm * BM + wr * 64 + fr; int colt = u.pn * BM; bf16_t* base = O;
        float sc = 1.f; if (split_cols) { const int t = colt / split_cols; base += (size_t)t * split_stride; colt -= t * split_cols; if (t == 0) sc = scale0; }
        const int col0 = colt + wc * 32 + 8 * fq, bcol0 = u.pn * BM + wc * 32 + 8 * fq;
        f32x4 bv[2][2];
#pragma unroll
        for (int bj = 0; bj < 2; ++bj)
#pragma unroll
            for (int n = 0; n < 2; ++n) bv[bj][n] = bias ? *(const f32x4*)(bias + bcol0 + bj * HALF + 4 * n) : (f32x4){0.f, 0.f, 0.f, 0.f};
#pragma unroll
        for (int ai = 0; ai < 2; ++ai)
#pragma unroll
            for (int m = 0; m < 4; ++m) { bf16_t* rowp = base + (size_t)(row0 + ai * HALF + m * 16) * ldc + col0;
#pragma unroll
                for (int bj = 0; bj < 2; ++bj) { f32x4 v0 = acc[ai][bj][m][0] + bv[bj][0], v1 = acc[ai][bj][m][1] + bv[bj][1];
                    if (ACT == 1) { f32x2 a = gelu_pk((f32x2){v0[0], v0[1]}), b = gelu_pk((f32x2){v0[2], v0[3]}), c = gelu_pk((f32x2){v1[0], v1[1]}), d = gelu_pk((f32x2){v1[2], v1[3]});
                        v0 = (f32x4){a.x, a.y, b.x, b.y}; v1 = (f32x4){c.x, c.y, d.x, d.y}; }
                    v0 = v0 * sc; v1 = v1 * sc; u32x4 w; w.x = cvt_pk_bf16(v0[0], v0[1]); w.y = cvt_pk_bf16(v0[2], v0[3]); w.z = cvt_pk_bf16(v1[0], v1[1]); w.w = cvt_pk_bf16(v1[2], v1[3]);
                    *(u32x4*)(rowp + bj * HALF) = w; } }
    }
};
struct EpiF32 {
    static constexpr bool PERM = false, AFTER_DRAIN = false;
    float* C; int ldc; const float* bias;
    __device__ __forceinline__ void operator()(const f32x4 (&acc)[2][2][4][2], const Unit& u, int wr, int wc, int fr, int fq) const {
        const int row0 = u.pm * BM + wr * 64 + fr, col0 = u.pn * BM + wc * 32 + 4 * fq;
        f32x4 bv[2][2];
#pragma unroll
        for (int bj = 0; bj < 2; ++bj)
#pragma unroll
            for (int n = 0; n < 2; ++n) bv[bj][n] = bias ? *(const f32x4*)(bias + col0 + bj * HALF + n * 16) : (f32x4){0.f, 0.f, 0.f, 0.f};
#pragma unroll
        for (int ai = 0; ai < 2; ++ai)
#pragma unroll
            for (int m = 0; m < 4; ++m) { float* rowp = C + (size_t)(row0 + ai * HALF + m * 16) * ldc + col0;
#pragma unroll
                for (int bj = 0; bj < 2; ++bj)
#pragma unroll
                    for (int n = 0; n < 2; ++n) *(f32x4*)(rowp + bj * HALF + n * 16) = acc[ai][bj][m][n] + bv[bj][n]; }
    }
};
__device__ __forceinline__ float silu_f(float g) { return g * __builtin_amdgcn_rcpf(1.0f + __builtin_amdgcn_exp2f(-1.4426950408889634f * g)); }
struct EpiSwiGLU {
    static constexpr bool PERM = true, AFTER_DRAIN = false;
    bf16_t* O; int ldc;
    __device__ __forceinline__ void operator()(const f32x4 (&acc)[2][2][4][2], const Unit& u, int wr, int wc, int fr, int fq) const {
        const int row0 = u.opm * BM + wr * 64 + fr, col0 = u.opn * HALF + wc * 32 + 8 * fq;
#pragma unroll
        for (int ai = 0; ai < 2; ++ai)
#pragma unroll
            for (int m = 0; m < 4; ++m) { bf16_t* rowp = O + (size_t)(row0 + ai * HALF + m * 16) * ldc + col0;
                const f32x4 g0 = acc[ai][0][m][0], g1 = acc[ai][0][m][1], u0 = acc[ai][1][m][0], u1 = acc[ai][1][m][1];
                f32x4 h0, h1;
#pragma unroll
                for (int j = 0; j < 4; ++j) { h0[j] = silu_f(g0[j]) * u0[j]; h1[j] = silu_f(g1[j]) * u1[j]; }
                u32x4 w; w.x = cvt_pk_bf16(h0[0], h0[1]); w.y = cvt_pk_bf16(h0[2], h0[3]); w.z = cvt_pk_bf16(h1[0], h1[1]); w.w = cvt_pk_bf16(h1[2], h1[3]);
                *(u32x4*)rowp = w; }
    }
};
struct EpiSwiGLU8 {
    static constexpr bool PERM = true, AFTER_DRAIN = false;
    unsigned char* O; int ldc;
    __device__ __forceinline__ void operator()(const f32x4 (&acc)[2][2][4][2], const Unit& u, int wr, int wc, int fr, int fq) const {
        const int row0 = u.opm * BM + wr * 64 + fr, col0 = u.opn * HALF + wc * 32 + 8 * fq;
#pragma unroll
        for (int ai = 0; ai < 2; ++ai)
#pragma unroll
            for (int m = 0; m < 4; ++m) { unsigned char* rowp = O + (size_t)(row0 + ai * HALF + m * 16) * ldc + col0;
                const f32x4 g0 = acc[ai][0][m][0], g1 = acc[ai][0][m][1], u0 = acc[ai][1][m][0], u1 = acc[ai][1][m][1];
                f32x4 h0, h1;
#pragma unroll
                for (int j = 0; j < 4; ++j) { h0[j] = __builtin_fminf(__builtin_fmaxf(silu_f(g0[j]) * u0[j] * 8.0f, -448.0f), 448.0f); h1[j] = __builtin_fminf(__builtin_fmaxf(silu_f(g1[j]) * u1[j] * 8.0f, -448.0f), 448.0f); }
                int w0 = 0, w1 = 0;
                w0 = __builtin_amdgcn_cvt_pk_fp8_f32(h0[0], h0[1], w0, false); w0 = __builtin_amdgcn_cvt_pk_fp8_f32(h0[2], h0[3], w0, true);
                w1 = __builtin_amdgcn_cvt_pk_fp8_f32(h1[0], h1[1], w1, false); w1 = __builtin_amdgcn_cvt_pk_fp8_f32(h1[2], h1[3], w1, true);
                typedef unsigned v2u_ __attribute__((ext_vector_type(2)));
                *(v2u_*)rowp = (v2u_){(unsigned)w0, (unsigned)w1}; }
    }
};
struct EpiF32Mod {
    static constexpr bool PERM = false, AFTER_DRAIN = false;
    float* C; int ldc;
    __device__ __forceinline__ void operator()(const f32x4 (&acc)[2][2][4][2], const Unit& u, int wr, int wc, int fr, int fq) const {
        const int row0 = u.opm * BM + wr * 64 + fr, col0 = u.opn * BM + wc * 32 + 4 * fq;
#pragma unroll
        for (int ai = 0; ai < 2; ++ai)
#pragma unroll
            for (int m = 0; m < 4; ++m) { float* rowp = C + (size_t)(row0 + ai * HALF + m * 16) * ldc + col0;
#pragma unroll
                for (int bj = 0; bj < 2; ++bj)
#pragma unroll
                    for (int n = 0; n < 2; ++n) *(f32x4*)(rowp + bj * HALF + n * 16) = acc[ai][bj][m][n]; }
    }
};
struct EpiBf16Mod {
    static constexpr bool PERM = true, AFTER_DRAIN = false;
    bf16_t* O; int ldc;
    __device__ __forceinline__ void operator()(const f32x4 (&acc)[2][2][4][2], const Unit& u, int wr, int wc, int fr, int fq) const {
        const int row0 = u.opm * BM + wr * 64 + fr, col0 = u.opn * BM + wc * 32 + 8 * fq;
#pragma unroll
        for (int ai = 0; ai < 2; ++ai)
#pragma unroll
            for (int m = 0; m < 4; ++m) { bf16_t* rowp = O + (size_t)(row0 + ai * HALF + m * 16) * ldc + col0;
#pragma unroll
                for (int bj = 0; bj < 2; ++bj) { const f32x4 v0 = acc[ai][bj][m][0], v1 = acc[ai][bj][m][1];
                    u32x4 w; w.x = cvt_pk_bf16(v0[0], v0[1]); w.y = cvt_pk_bf16(v0[2], v0[3]); w.z = cvt_pk_bf16(v1[0], v1[1]); w.w = cvt_pk_bf16(v1[2], v1[3]);
                    *(u32x4*)(rowp + bj * HALF) = w; } }
    }
};
struct EpiQKV {
    static constexpr bool PERM = true, AFTER_DRAIN = false;
    bf16_t* O; int ldc; const float* rope; float* kpart;
    __device__ __forceinline__ void operator()(const f32x4 (&acc)[2][2][4][2], const Unit& u, int wr, int wc, int fr, int fq) const {
        const int row0 = u.pm * BM + wr * 64 + fr; const int col0 = u.pn * BM + wc * 32 + 8 * fq;
        const bool rot = (u.pn < 12) && (wc == 0), isk = (u.pn >= 6) && (u.pn < 12);
        f32x4 cs_[2][2];
#pragma unroll
        for (int bj = 0; bj < 2; ++bj)
#pragma unroll
            for (int n = 0; n < 2; ++n) cs_[bj][n] = (f32x4){0.f, 0.f, 0.f, 0.f};
#pragma unroll
        for (int ai = 0; ai < 2; ++ai)
#pragma unroll
            for (int m = 0; m < 4; ++m) { const int t = row0 + ai * HALF + m * 16; bf16_t* rowp = O + (size_t)t * ldc + col0;
                f32x4 c4[2];
                if (rot) { c4[0] = *(const f32x4*)(rope + ((size_t)t * 16 + 4 * fq) * 2); c4[1] = *(const f32x4*)(rope + ((size_t)t * 16 + 4 * fq + 2) * 2); }
#pragma unroll
                for (int bj = 0; bj < 2; ++bj) { f32x4 v[2];
#pragma unroll
                    for (int n = 0; n < 2; ++n) { v[n] = acc[ai][bj][m][n];
                        if (rot) { const f32x4 x = v[n], c = c4[n]; v[n] = (f32x4){x[0] * c[0] - x[1] * c[1], x[1] * c[0] + x[0] * c[1], x[2] * c[2] - x[3] * c[3], x[3] * c[2] + x[2] * c[3]}; }
                        cs_[bj][n] += v[n]; }
                    u32x4 w; w.x = cvt_pk_bf16(v[0][0], v[0][1]); w.y = cvt_pk_bf16(v[0][2], v[0][3]); w.z = cvt_pk_bf16(v[1][0], v[1][1]); w.w = cvt_pk_bf16(v[1][2], v[1][3]);
                    *(u32x4*)(rowp + bj * HALF) = w; } }
        if (isk) {
#pragma unroll
            for (int bj = 0; bj < 2; ++bj)
#pragma unroll
                for (int n = 0; n < 2; ++n)
#pragma unroll
                    for (int j = 0; j < 4; ++j) { float s = cs_[bj][n][j]; s += __shfl_xor(s, 1); s += __shfl_xor(s, 2); s += __shfl_xor(s, 4); s += __shfl_xor(s, 8); cs_[bj][n][j] = s; }
            if (fr == 0) {
#pragma unroll
                for (int bj = 0; bj < 2; ++bj) { float* kp = kpart + ((size_t)((2 * (u.pn - 6) + bj) * 32 + u.pm) * 2 + wr) * 128 + wc * 32 + 8 * fq;
                    *(f32x4*)kp = cs_[bj][0]; *(f32x4*)(kp + 4) = cs_[bj][1]; } }
        }
    }
};
struct EpiIn1 {
    static constexpr bool PERM = true, AFTER_DRAIN = false;
    bf16_t* O; int ldc; float* DT; int dt_pn;
    __device__ __forceinline__ void operator()(const f32x4 (&acc)[2][2][4][2], const Unit& u, int wr, int wc, int fr, int fq) const {
        const int row0 = u.pm * BM + wr * 64 + fr; const int col0 = u.pn * BM + wc * 32 + 8 * fq;
#pragma unroll
        for (int ai = 0; ai < 2; ++ai)
#pragma unroll
            for (int m = 0; m < 4; ++m) { bf16_t* rowp = O + (size_t)(row0 + ai * HALF + m * 16) * ldc + col0;
#pragma unroll
                for (int bj = 0; bj < 2; ++bj) { const f32x4 v0 = acc[ai][bj][m][0], v1 = acc[ai][bj][m][1];
                    u32x4 w; w.x = cvt_pk_bf16(v0[0], v0[1]); w.y = cvt_pk_bf16(v0[2], v0[3]); w.z = cvt_pk_bf16(v1[0], v1[1]); w.w = cvt_pk_bf16(v1[2], v1[3]);
                    *(u32x4*)(rowp + bj * HALF) = w; } }
        if (u.pn == dt_pn && wc == 0 && fq < 3) {
#pragma unroll
            for (int ai = 0; ai < 2; ++ai)
#pragma unroll
                for (int m = 0; m < 4; ++m) { float* dp = DT + (size_t)(row0 + ai * HALF + m * 16) * 32 + 8 * fq;
                    *(f32x4*)dp = acc[ai][0][m][0]; *(f32x4*)(dp + 4) = acc[ai][0][m][1]; }
        }
    }
};
struct MoeOrder {
    int G, c, npn, per, imax; int tp[9];
    __device__ __forceinline__ void init(const int* counts, int npn_, int G_, int c_, int imax_) { G = G_; c = c_; npn = npn_; imax = imax_; tp[0] = 0;
#pragma unroll
        for (int e = 0; e < 8; ++e) tp[e + 1] = tp[e] + ((counts[e] + 255) >> 8);
        per = tp[8] * npn / 8; }
    __device__ __forceinline__ void decode(int L, Unit& u) const {
        int e = 0;
#pragma unroll
        for (int k = 1; k < 8; ++k) e += (L >= tp[k] * npn) ? 1 : 0;
        int tpe = 0, tpn = 0;
#pragma unroll
        for (int k = 0; k < 8; ++k) { if (k == e) { tpe = tp[k]; tpn = tp[k + 1]; } }
        const int r = L - tpe * npn, nt = tpn - tpe; const int pn = r / nt, pml = r - pn * nt;
        u.pm = tpe + pml; u.pn = e * npn + pn; u.kofs = 0; u.opm = u.pm; u.opn = pn; }
    __device__ __forceinline__ bool next(int i, Unit& u) const {
        const int s = i * (G >> 3) + (c >> 3); if (i >= imax || s >= per) return false;
        decode((c & 7) * per + s, u); return true; }
    __device__ __forceinline__ void a_ready(const Unit&) const {}
    __device__ __forceinline__ void done(const Unit&) const {}
};
struct MoeSplitOrder {
    MoeOrder base; int first, S, kpiece;
    __device__ __forceinline__ void init(const MoeOrder& b, int done_rounds, int S_, int Ktot) { base = b; first = done_rounds * (b.G >> 3); S = S_; kpiece = Ktot / S_; }
    __device__ __forceinline__ bool next(int i, Unit& u) const {
        const int q = base.c >> 3; if (i > 0 || first + q / S >= base.per) return false;
        base.decode((base.c & 7) * base.per + first + q / S, u); u.kofs = (q % S) * kpiece; u.opm = (base.c & 7) * 32 + q; u.opn = 0; return true; }
    __device__ __forceinline__ void a_ready(const Unit&) const {}
    __device__ __forceinline__ void done(const Unit&) const {}
};
template <class Base> struct RangeOrder {
    Base b; int i0, i1;
    __device__ __forceinline__ bool next(int i, Unit& u) const { return (i0 + i < i1) && b.next(i0 + i, u); }
    __device__ __forceinline__ void a_ready(const Unit&) const {}
    __device__ __forceinline__ void done(const Unit&) const {}
};
template <class Epi, class Sched, bool ALIGN_EPI = false, bool SP2 = false, int FP8 = 0>
__device__ __forceinline__ void gemm_phase(PG8_LAS unsigned char* lds, const Gemm g, const Sched& S, const Epi& E, int tid_in = -1) {
    int tid_ = fresh_tid(); (void)tid_in; asm volatile("" : "+v"(tid_));
    const int tid = tid_, wid = __builtin_amdgcn_readfirstlane(tid >> 6), lane = tid & 63, wr = wid >> 2, wc = wid & 3, fr = lane & 15, fq = lane >> 4;
    const int K = g.ld, nt = g.K / BK;
    unsigned voffA[2], voffB[2];
#pragma unroll
    for (int i = 0; i < 2; ++i) { int R, C; stage_rc(tid * 16 + i * 8192, R, C); const int Rb = Epi::PERM ? ((R & ~31) + perm32(R & 31)) : R;
        voffA[i] = (unsigned)(R * K + C) * 2u; voffB[i] = (unsigned)(Rb * K + C) * 2u; }
    const size_t kstep = (size_t)(BK * 2);
    const size_t hstep = (size_t)HALF * K * 2;
    const size_t tstep = 2 * hstep;
    const unsigned ldsw = (unsigned)wid * 1024u;
    const int aoff = lds_byte(wr * 64 + fr, fq * 8), boff = lds_byte(wc * 32 + fr, fq * 8);
#define PG8_SA(b, h) (((b) * 2 + (h)) * HTB)
#define PG8_SB(b, h) ((4 + (b) * 2 + (h)) * HTB)
#define PG8_STAGE(bufoff, gbase, voff) do { _Pragma("unroll") for (int _i = 0; _i < 2; ++_i) { unsigned vo_ = (voff)[_i]; if constexpr (FP8 != 0) asm volatile("" : "+v"(vo_));     \
        __builtin_amdgcn_global_load_lds((const unsigned*)((const char*)(gbase) + vo_), (PG8_LAS unsigned*)(lds + (bufoff) + ldsw + _i * 8192), 16, 0, 0); } } while (0)
#define PG8_LDA(dst, b, h) do { if constexpr (FP8 == 0) { _Pragma("unroll") for (int m = 0; m < 4; ++m) _Pragma("unroll") for (int k = 0; k < 2; ++k) dst[m][k] = *(const PG8_LAS bf16x8*)(lds + PG8_SA(b, h) + aoff + m * 2048 + k * 1024); } \
    else { _Pragma("unroll") for (int m = 0; m < 4; ++m) { const v4i_ l_ = *(const PG8_LAS v4i_*)(lds + PG8_SA(b, h) + aoff + m * 2048), h_ = *(const PG8_LAS v4i_*)(lds + PG8_SA(b, h) + aoff + m * 2048 + 1024); \
        dst##8[m] = __builtin_shufflevector(l_, h_, 0, 1, 2, 3, 4, 5, 6, 7); } } } while (0)
#define PG8_LDB(dst, b, h) do { if constexpr (FP8 == 0) { _Pragma("unroll") for (int n = 0; n < 2; ++n) _Pragma("unroll") for (int k = 0; k < 2; ++k) dst[n][k] = *(const PG8_LAS bf16x8*)(lds + PG8_SB(b, h) + boff + n * 2048 + k * 1024); } \
    else { _Pragma("unroll") for (int n = 0; n < 2; ++n) { const v4i_ l_ = *(const PG8_LAS v4i_*)(lds + PG8_SB(b, h) + boff + n * 2048), h_ = *(const PG8_LAS v4i_*)(lds + PG8_SB(b, h) + boff + n * 2048 + 1024); \
        dst##8[n] = __builtin_shufflevector(l_, h_, 0, 1, 2, 3, 4, 5, 6, 7); } } } while (0)
#define PG8_MMA(ai, bj, At, Bt) do { __builtin_amdgcn_s_setprio(1); if constexpr (FP8 == 0) { _Pragma("unroll") for (int m = 0; m < 4; ++m) _Pragma("unroll") for (int n = 0; n < 2; ++n) _Pragma("unroll") for (int k = 0; k < 2; ++k) \
        acc[ai][bj][m][n] = __builtin_amdgcn_mfma_f32_16x16x32_bf16(Bt[n][k], At[m][k], acc[ai][bj][m][n], 0, 0, 0); } \
    else { _Pragma("unroll") for (int m = 0; m < 4; ++m) _Pragma("unroll") for (int n = 0; n < 2; ++n) \
        acc[ai][bj][m][n] = __builtin_amdgcn_mfma_scale_f32_16x16x128_f8f6f4(Bt##8[n], At##8[m], acc[ai][bj][m][n], 0, 0, 0, FP8 * 0x01010101, 0, FP8 * 0x01010101); } \
    __builtin_amdgcn_s_setprio(0); } while (0)
#define PG8_WAIT_V(n) asm volatile("s_waitcnt vmcnt(" #n ")" ::: "memory")
#define PG8_WAIT_L(n) asm volatile("s_waitcnt lgkmcnt(" #n ")" ::: "memory")
#define PG8_BAR __builtin_amdgcn_s_barrier()
#define PG8_SCHED __builtin_amdgcn_sched_barrier(0)
    Unit cur, nxt; int ui = 0;
    if (!S.next(0, cur)) return;
    f32x4 acc[2][2][4][2];
#pragma unroll
    for (int a = 0; a < 2; ++a)
#pragma unroll
        for (int b = 0; b < 2; ++b)
#pragma unroll
            for (int m = 0; m < 4; ++m)
#pragma unroll
                for (int n = 0; n < 2; ++n) acc[a][b][m][n] = (f32x4){0.f, 0.f, 0.f, 0.f};
    typedef int v4i_ __attribute__((ext_vector_type(4))); typedef int v8i_ __attribute__((ext_vector_type(8)));
    bf16x8 At[4][2], B0[2][2], B1[2][2];
    v8i_ At8[4], B08[2], B18[2];
    const char* cA = (const char*)g.A + (size_t)cur.pm * tstep + (size_t)cur.kofs * 2; const char* cB = (const char*)g.Bt + (size_t)cur.pn * tstep + (size_t)cur.kofs * 2;
    S.a_ready(cur);
    if constexpr (SP2) {
        PG8_STAGE(PG8_SB(0, 0), cB, voffB); PG8_STAGE(PG8_SB(0, 1), cB + hstep, voffB); PG8_STAGE(PG8_SA(0, 0), cA, voffA); PG8_STAGE(PG8_SA(0, 1), cA + hstep, voffA);
        if (wr == 1) PG8_BAR;
        PG8_WAIT_V(2); PG8_BAR;
        PG8_STAGE(PG8_SB(1, 0), cB + kstep, voffB); PG8_STAGE(PG8_SA(1, 0), cA + kstep, voffA); PG8_STAGE(PG8_SB(1, 1), cB + hstep + kstep, voffB);
        PG8_WAIT_V(6); PG8_BAR;
    } else {
        PG8_STAGE(PG8_SB(0, 0), cB, voffB); PG8_STAGE(PG8_SA(0, 0), cA, voffA); PG8_STAGE(PG8_SB(0, 1), cB + hstep, voffB); PG8_STAGE(PG8_SA(0, 1), cA + hstep, voffA);
        if (wr == 1) PG8_BAR;
        PG8_WAIT_V(4); PG8_BAR;
        PG8_STAGE(PG8_SB(1, 0), cB + kstep, voffB); PG8_STAGE(PG8_SA(1, 0), cA + kstep, voffA); PG8_STAGE(PG8_SB(1, 1), cB + hstep + kstep, voffB);
        PG8_WAIT_V(6); PG8_BAR;
    }
    for (;;) {
        const bool has_next = S.next(ui + 1, nxt);
        const char* nA = has_next ? (const char*)g.A + (size_t)nxt.pm * tstep + (size_t)nxt.kofs * 2 : cA; const char* nB = has_next ? (const char*)g.Bt + (size_t)nxt.pn * tstep + (size_t)nxt.kofs * 2 : cB;
        for (int t = 0; t < nt; t += 2) {
            const bool last = (t == nt - 2);
            const char* a1 = cA + (size_t)(t + 1) * kstep;
            const char* a2 = last ? nA : cA + (size_t)(t + 2) * kstep; const char* b2 = last ? nB : cB + (size_t)(t + 2) * kstep;
            const char* a3 = a2 + kstep; const char* b3 = b2 + kstep;
            if constexpr (FP8 != 0) { asm volatile("" : "+s"(a1), "+s"(a2), "+s"(b2), "+s"(a3), "+s"(b3)); }
            if (last && has_next) S.a_ready(nxt);
            if constexpr (SP2) {
            PG8_LDB(B0, 0, 0); PG8_LDB(B1, 0, 1); PG8_SCHED; PG8_LDA(At, 0, 0); PG8_STAGE(PG8_SA(1, 1), a1 + hstep, voffA);
            PG8_WAIT_V(8); PG8_WAIT_L(0); PG8_BAR; PG8_MMA(0, 0, At, B0); PG8_MMA(0, 1, At, B1); PG8_BAR; PG8_SCHED;
            PG8_LDA(At, 0, 1); PG8_STAGE(PG8_SB(0, 0), b2, voffB); PG8_STAGE(PG8_SB(0, 1), b2 + hstep, voffB); PG8_STAGE(PG8_SA(0, 0), a2, voffA);
            PG8_WAIT_V(8); PG8_WAIT_L(0); PG8_BAR; PG8_MMA(1, 0, At, B0); PG8_MMA(1, 1, At, B1); PG8_BAR; PG8_SCHED;
            PG8_LDB(B0, 1, 0); PG8_LDB(B1, 1, 1); PG8_SCHED; PG8_LDA(At, 1, 0); PG8_STAGE(PG8_SA(0, 1), a2 + hstep, voffA);
            PG8_WAIT_V(8); PG8_WAIT_L(0); PG8_BAR; PG8_MMA(0, 0, At, B0); PG8_MMA(0, 1, At, B1); PG8_BAR; PG8_SCHED;
            PG8_LDA(At, 1, 1); PG8_STAGE(PG8_SB(1, 0), b3, voffB); PG8_STAGE(PG8_SB(1, 1), b3 + hstep, voffB); PG8_STAGE(PG8_SA(1, 0), a3, voffA);
            PG8_WAIT_V(8); PG8_WAIT_L(0); PG8_BAR; PG8_MMA(1, 0, At, B0); PG8_MMA(1, 1, At, B1); PG8_BAR; PG8_SCHED;
            } else {
            PG8_LDB(B0, 0, 0); PG8_SCHED; PG8_LDA(At, 0, 0); PG8_STAGE(PG8_SA(1, 1), a1 + hstep, voffA);
            PG8_WAIT_L(8); PG8_BAR; PG8_WAIT_L(0); PG8_MMA(0, 0, At, B0); PG8_BAR; PG8_SCHED;
            PG8_LDB(B1, 0, 1); PG8_STAGE(PG8_SB(0, 0), b2, voffB);
            PG8_BAR; PG8_WAIT_L(0); PG8_MMA(0, 1, At, B1); PG8_BAR;
            PG8_LDA(At, 0, 1); PG8_STAGE(PG8_SA(0, 0), a2, voffA);
            PG8_BAR; PG8_WAIT_L(0); PG8_MMA(1, 0, At, B0); PG8_BAR; PG8_SCHED;
            PG8_STAGE(PG8_SB(0, 1), b2 + hstep, voffB);
            PG8_WAIT_V(6); PG8_BAR; PG8_MMA(1, 1, At, B1); PG8_BAR;
            PG8_LDB(B0, 1, 0); PG8_SCHED; PG8_LDA(At, 1, 0); PG8_STAGE(PG8_SA(0, 1), a2 + hstep, voffA);
            PG8_WAIT_L(8); PG8_BAR; PG8_WAIT_L(0); PG8_MMA(0, 0, At, B0); PG8_BAR; PG8_SCHED;
            PG8_LDB(B1, 1, 1); PG8_STAGE(PG8_SB(1, 0), b3, voffB);
            PG8_BAR; PG8_WAIT_L(0); PG8_MMA(0, 1, At, B1); PG8_BAR;
            PG8_LDA(At, 1, 1); PG8_STAGE(PG8_SA(1, 0), a3, voffA);
            PG8_BAR; PG8_WAIT_L(0); PG8_MMA(1, 0, At, B0); PG8_BAR; PG8_SCHED;
            PG8_STAGE(PG8_SB(1, 1), b3 + hstep, voffB);
            PG8_WAIT_V(6); PG8_BAR; PG8_MMA(1, 1, At, B1); PG8_BAR;
            }
        }
        if constexpr (ALIGN_EPI) { if (wr == 0) PG8_BAR; }
        if constexpr (!Epi::AFTER_DRAIN) { int fr_ = fr, fq_ = fq; if constexpr (FP8 != 0) asm volatile("" : "+v"(fr_), "+v"(fq_));
            E(acc, cur, wr, wc, fr_, fq_); S.done(cur); }
        if (!has_next) break;
#pragma unroll
        for (int a = 0; a < 2; ++a)
#pragma unroll
            for (int b = 0; b < 2; ++b)
#pragma unroll
                for (int m = 0; m < 4; ++m)
#pragma unroll
                    for (int n = 0; n < 2; ++n) acc[a][b][m][n] = (f32x4){0.f, 0.f, 0.f, 0.f};
        cur = nxt; cA = nA; cB = nB; ++ui;
        if constexpr (ALIGN_EPI) { if (wr == 1) PG8_BAR; }
    }
    PG8_WAIT_V(0);
    if constexpr (!ALIGN_EPI) { if (wr == 0) PG8_BAR; }
    PG8_BAR;
    if constexpr (Epi::AFTER_DRAIN) { E.fused(acc, cur, wr, wc, fr, fq, lds, wid, lane); S.done(cur); }
#undef PG8_SA
#undef PG8_SB
#undef PG8_STAGE
#undef PG8_LDA
#undef PG8_LDB
#undef PG8_MMA
#undef PG8_WAIT_V
#undef PG8_WAIT_L
#undef PG8_BAR
#undef PG8_SCHED
}
}

namespace att {
using bf16x8 = __attribute__((ext_vector_type(8))) short;
using s16x4  = __attribute__((ext_vector_type(4))) short;
using f32x16 = __attribute__((ext_vector_type(16))) float;
using f32x4  = __attribute__((ext_vector_type(4))) float;
using u32x4  = __attribute__((ext_vector_type(4))) unsigned;
using u32x2  = __attribute__((ext_vector_type(2))) unsigned;
typedef unsigned short bf16;
constexpr int   D = 128, NW = 8, QBLK = 32, KVBLK = 64;
constexpr float SCALE = 0.088388347648318440f;
constexpr float THR = 8.f;
constexpr float NEG = -1e30f;
constexpr int SHM_V = KVBLK * D * 2, SHM_K = KVBLK * D * 2;
constexpr int SHM_ATTN = 2 * SHM_V + 2 * SHM_K + NW * 64 * 4;
constexpr int ACS_OFF = SHM_ATTN;
#define KSWZ(row, colB) ((row) * 256 + ((colB) ^ (((row) & 7) << 4)))
#define SBAR() __builtin_amdgcn_sched_barrier(0)
__device__ __forceinline__ int crow(int r, int hi) { return (r & 3) + 8 * (r >> 2) + 4 * hi; }
__device__ __forceinline__ unsigned cvtpk(float lo, float hi) { unsigned r; asm volatile("v_cvt_pk_bf16_f32 %0, %1, %2" : "=v"(r) : "v"(lo), "v"(hi)); return r; }
__device__ __forceinline__ float bf2f(unsigned short b) { return __uint_as_float(((unsigned)b) << 16); }
__device__ __forceinline__ bf16x8 ld8(const bf16* p) { return *reinterpret_cast<const bf16x8*>(p); }

__device__ __forceinline__ int moba_lim(int idx, int qrow, unsigned rowmask, int hi) {
  const int vis = ((rowmask >> (((idx - 4) >> 2) & 31)) & 1u) ? 64 : -1;
  return ((idx < 4) ? (qrow - 64 * idx) : vis) - 4 * hi;
}
__device__ __forceinline__ void partialSM(f32x16& p0, f32x16& p1, float& m_reg, float& mn, float& alpha) {
  constexpr float C = SCALE * 1.4426950408889634f;
  float pmax = p0[0];
#pragma unroll
  for (int r = 1; r < 16; ++r) pmax = fmaxf(pmax, p0[r]);
#pragma unroll
  for (int r = 0; r < 16; ++r) pmax = fmaxf(pmax, p1[r]);
  { auto rr = __builtin_amdgcn_permlane32_swap(__float_as_uint(pmax), __float_as_uint(pmax), false, false);
    pmax = fmaxf(__uint_as_float(rr[0]), __uint_as_float(rr[1])); }
  if (__builtin_expect(__all(pmax - m_reg <= THR / SCALE), 1)) { mn = m_reg; alpha = 1.f; }
  else { mn = fmaxf(m_reg, pmax); alpha = __builtin_amdgcn_exp2f((m_reg - mn) * C); m_reg = mn; }
  const float mnC = -mn * C;
#pragma unroll
  for (int r = 0; r < 16; ++r) p0[r] = fmaf(p0[r], C, mnC);
#pragma unroll
  for (int r = 0; r < 16; ++r) p1[r] = fmaf(p1[r], C, mnC);
#pragma unroll
  for (int r = 0; r < 16; ++r) p0[r] = __builtin_amdgcn_exp2f(p0[r]);
}
#define ATT_PK4(P, BASE, OUT) do { unsigned a0 = cvtpk(P[BASE + 0], P[BASE + 1]), a1 = cvtpk(P[BASE + 2], P[BASE + 3]);   \
    unsigned b0 = cvtpk(P[BASE + 4], P[BASE + 5]), b1 = cvtpk(P[BASE + 6], P[BASE + 7]);                              \
    auto r0 = __builtin_amdgcn_permlane32_swap(a0, b0, false, false); auto r1 = __builtin_amdgcn_permlane32_swap(a1, b1, false, false); \
    u32x4 w = {r0[0], r1[0], r0[1], r1[1]}; OUT = *reinterpret_cast<bf16x8*>(&w); } while (0)
__device__ __forceinline__ void finishSM(f32x16& p0, f32x16& p1, float alpha, float& l_reg, bf16x8& pa0, bf16x8& pa1, bf16x8& pa2, bf16x8& pa3) {
#pragma unroll
  for (int r = 0; r < 16; ++r) p1[r] = __builtin_amdgcn_exp2f(p1[r]);
  float ps = 0;
#pragma unroll
  for (int r = 0; r < 16; ++r) ps += p0[r];
#pragma unroll
  for (int r = 0; r < 16; ++r) ps += p1[r];
  { auto rr = __builtin_amdgcn_permlane32_swap(__float_as_uint(ps), __float_as_uint(ps), false, false);
    ps = __uint_as_float(rr[0]) + __uint_as_float(rr[1]); }
  l_reg = l_reg * alpha + ps;
  ATT_PK4(p0, 0, pa0); ATT_PK4(p0, 8, pa1); ATT_PK4(p1, 0, pa2); ATT_PK4(p1, 8, pa3);
}
template <bool MASKED>
__device__ __forceinline__ void qkt(f32x16& p0, f32x16& p1, const char* Ks, const bf16x8* qr, int r32, int hi, int lim = 0) {
  if (MASKED) {
#pragma unroll
    for (int r = 0; r < 16; ++r) { const int cr = (r & 3) + 8 * (r >> 2); p0[r] = (cr > lim) ? NEG : 0.f; p1[r] = (cr + 32 > lim) ? NEG : 0.f; }
  } else { p0 = f32x16{}; p1 = f32x16{}; }
#pragma unroll
  for (int d0 = 0; d0 < 8; ++d0) { const int cb = (d0 * 16 + hi * 8) * 2;
    bf16x8 b0 = *reinterpret_cast<const bf16x8*>(Ks + KSWZ(r32, cb));
    bf16x8 b1 = *reinterpret_cast<const bf16x8*>(Ks + KSWZ(32 + r32, cb));
    p0 = __builtin_amdgcn_mfma_f32_32x32x16_bf16(b0, qr[d0], p0, 0, 0, 0);
    p1 = __builtin_amdgcn_mfma_f32_32x32x16_bf16(b1, qr[d0], p1, 0, 0, 0); }
}
__device__ __forceinline__ int v_st(int k, int c) { const int kk = (k & ~0xC) | ((k & 4) << 1) | ((k & 8) >> 1); return ((kk >> 3) * 4 + (c >> 5)) * 512 + ((kk & 7) * 32 + (c & 31)) * 2; }
__device__ __forceinline__ int v_rd_base(int lane) { return ((lane & 3) << 3) | (((lane >> 2) & 3) << 6) | (((lane >> 4) & 1) << 5) | (((lane >> 5) & 1) << 8); }
constexpr int v_rd_off(int d0, int ks, int half) { return d0 * 512 + ks * 4096 + half * 2048; }
template <int OFF> __device__ __forceinline__ s16x4 tr_read(int vb) {
  s16x4 r; asm volatile("ds_read_b64_tr_b16 %0, %1 offset:%2" : "=&v"(r) : "v"(vb), "i"(OFF) : "memory"); return r;
}
#define ATT_PK(L, H) (bf16x8){L[0], L[1], L[2], L[3], H[0], H[1], H[2], H[3]}
template <int D0> __device__ __forceinline__ void pv_one(f32x16& od, int vb, bf16x8 pa0, bf16x8 pa1, bf16x8 pa2, bf16x8 pa3) {
  const s16x4 l0 = tr_read<v_rd_off(D0, 0, 0)>(vb), h0 = tr_read<v_rd_off(D0, 0, 1)>(vb), l1 = tr_read<v_rd_off(D0, 1, 0)>(vb), h1 = tr_read<v_rd_off(D0, 1, 1)>(vb);
  const s16x4 l2 = tr_read<v_rd_off(D0, 2, 0)>(vb), h2 = tr_read<v_rd_off(D0, 2, 1)>(vb), l3 = tr_read<v_rd_off(D0, 3, 0)>(vb), h3 = tr_read<v_rd_off(D0, 3, 1)>(vb);
  asm volatile("s_waitcnt lgkmcnt(0)" ::: "memory"); SBAR();
  od = __builtin_amdgcn_mfma_f32_32x32x16_bf16(pa0, ATT_PK(l0, h0), od, 0, 0, 0);
  od = __builtin_amdgcn_mfma_f32_32x32x16_bf16(pa1, ATT_PK(l1, h1), od, 0, 0, 0);
  od = __builtin_amdgcn_mfma_f32_32x32x16_bf16(pa2, ATT_PK(l2, h2), od, 0, 0, 0);
  od = __builtin_amdgcn_mfma_f32_32x32x16_bf16(pa3, ATT_PK(l3, h3), od, 0, 0, 0);
}
__device__ __forceinline__ void pv_d0(f32x16* o, int vb, bf16x8 pa0, bf16x8 pa1, bf16x8 pa2, bf16x8 pa3) {
  pv_one<0>(o[0], vb, pa0, pa1, pa2, pa3); pv_one<1>(o[1], vb, pa0, pa1, pa2, pa3); pv_one<2>(o[2], vb, pa0, pa1, pa2, pa3); pv_one<3>(o[3], vb, pa0, pa1, pa2, pa3);
}
template <int KS> __device__ __forceinline__ void pv_ks(f32x16* o, int vb, bf16x8 pa) {
  const s16x4 l0 = tr_read<v_rd_off(0, KS, 0)>(vb), h0 = tr_read<v_rd_off(0, KS, 1)>(vb), l1 = tr_read<v_rd_off(1, KS, 0)>(vb), h1 = tr_read<v_rd_off(1, KS, 1)>(vb);
  const s16x4 l2 = tr_read<v_rd_off(2, KS, 0)>(vb), h2 = tr_read<v_rd_off(2, KS, 1)>(vb), l3 = tr_read<v_rd_off(3, KS, 0)>(vb), h3 = tr_read<v_rd_off(3, KS, 1)>(vb);
  asm volatile("s_waitcnt lgkmcnt(0)" ::: "memory"); SBAR();
  o[0] = __builtin_amdgcn_mfma_f32_32x32x16_bf16(pa, ATT_PK(l0, h0), o[0], 0, 0, 0);
  o[1] = __builtin_amdgcn_mfma_f32_32x32x16_bf16(pa, ATT_PK(l1, h1), o[1], 0, 0, 0);
  o[2] = __builtin_amdgcn_mfma_f32_32x32x16_bf16(pa, ATT_PK(l2, h2), o[2], 0, 0, 0);
  o[3] = __builtin_amdgcn_mfma_f32_32x32x16_bf16(pa, ATT_PK(l3, h3), o[3], 0, 0, 0);
}
__device__ __forceinline__ void pv_il(f32x16* o, int vb, bf16x8 pa0, bf16x8 pa1, bf16x8 pa2, bf16x8 pa3) {
  pv_ks<0>(o, vb, pa0); pv_ks<1>(o, vb, pa1); pv_ks<2>(o, vb, pa2); pv_ks<3>(o, vb, pa3);
}

template <bool MOBA, int ldq, int ldk, int ldo>
__device__ __forceinline__ void attn_unit(const bf16* __restrict__ Qb, const bf16* __restrict__ Kh, const bf16* __restrict__ Vh, bf16* __restrict__ Ob,
                                          int NT, int b, const float* __restrict__ kmean, char* lds) {
  const int tid = fresh_tid(), wid = tid >> 6, lane = tid & 63, r32 = lane & 31, hi = lane >> 5;
  char* V_lds = lds; char* K_lds = lds + 2 * SHM_V;
  float* ws = (float*)(lds + 2 * SHM_V + 2 * SHM_K) + wid * 64; float* li_l = ws; float* al_l = ws + 32;
  float m_reg = NEG, l_reg = 0; f32x16 o[4] = {}; bf16x8 qr[8];
  const bf16* Qw = Qb + (long)(wid * QBLK + r32) * ldq + hi * 8;
#pragma unroll
  for (int d0 = 0; d0 < 8; ++d0) qr[d0] = ld8(Qw + d0 * 16);
  const int sr = tid >> 4, sc = (tid & 15) * 8, vst0 = v_st(sr, sc), vst1 = v_st(32 + sr, sc);
  const int vb0 = (int)(uintptr_t)V_lds + v_rd_base(lane);
  const int qrow = wid * QBLK + r32;
  unsigned rowmask = 0u;
  if (MOBA) {
    { const float* km = kmean + sr * 128 + sc; const f32x4 a = *(const f32x4*)km, c4 = *(const f32x4*)(km + 4);
      u32x4 w = {cvtpk(a[0], a[1]), cvtpk(a[2], a[3]), cvtpk(c4[0], c4[1]), cvtpk(c4[2], c4[3])};
      *(u32x4*)(K_lds + KSWZ(sr, sc * 2)) = w; }
    __syncthreads();
    f32x16 g = f32x16{};
#pragma unroll
    for (int d0 = 0; d0 < 8; ++d0) { const int cb = (d0 * 16 + hi * 8) * 2;
      bf16x8 b0 = *reinterpret_cast<const bf16x8*>(K_lds + KSWZ(r32, cb));
      g = __builtin_amdgcn_mfma_f32_32x32x16_bf16(b0, qr[d0], g, 0, 0, 0); }
#pragma unroll
    for (int r = 0; r < 16; ++r) g[r] = (crow(r, hi) < b) ? g[r] : -__builtin_inff();
#pragma unroll
    for (int k = 0; k < 3; ++k) {
      float best = -__builtin_inff(); int bi = 99;
#pragma unroll
      for (int r = 0; r < 16; ++r) { const int n = crow(r, hi); const bool t = (g[r] > best) || (g[r] == best && n < bi); best = t ? g[r] : best; bi = t ? n : bi; }
      const float pv = __shfl_xor(best, 32); const int pi = __shfl_xor(bi, 32);
      const bool pt = (pv > best) || (pv == best && pi < bi);
      const int wi = pt ? pi : bi;
      if (k < b) rowmask |= 1u << (wi & 31);
#pragma unroll
      for (int r = 0; r < 16; ++r) g[r] = (crow(r, hi) == wi) ? -__builtin_inff() : g[r];
    }
    __syncthreads();
  }
  const bf16* Kp = Kh + (long)sr * ldk + sc; const bf16* Vp = Vh + (long)sr * ldk + sc;
#define TK0(idx) (MOBA ? ((idx) < 4 ? 256 * b + 64 * (idx) : 64 * ((idx) - 4)) : 64 * (idx))
#define RESC(a) do { if (__any((a) < 1.f)) { if (hi == 0) al_l[r32] = (a); asm volatile("s_waitcnt lgkmcnt(0)" ::: "memory"); \
    _Pragma("unroll") for (int d = 0; d < 4; ++d) _Pragma("unroll") for (int r = 0; r < 16; ++r) o[d][r] *= al_l[crow(r, hi)]; } } while (0)
  if constexpr (MOBA) {
    bf16x8 vs0, vs1, ks0, ks1;
#define SLOAD1(idx) do { const long ko_ = (long)(TK0(idx)) * ldk; vs0 = ld8(Vp + ko_); vs1 = ld8(Vp + ko_ + 32 * ldk); ks0 = ld8(Kp + ko_); ks1 = ld8(Kp + ko_ + 32 * ldk); } while (0)
    SLOAD1(0);
#pragma nounroll
    for (int idx = 0; idx < NT; ++idx) {
      __syncthreads();
      *(bf16x8*)(V_lds + vst0) = vs0; *(bf16x8*)(V_lds + vst1) = vs1; { const int kc = sc * 2; *(bf16x8*)(K_lds + KSWZ(sr, kc)) = ks0; *(bf16x8*)(K_lds + KSWZ(32 + sr, kc)) = ks1; }
      if (idx + 1 < NT) SLOAD1(idx + 1);
      __syncthreads();
      f32x16 p0, p1; float mn, al; bf16x8 pa0, pa1, pa2, pa3;
      qkt<true>(p0, p1, K_lds, qr, r32, hi, moba_lim(idx, qrow, rowmask, hi));
      partialSM(p0, p1, m_reg, mn, al);
      RESC(al);
      finishSM(p0, p1, al, l_reg, pa0, pa1, pa2, pa3); SBAR();
      pv_d0(o, vb0, pa0, pa1, pa2, pa3);
    }
#undef SLOAD1
  } else {
  constexpr int SDEPTH = MOBA ? 1 : 2;
  struct { bf16x8 vs0, vs1, ks0, ks1; } sr_[SDEPTH];
#define SLOAD(i, idx) do { const long ko_ = (long)(TK0(idx)) * ldk; sr_[i].vs0 = ld8(Vp + ko_); sr_[i].vs1 = ld8(Vp + ko_ + 32 * ldk); \
    sr_[i].ks0 = ld8(Kp + ko_); sr_[i].ks1 = ld8(Kp + ko_ + 32 * ldk); } while (0)
#define SWRITE(bb, i) do { *(bf16x8*)(V_lds + (bb) * SHM_V + vst0) = sr_[i].vs0;          \
    *(bf16x8*)(V_lds + (bb) * SHM_V + vst1) = sr_[i].vs1; const int kc = sc * 2;               \
    *(bf16x8*)(K_lds + (bb) * SHM_K + KSWZ(sr, kc)) = sr_[i].ks0;                       \
    *(bf16x8*)(K_lds + (bb) * SHM_K + KSWZ(32 + sr, kc)) = sr_[i].ks1; } while (0)
#define SWAIT() do { if constexpr (SDEPTH == 2) asm volatile("s_waitcnt vmcnt(4)" ::: "memory"); else asm volatile("s_waitcnt vmcnt(0)" ::: "memory"); } while (0)
#define QKT(P0, P1, KS, idx) qkt<MOBA>(P0, P1, KS, qr, r32, hi, MOBA ? moba_lim((idx), qrow, rowmask, hi) : 0)
  f32x16 pA0, pA1, pB0, pB1; float mnA, mnB, alA, alB; bf16x8 pa0, pa1, pa2, pa3;
  constexpr int SE = 0, SO = SDEPTH - 1;
  SLOAD(SE, 0); asm volatile("s_waitcnt vmcnt(0)" ::: "memory"); SWRITE(0, SE); __syncthreads();
  QKT(pA0, pA1, K_lds, 0); partialSM(pA0, pA1, m_reg, mnA, alA);
  SLOAD(SO, 1); if constexpr (SDEPTH == 2) { if (2 < NT) SLOAD(SE, 2); }
  SWAIT(); SWRITE(1, SO); __syncthreads();
  for (int j = 1; j + 1 < NT; j += 2) {
    SBAR(); QKT(pB0, pB1, K_lds + SHM_K, j);
    finishSM(pA0, pA1, alA, l_reg, pa0, pa1, pa2, pa3); SBAR();
    SLOAD(SO, j + SDEPTH); SBAR();
    pv_d0(o, vb0, pa0, pa1, pa2, pa3); partialSM(pB0, pB1, m_reg, mnB, alB);
    __syncthreads(); SWAIT(); SWRITE(0, SE);
    RESC(alB); __syncthreads();
    SBAR(); QKT(pA0, pA1, K_lds, j + 1);
    finishSM(pB0, pB1, alB, l_reg, pa0, pa1, pa2, pa3); SBAR();
    if (SDEPTH == 1 || j + 3 < NT) SLOAD(SE, j + 1 + SDEPTH); SBAR();
    pv_d0(o, vb0 + SHM_V, pa0, pa1, pa2, pa3); partialSM(pA0, pA1, m_reg, mnA, alA);
    __syncthreads(); SWAIT(); SWRITE(1, SO);
    RESC(alA); __syncthreads();
  }
  SBAR(); QKT(pB0, pB1, K_lds + SHM_K, NT - 1);
  finishSM(pA0, pA1, alA, l_reg, pa0, pa1, pa2, pa3); SBAR();
  pv_d0(o, vb0, pa0, pa1, pa2, pa3); partialSM(pB0, pB1, m_reg, mnB, alB);
  __syncthreads(); RESC(alB);
  finishSM(pB0, pB1, alB, l_reg, pa0, pa1, pa2, pa3); SBAR();
  pv_d0(o, vb0 + SHM_V, pa0, pa1, pa2, pa3);
  }
  if (hi == 0) li_l[r32] = l_reg; asm volatile("s_waitcnt lgkmcnt(0)" ::: "memory");
  float rli[16];
#pragma unroll
  for (int r = 0; r < 16; ++r) rli[r] = __builtin_amdgcn_rcpf(li_l[crow(r, hi)]);
  bf16* Ow = Ob + (long)(wid * QBLK) * ldo;
#pragma unroll
  for (int r = 0; r < 16; ++r) { const int orow = crow(r, hi);
#pragma unroll
    for (int d0 = 0; d0 < 4; ++d0) Ow[(long)orow * ldo + d0 * 32 + r32] = (bf16)(cvtpk(o[d0][r] * rli[r], 0.f) & 0xffffu); }
  __syncthreads();
#undef TK0
#undef SLOAD
#undef SWRITE
#undef SWAIT
#undef RESC
#undef QKT
}

__device__ __forceinline__ void moba_gate_unit(const bf16* __restrict__ Qb, const float* __restrict__ kmean, int b, int h, unsigned* __restrict__ ROWMASK, unsigned char* __restrict__ SEG, int* __restrict__ CNT, char* lds) {
  const int tid = fresh_tid(), wid = tid >> 6, lane = tid & 63, r32 = lane & 31, hi = lane >> 5;
  char* K_lds = lds + 2 * SHM_V; int* cw = (int*)(lds + ACS_OFF);
  constexpr int ldq = 5120;
  bf16x8 qr[8];
  const bf16* Qw = Qb + (long)(wid * QBLK + r32) * ldq + hi * 8;
#pragma unroll
  for (int d0 = 0; d0 < 8; ++d0) qr[d0] = ld8(Qw + d0 * 16);
  const int sr = tid >> 4, sc = (tid & 15) * 8;
  unsigned rowmask = 0u;
  { const float* km = kmean + (size_t)sr * 256 + sc;
    const f32x4 a = (*(const f32x4*)km + *(const f32x4*)(km + 128)) * (1.0f / 256.0f), c4 = (*(const f32x4*)(km + 4) + *(const f32x4*)(km + 132)) * (1.0f / 256.0f);
    u32x4 w = {cvtpk(a[0], a[1]), cvtpk(a[2], a[3]), cvtpk(c4[0], c4[1]), cvtpk(c4[2], c4[3])};
    *(u32x4*)(K_lds + KSWZ(sr, sc * 2)) = w; }
  __syncthreads();
  f32x16 g = f32x16{};
#pragma unroll
  for (int d0 = 0; d0 < 8; ++d0) { const int cb = (d0 * 16 + hi * 8) * 2;
    bf16x8 b0 = *reinterpret_cast<const bf16x8*>(K_lds + KSWZ(r32, cb));
    g = __builtin_amdgcn_mfma_f32_32x32x16_bf16(b0, qr[d0], g, 0, 0, 0); }
#pragma unroll
  for (int r = 0; r < 16; ++r) g[r] = (crow(r, hi) < b) ? g[r] : -__builtin_inff();
#pragma unroll
  for (int k = 0; k < 3; ++k) {
    float best = -__builtin_inff(); int bi = 99;
#pragma unroll
    for (int r = 0; r < 16; ++r) { const int n = crow(r, hi); const bool t = (g[r] > best) || (g[r] == best && n < bi); best = t ? g[r] : best; bi = t ? n : bi; }
    const float pv = __shfl_xor(best, 32); const int pi = __shfl_xor(bi, 32);
    const bool pt = (pv > best) || (pv == best && pi < bi);
    const int wi = pt ? pi : bi;
    if (k < b) rowmask |= 1u << (wi & 31);
#pragma unroll
    for (int r = 0; r < 16; ++r) g[r] = (crow(r, hi) == wi) ? -__builtin_inff() : g[r];
  }
  if (hi == 0) ROWMASK[(size_t)(256 * b + wid * QBLK + r32) * 12 + h] = rowmask;
  int mycnt = 0;
  for (int j = 0; j < b; ++j) { const unsigned long long bal = __ballot(((rowmask >> j) & 1u) && hi == 0); const int c = __popcll(bal); if (lane == j) mycnt = c; }
  if (lane < 32) cw[wid * 32 + lane] = mycnt;
  __syncthreads();
  int off = 0, tot = 0;
  if (lane < 32) {
#pragma unroll
    for (int w = 0; w < 8; ++w) { const int c = cw[w * 32 + lane]; off += (w < wid) ? c : 0; tot += c; } }
  if (wid == 0 && lane < b) CNT[(h * 32 + lane) * 32 + b] = tot;
  for (int j = 0; j < b; ++j) { const bool bit = ((rowmask >> j) & 1u) && hi == 0; const unsigned long long bal = __ballot(bit); const int base = __shfl(off, j);
    if (bit) { const int rank = __popcll(bal & ((1ull << lane) - 1ull)); SEG[((size_t)(h * 32 + j) * 32 + b) * 256 + base + rank] = (unsigned char)(wid * QBLK + r32); } }
  __syncthreads();
}
template <bool OWN>
__device__ __forceinline__ void attn_part_unit(const bf16* __restrict__ Qw, const bf16* __restrict__ Kh, const bf16* __restrict__ Vh, int dst, bf16* __restrict__ PARTO, float* __restrict__ PARTML, char* lds) {
  constexpr int ldk = 5120, NT = 4;
  const int tid = fresh_tid(), wid = tid >> 6, lane = tid & 63, r32 = lane & 31, hi = lane >> 5;
  char* V_lds = lds; char* K_lds = lds + 2 * SHM_V;
  float* ws = (float*)(lds + 2 * SHM_V + 2 * SHM_K) + wid * 64; float* li_l = ws; float* al_l = ws + 32; int* dst_l = (int*)(lds + ACS_OFF) + wid * 32;
  float m_reg = NEG, l_reg = 0; f32x16 o[4] = {}; bf16x8 qr[8];
#pragma unroll
  for (int d0 = 0; d0 < 8; ++d0) qr[d0] = ld8(Qw + d0 * 16);
  const int sr = tid >> 4, sc = (tid & 15) * 8, vst0 = v_st(sr, sc), vst1 = v_st(32 + sr, sc);
  const int vb0 = (int)(uintptr_t)V_lds + v_rd_base(lane);
  const int qrow = wid * QBLK + r32;
  const bf16* Kp = Kh + (long)sr * ldk + sc; const bf16* Vp = Vh + (long)sr * ldk + sc;
#define RESC(a) do { if (__any((a) < 1.f)) { if (hi == 0) al_l[r32] = (a); asm volatile("s_waitcnt lgkmcnt(0)" ::: "memory"); \
    _Pragma("unroll") for (int d = 0; d < 4; ++d) _Pragma("unroll") for (int r = 0; r < 16; ++r) o[d][r] *= al_l[crow(r, hi)]; } } while (0)
  if constexpr (OWN) {
    bf16x8 vs0, vs1, ks0, ks1;
#define SLOAD1(idx) do { const long ko_ = (long)(64 * (idx)) * ldk; vs0 = ld8(Vp + ko_); vs1 = ld8(Vp + ko_ + 32 * ldk); ks0 = ld8(Kp + ko_); ks1 = ld8(Kp + ko_ + 32 * ldk); } while (0)
    SLOAD1(0);
#pragma nounroll
    for (int idx = 0; idx < NT; ++idx) {
      __syncthreads();
      *(bf16x8*)(V_lds + vst0) = vs0; *(bf16x8*)(V_lds + vst1) = vs1; { const int kc = sc * 2; *(bf16x8*)(K_lds + KSWZ(sr, kc)) = ks0; *(bf16x8*)(K_lds + KSWZ(32 + sr, kc)) = ks1; }
      if (idx + 1 < NT) SLOAD1(idx + 1);
      __syncthreads();
      f32x16 p0, p1; float mn, al; bf16x8 pa0, pa1, pa2, pa3;
      qkt<true>(p0, p1, K_lds, qr, r32, hi, qrow - 64 * idx - 4 * hi);
      partialSM(p0, p1, m_reg, mn, al);
      RESC(al);
      finishSM(p0, p1, al, l_reg, pa0, pa1, pa2, pa3); SBAR();
      pv_d0(o, vb0, pa0, pa1, pa2, pa3);
    }
#undef SLOAD1
  } else {
    struct { bf16x8 vs0, vs1, ks0, ks1; } sr_[2];
#define SLOAD(i, idx) do { const long ko_ = (long)(64 * (idx)) * ldk; sr_[i].vs0 = ld8(Vp + ko_); sr_[i].vs1 = ld8(Vp + ko_ + 32 * ldk); \
    sr_[i].ks0 = ld8(Kp + ko_); sr_[i].ks1 = ld8(Kp + ko_ + 32 * ldk); } while (0)
#define SWRITE(bb, i) do { *(bf16x8*)(V_lds + (bb) * SHM_V + vst0) = sr_[i].vs0;          \
    *(bf16x8*)(V_lds + (bb) * SHM_V + vst1) = sr_[i].vs1; const int kc = sc * 2;               \
    *(bf16x8*)(K_lds + (bb) * SHM_K + KSWZ(sr, kc)) = sr_[i].ks0;                       \
    *(bf16x8*)(K_lds + (bb) * SHM_K + KSWZ(32 + sr, kc)) = sr_[i].ks1; } while (0)
#define SWAIT() asm volatile("s_waitcnt vmcnt(4)" ::: "memory")
    f32x16 pA0, pA1, pB0, pB1; float mnA, mnB, alA, alB; bf16x8 pa0, pa1, pa2, pa3;
    SLOAD(0, 0); asm volatile("s_waitcnt vmcnt(0)" ::: "memory"); SWRITE(0, 0); __syncthreads();
    qkt<false>(pA0, pA1, K_lds, qr, r32, hi); partialSM(pA0, pA1, m_reg, mnA, alA);
    SLOAD(1, 1); SLOAD(0, 2);
    SWAIT(); SWRITE(1, 1); __syncthreads();
    SBAR(); qkt<false>(pB0, pB1, K_lds + SHM_K, qr, r32, hi);
    finishSM(pA0, pA1, alA, l_reg, pa0, pa1, pa2, pa3); SBAR();
    SLOAD(1, 3); SBAR();
    pv_d0(o, vb0, pa0, pa1, pa2, pa3); partialSM(pB0, pB1, m_reg, mnB, alB);
    __syncthreads(); SWAIT(); SWRITE(0, 0);
    RESC(alB); __syncthreads();
    SBAR(); qkt<false>(pA0, pA1, K_lds, qr, r32, hi);
    finishSM(pB0, pB1, alB, l_reg, pa0, pa1, pa2, pa3); SBAR();
    pv_d0(o, vb0 + SHM_V, pa0, pa1, pa2, pa3); partialSM(pA0, pA1, m_reg, mnA, alA);
    __syncthreads(); asm volatile("s_waitcnt vmcnt(0)" ::: "memory"); SWRITE(1, 1);
    RESC(alA); __syncthreads();
    SBAR(); qkt<false>(pB0, pB1, K_lds + SHM_K, qr, r32, hi);
    finishSM(pA0, pA1, alA, l_reg, pa0, pa1, pa2, pa3); SBAR();
    pv_d0(o, vb0, pa0, pa1, pa2, pa3); partialSM(pB0, pB1, m_reg, mnB, alB);
    __syncthreads(); RESC(alB);
    finishSM(pB0, pB1, alB, l_reg, pa0, pa1, pa2, pa3); SBAR();
    pv_d0(o, vb0 + SHM_V, pa0, pa1, pa2, pa3);
#undef SLOAD
#undef SWRITE
#undef SWAIT
  }
#undef RESC
  if (hi == 0) { li_l[r32] = l_reg; dst_l[r32] = dst; if (dst >= 0) { PARTML[2 * (size_t)dst] = m_reg; PARTML[2 * (size_t)dst + 1] = l_reg; } }
  asm volatile("s_waitcnt lgkmcnt(0)" ::: "memory");
#pragma unroll
  for (int r = 0; r < 16; ++r) { const int row = crow(r, hi); const int d = dst_l[row]; const float rl = __builtin_amdgcn_rcpf(li_l[row]);
    if (d >= 0) { bf16* op = PARTO + (size_t)d * 128 + r32;
#pragma unroll
      for (int d0 = 0; d0 < 4; ++d0) op[d0 * 32] = (bf16)(cvtpk(o[d0][r] * rl, 0.f) & 0xffffu); } }
  __syncthreads();
}

__device__ __forceinline__ void moba_kv_item(const bf16* __restrict__ QKVM, int h, int j, int row0, int rowend, const int* segp, const unsigned* __restrict__ ROWMASK, const unsigned char* __restrict__ SEG,
                                             bf16* __restrict__ PARTO, float* __restrict__ PARTML, char* lds, char* scr) {
  constexpr int ld = 5120;
  const int tid = fresh_tid(), wid = tid >> 6, lane = tid & 63, r32 = lane & 31, hi = lane >> 5;
  char* V_lds = lds; char* K_lds = lds + 4 * SHM_V;
  float* ws = (float*)scr + wid * 64; float* li_l = ws; float* al_l = ws + 32; int* dst_l = (int*)(scr + 2048) + wid * 32;
  {
    const int sr = tid >> 4, sc = (tid & 15) * 8, vst0 = v_st(sr, sc), vst1 = v_st(32 + sr, sc);
    const bf16* Kp = QKVM + (size_t)(256 * j + sr) * ld + 1536 + h * 128 + sc; const bf16* Vp = Kp + 1536;
    bf16x8 kv[16];
#pragma unroll
    for (int i = 0; i < 4; ++i) { kv[4 * i] = ld8(Kp + (size_t)(64 * i) * ld); kv[4 * i + 1] = ld8(Kp + (size_t)(64 * i + 32) * ld); kv[4 * i + 2] = ld8(Vp + (size_t)(64 * i) * ld); kv[4 * i + 3] = ld8(Vp + (size_t)(64 * i + 32) * ld); }
#pragma unroll
    for (int i = 0; i < 4; ++i) { const int kc = sc * 2;
      *(bf16x8*)(K_lds + i * SHM_K + KSWZ(sr, kc)) = kv[4 * i]; *(bf16x8*)(K_lds + i * SHM_K + KSWZ(32 + sr, kc)) = kv[4 * i + 1];
      *(bf16x8*)(V_lds + i * SHM_V + vst0) = kv[4 * i + 2]; *(bf16x8*)(V_lds + i * SHM_V + vst1) = kv[4 * i + 3]; } }
  __syncthreads();
  const int vb0 = (int)(uintptr_t)V_lds + v_rd_base(lane);
  const int nwu = (rowend - row0 + 31) >> 5;
#pragma nounroll
  for (int wu = wid; wu < nwu; wu += NW) {
    const int r = row0 + wu * 32 + r32; const bool own = r < 256; const bool valid = r < rowend;
    int t, dst;
    if (own) { t = 256 * j + r; dst = (t * 12 + h) * 4 + 3; }
    else { const int rg = valid ? r - 256 : 0; int b = j + 1; while (b < 31 && rg >= segp[b + 1]) ++b;
      t = 256 * b + SEG[((size_t)(h * 32 + j) * 32 + b) * 256 + (rg - segp[b])];
      const unsigned rm = ROWMASK[(size_t)t * 12 + h]; dst = valid ? (t * 12 + h) * 4 + __popc(rm & ((1u << j) - 1u)) : -1; }
    bf16x8 qr[8];
    { const bf16* Qw = QKVM + (size_t)t * ld + h * 128 + hi * 8;
#pragma unroll
      for (int d0 = 0; d0 < 8; ++d0) qr[d0] = ld8(Qw + d0 * 16); }
    float m_reg = NEG, l_reg = 0; f32x16 o[4] = {};
    const int limbase = own ? (r - 4 * hi) : 4096;
    const int ntl = own ? ((row0 + wu * 32 + 31) >> 6) + 1 : 4;
#pragma nounroll
    for (int idx = 0; idx < ntl; ++idx) {
      f32x16 p0, p1; float mn, al; bf16x8 pa0, pa1, pa2, pa3;
      qkt<true>(p0, p1, K_lds + idx * SHM_K, qr, r32, hi, limbase - 64 * idx);
      partialSM(p0, p1, m_reg, mn, al);
      if (__any(al < 1.f)) { if (hi == 0) al_l[r32] = al; asm volatile("s_waitcnt lgkmcnt(0)" ::: "memory");
#pragma unroll
        for (int d = 0; d < 4; ++d)
#pragma unroll
          for (int rr = 0; rr < 16; ++rr) o[d][rr] *= al_l[crow(rr, hi)]; }
      finishSM(p0, p1, al, l_reg, pa0, pa1, pa2, pa3); SBAR();
      pv_il(o, vb0 + idx * SHM_V, pa0, pa1, pa2, pa3);
    }
    if (hi == 0) { li_l[r32] = l_reg; dst_l[r32] = dst; if (dst >= 0) { PARTML[2 * (size_t)dst] = m_reg; PARTML[2 * (size_t)dst + 1] = l_reg; } }
    asm volatile("s_waitcnt lgkmcnt(0)" ::: "memory");
#pragma unroll
    for (int rr = 0; rr < 16; ++rr) { const int row = crow(rr, hi); const int d = dst_l[row]; const float rl = __builtin_amdgcn_rcpf(li_l[row]);
      if (d >= 0) { bf16* op = PARTO + (size_t)d * 128 + r32;
#pragma unroll
        for (int d0 = 0; d0 < 4; ++d0) op[d0 * 32] = (bf16)(cvtpk(o[d0][rr] * rl, 0.f) & 0xffffu); } }
    asm volatile("s_waitcnt lgkmcnt(0)" ::: "memory");
  }
  __syncthreads();
}
constexpr int CVP = 4096, CV_B = 1536, CV_C = 2048, CV_XDT = 2560;
constexpr float LOG2E = 1.4426950408889634f;
__device__ __forceinline__ void ssd_state_unit(const bf16* __restrict__ CV, const float* __restrict__ ACS, float* __restrict__ STATES, int c, int h, char* lds) {
  const int tid = fresh_tid(), wid = tid >> 6, lane = tid & 63, r32 = lane & 31, hi = lane >> 5;
  const int g = h / 6; const long t0 = 256L * c;
  char* X_lds = lds; char* B_lds = lds + SHM_V; float* acs_lds = (float*)(lds + ACS_OFF);
  if (tid < 256) acs_lds[tid] = ACS[(c * 24 + h) * 256 + tid];
  const int sr = tid >> 4, sc = (tid & 15) * 8, vst0 = v_st(sr, sc), vst1 = v_st(32 + sr, sc);
  const int pb = wid & 1, nb = wid >> 1;
  const int xb = (int)(uintptr_t)X_lds + v_rd_base(lane) + pb * 512, bb = (int)(uintptr_t)B_lds + v_rd_base(lane) + nb * 512;
  bf16x8 xv0 = {}, xv1 = {}, kb0, kb1;
#define SLOAD(i) do { const bf16* rp = CV + (t0 + 64 * (i) + sr) * CVP; kb0 = ld8(rp + CV_B + g * 128 + sc); kb1 = ld8(rp + 32 * CVP + CV_B + g * 128 + sc); \
    if (sc < 64) { xv0 = ld8(rp + CV_XDT + h * 64 + sc); xv1 = ld8(rp + 32 * CVP + CV_XDT + h * 64 + sc); } } while (0)
  SLOAD(0);
  f32x16 acc = f32x16{};
#pragma nounroll
  for (int i = 0; i < 4; ++i) {
    __syncthreads();
    const float aend = acs_lds[255];
    if (sc < 64) {
      const float f0 = __builtin_amdgcn_exp2f((aend - acs_lds[64 * i + sr]) * LOG2E), f1 = __builtin_amdgcn_exp2f((aend - acs_lds[64 * i + 32 + sr]) * LOG2E);
      u32x4 w0, w1;
#pragma unroll
      for (int q = 0; q < 4; ++q) { w0[q] = cvtpk(bf2f((unsigned short)xv0[2 * q]) * f0, bf2f((unsigned short)xv0[2 * q + 1]) * f0);
                                    w1[q] = cvtpk(bf2f((unsigned short)xv1[2 * q]) * f1, bf2f((unsigned short)xv1[2 * q + 1]) * f1); }
      *(u32x4*)(X_lds + vst0) = w0; *(u32x4*)(X_lds + vst1) = w1;
    }
    *(bf16x8*)(B_lds + vst0) = kb0; *(bf16x8*)(B_lds + vst1) = kb1;
    if (i < 3) SLOAD(i + 1);
    __syncthreads();
    { const s16x4 al0 = tr_read<v_rd_off(0, 0, 0)>(xb), ah0 = tr_read<v_rd_off(0, 0, 1)>(xb), al1 = tr_read<v_rd_off(0, 1, 0)>(xb), ah1 = tr_read<v_rd_off(0, 1, 1)>(xb);
      const s16x4 al2 = tr_read<v_rd_off(0, 2, 0)>(xb), ah2 = tr_read<v_rd_off(0, 2, 1)>(xb), al3 = tr_read<v_rd_off(0, 3, 0)>(xb), ah3 = tr_read<v_rd_off(0, 3, 1)>(xb);
      const s16x4 bl0 = tr_read<v_rd_off(0, 0, 0)>(bb), bh0 = tr_read<v_rd_off(0, 0, 1)>(bb), bl1 = tr_read<v_rd_off(0, 1, 0)>(bb), bh1 = tr_read<v_rd_off(0, 1, 1)>(bb);
      const s16x4 bl2 = tr_read<v_rd_off(0, 2, 0)>(bb), bh2 = tr_read<v_rd_off(0, 2, 1)>(bb), bl3 = tr_read<v_rd_off(0, 3, 0)>(bb), bh3 = tr_read<v_rd_off(0, 3, 1)>(bb);
      asm volatile("s_waitcnt lgkmcnt(0)" ::: "memory"); SBAR();
      acc = __builtin_amdgcn_mfma_f32_32x32x16_bf16(ATT_PK(al0, ah0), ATT_PK(bl0, bh0), acc, 0, 0, 0);
      acc = __builtin_amdgcn_mfma_f32_32x32x16_bf16(ATT_PK(al1, ah1), ATT_PK(bl1, bh1), acc, 0, 0, 0);
      acc = __builtin_amdgcn_mfma_f32_32x32x16_bf16(ATT_PK(al2, ah2), ATT_PK(bl2, bh2), acc, 0, 0, 0);
      acc = __builtin_amdgcn_mfma_f32_32x32x16_bf16(ATT_PK(al3, ah3), ATT_PK(bl3, bh3), acc, 0, 0, 0); }
  }
#undef SLOAD
  float* Sp = STATES + ((long)(c * 24 + h) * 64 + 32 * pb) * 128 + 32 * nb + r32;
#pragma unroll
  for (int r = 0; r < 16; ++r) Sp[crow(r, hi) * 128] = acc[r];
  __syncthreads();
}
__device__ __forceinline__ void ssd_y_unit(const bf16* __restrict__ CV, const float* __restrict__ ACS, const bf16* __restrict__ PREV, float dsk, float* __restrict__ YS, int c, int h, char* lds) {
  const int tid = fresh_tid(), wid = tid >> 6, lane = tid & 63, r32 = lane & 31, hi = lane >> 5;
  const int g = h / 6; const long t0 = 256L * c;
  char* V_lds = lds; char* K_lds = lds + 2 * SHM_V; float* acs_lds = (float*)(lds + ACS_OFF);
  if (tid < 256) acs_lds[tid] = ACS[(c * 24 + h) * 256 + tid];
  const int lrow = wid * 32 + r32;
  const float acs_l = ACS[(c * 24 + h) * 256 + lrow];
  bf16x8 qr[8];
  { const bf16* Qw = CV + (t0 + lrow) * CVP + CV_C + g * 128 + hi * 8;
#pragma unroll
    for (int d0 = 0; d0 < 8; ++d0) qr[d0] = ld8(Qw + d0 * 16); }
  const int sr = tid >> 4, sc = (tid & 15) * 8, vst0 = v_st(sr, sc), vst1 = v_st(32 + sr, sc);
  const int vb0 = (int)(uintptr_t)V_lds + v_rd_base(lane);
  bf16x8 xv0 = {}, xv1 = {}, kb0, kb1;
#define SLOAD(i) do { const bf16* rp = CV + (t0 + 64 * (i) + sr) * CVP; kb0 = ld8(rp + CV_B + g * 128 + sc); kb1 = ld8(rp + 32 * CVP + CV_B + g * 128 + sc); \
    if (sc < 64) { xv0 = ld8(rp + CV_XDT + h * 64 + sc); xv1 = ld8(rp + 32 * CVP + CV_XDT + h * 64 + sc); } } while (0)
  SLOAD(0);
  f32x16 o[2] = {};
#pragma nounroll
  for (int i = 0; i < 4; ++i) {
    __syncthreads();
    { const int kc = sc * 2; *(bf16x8*)(K_lds + KSWZ(sr, kc)) = kb0; *(bf16x8*)(K_lds + KSWZ(32 + sr, kc)) = kb1; }
    if (sc < 64) { *(bf16x8*)(V_lds + vst0) = xv0; *(bf16x8*)(V_lds + vst1) = xv1; }
    if (i < 3) SLOAD(i + 1);
    __syncthreads();
    if (64 * i <= wid * 32 + 31) {
      f32x16 p0, p1; qkt<false>(p0, p1, K_lds, qr, r32, hi);
#pragma unroll
      for (int r = 0; r < 16; ++r) { const int s = 64 * i + crow(r, hi);
        const float e0 = __builtin_amdgcn_exp2f((acs_l - acs_lds[s]) * LOG2E), e1 = __builtin_amdgcn_exp2f((acs_l - acs_lds[s + 32]) * LOG2E);
        p0[r] = (s <= lrow) ? p0[r] * e0 : 0.f; p1[r] = (s + 32 <= lrow) ? p1[r] * e1 : 0.f; }
      bf16x8 pa0, pa1, pa2, pa3;
      ATT_PK4(p0, 0, pa0); ATT_PK4(p0, 8, pa1); ATT_PK4(p1, 0, pa2); ATT_PK4(p1, 8, pa3);
      pv_one<0>(o[0], vb0, pa0, pa1, pa2, pa3); pv_one<1>(o[1], vb0, pa0, pa1, pa2, pa3);
    }
  }
#undef SLOAD
  f32x16 o2[2] = {};
  { const bf16* Pp = PREV + ((long)(c * 24 + h) * 64 + r32) * 128 + hi * 8;
#pragma unroll
    for (int d0 = 0; d0 < 2; ++d0)
#pragma unroll
      for (int d = 0; d < 8; ++d) { const bf16x8 bfrag = ld8(Pp + d0 * 32 * 128 + d * 16);
        o2[d0] = __builtin_amdgcn_mfma_f32_32x32x16_bf16(qr[d], bfrag, o2[d0], 0, 0, 0); } }
  { const bf16* xp0 = CV + (t0 + wid * 32 + 4 * hi) * CVP + h * 64 + r32; float* yp0 = YS + (t0 + wid * 32 + 4 * hi) * 1536 + h * 64 + r32; const float* ap = acs_lds + wid * 32 + 4 * hi;
#pragma unroll
  for (int r = 0; r < 16; ++r) { const int ro = (r & 3) + 8 * (r >> 2); const float ea = __builtin_amdgcn_exp2f(ap[ro] * LOG2E);
    asm volatile("" ::: "memory");
#pragma unroll
    for (int d0 = 0; d0 < 2; ++d0) yp0[ro * 1536 + d0 * 32] = o[d0][r] + o2[d0][r] * ea + dsk * bf2f(xp0[ro * CVP + d0 * 32]); } }
  __syncthreads();
}
__device__ __forceinline__ void ssd_state_unit2(const bf16* __restrict__ CV, const float* __restrict__ ACS, float* __restrict__ STATES, int c, int h, char* lds, float* acs_lds) {
  const int tid = fresh_tid(), wid = tid >> 6, lane = tid & 63, r32 = lane & 31, hi = lane >> 5;
  const int g = h / 6; const long t0 = 256L * c;
  char* X_lds = lds; char* B_lds = lds + 4 * SHM_V;
  const float* acs_g = ACS + (c * 24 + h) * 256;
  const int sr = tid >> 4, sc = (tid & 15) * 8, vst0 = v_st(sr, sc), vst1 = v_st(32 + sr, sc);
  const int pb = wid & 1, nb = wid >> 1;
  const int xb = (int)(uintptr_t)X_lds + v_rd_base(lane) + pb * 512, bb = (int)(uintptr_t)B_lds + v_rd_base(lane) + nb * 512;
  { bf16x8 kb[8], xv[8]; const float aend = acs_g[255]; float f[8];
    const bf16* rp = CV + (t0 + sr) * CVP;
#pragma unroll
    for (int i = 0; i < 4; ++i) { kb[2 * i] = ld8(rp + (size_t)(64 * i) * CVP + CV_B + g * 128 + sc); kb[2 * i + 1] = ld8(rp + (size_t)(64 * i + 32) * CVP + CV_B + g * 128 + sc);
      if (sc < 64) { xv[2 * i] = ld8(rp + (size_t)(64 * i) * CVP + CV_XDT + h * 64 + sc); xv[2 * i + 1] = ld8(rp + (size_t)(64 * i + 32) * CVP + CV_XDT + h * 64 + sc);
        f[2 * i] = __builtin_amdgcn_exp2f((aend - acs_g[64 * i + sr]) * LOG2E); f[2 * i + 1] = __builtin_amdgcn_exp2f((aend - acs_g[64 * i + 32 + sr]) * LOG2E); } }
#pragma unroll
    for (int i = 0; i < 4; ++i) {
      *(bf16x8*)(B_lds + i * SHM_V + vst0) = kb[2 * i]; *(bf16x8*)(B_lds + i * SHM_V + vst1) = kb[2 * i + 1];
      if (sc < 64) { u32x4 w0, w1;
#pragma unroll
        for (int q = 0; q < 4; ++q) { w0[q] = cvtpk(bf2f((unsigned short)xv[2 * i][2 * q]) * f[2 * i], bf2f((unsigned short)xv[2 * i][2 * q + 1]) * f[2 * i]);
                                      w1[q] = cvtpk(bf2f((unsigned short)xv[2 * i + 1][2 * q]) * f[2 * i + 1], bf2f((unsigned short)xv[2 * i + 1][2 * q + 1]) * f[2 * i + 1]); }
        *(u32x4*)(X_lds + i * SHM_V + vst0) = w0; *(u32x4*)(X_lds + i * SHM_V + vst1) = w1; } } }
  __syncthreads();
  f32x16 acc = f32x16{};
#pragma unroll
  for (int i = 0; i < 4; ++i) {
    const int xo = xb + i * SHM_V, bo = bb + i * SHM_V;
    const s16x4 al0 = tr_read<v_rd_off(0, 0, 0)>(xo), ah0 = tr_read<v_rd_off(0, 0, 1)>(xo), al1 = tr_read<v_rd_off(0, 1, 0)>(xo), ah1 = tr_read<v_rd_off(0, 1, 1)>(xo);
    const s16x4 al2 = tr_read<v_rd_off(0, 2, 0)>(xo), ah2 = tr_read<v_rd_off(0, 2, 1)>(xo), al3 = tr_read<v_rd_off(0, 3, 0)>(xo), ah3 = tr_read<v_rd_off(0, 3, 1)>(xo);
    const s16x4 bl0 = tr_read<v_rd_off(0, 0, 0)>(bo), bh0 = tr_read<v_rd_off(0, 0, 1)>(bo), bl1 = tr_read<v_rd_off(0, 1, 0)>(bo), bh1 = tr_read<v_rd_off(0, 1, 1)>(bo);
    const s16x4 bl2 = tr_read<v_rd_off(0, 2, 0)>(bo), bh2 = tr_read<v_rd_off(0, 2, 1)>(bo), bl3 = tr_read<v_rd_off(0, 3, 0)>(bo), bh3 = tr_read<v_rd_off(0, 3, 1)>(bo);
    asm volatile("s_waitcnt lgkmcnt(0)" ::: "memory"); SBAR();
    acc = __builtin_amdgcn_mfma_f32_32x32x16_bf16(ATT_PK(al0, ah0), ATT_PK(bl0, bh0), acc, 0, 0, 0);
    acc = __builtin_amdgcn_mfma_f32_32x32x16_bf16(ATT_PK(al1, ah1), ATT_PK(bl1, bh1), acc, 0, 0, 0);
    acc = __builtin_amdgcn_mfma_f32_32x32x16_bf16(ATT_PK(al2, ah2), ATT_PK(bl2, bh2), acc, 0, 0, 0);
    acc = __builtin_amdgcn_mfma_f32_32x32x16_bf16(ATT_PK(al3, ah3), ATT_PK(bl3, bh3), acc, 0, 0, 0);
  }
  float* Sp = STATES + ((long)(c * 24 + h) * 64 + 32 * pb) * 128 + 32 * nb + r32;
#pragma unroll
  for (int r = 0; r < 16; ++r) Sp[crow(r, hi) * 128] = acc[r];
  __syncthreads();
}
__device__ __forceinline__ void ssd_y_unit2(const bf16* __restrict__ CV, const float* __restrict__ ACS, const bf16* __restrict__ PREV, float dsk, float* __restrict__ YS, int c, int h, char* lds, float* acs_lds) {
  const int tid = fresh_tid(), wid = tid >> 6, lane = tid & 63, r32 = lane & 31, hi = lane >> 5;
  const int g = h / 6; const long t0 = 256L * c;
  char* V_lds = lds; char* K_lds = lds + 4 * SHM_V;
  if (tid < 256) acs_lds[tid] = ACS[(c * 24 + h) * 256 + tid];
  const int lrow = wid * 32 + r32;
  const float acs_l = ACS[(c * 24 + h) * 256 + lrow];
  bf16x8 qr[8];
  { const bf16* Qw = CV + (t0 + lrow) * CVP + CV_C + g * 128 + hi * 8;
#pragma unroll
    for (int d0 = 0; d0 < 8; ++d0) qr[d0] = ld8(Qw + d0 * 16); }
  { const int sr = tid >> 4, sc = (tid & 15) * 8, vst0 = v_st(sr, sc), vst1 = v_st(32 + sr, sc);
    bf16x8 kb[8], xv[8]; const bf16* rp = CV + (t0 + sr) * CVP;
#pragma unroll
    for (int i = 0; i < 4; ++i) { kb[2 * i] = ld8(rp + (size_t)(64 * i) * CVP + CV_B + g * 128 + sc); kb[2 * i + 1] = ld8(rp + (size_t)(64 * i + 32) * CVP + CV_B + g * 128 + sc);
      if (sc < 64) { xv[2 * i] = ld8(rp + (size_t)(64 * i) * CVP + CV_XDT + h * 64 + sc); xv[2 * i + 1] = ld8(rp + (size_t)(64 * i + 32) * CVP + CV_XDT + h * 64 + sc); } }
#pragma unroll
    for (int i = 0; i < 4; ++i) { const int kc = sc * 2;
      *(bf16x8*)(K_lds + i * SHM_K + KSWZ(sr, kc)) = kb[2 * i]; *(bf16x8*)(K_lds + i * SHM_K + KSWZ(32 + sr, kc)) = kb[2 * i + 1];
      if (sc < 64) { *(bf16x8*)(V_lds + i * SHM_V + vst0) = xv[2 * i]; *(bf16x8*)(V_lds + i * SHM_V + vst1) = xv[2 * i + 1]; } } }
  __syncthreads();
  const int vb0 = (int)(uintptr_t)V_lds + v_rd_base(lane);
  f32x16 o[2] = {};
  const int ntile = (wid * 32 + 31) / 64 + 1;
#pragma nounroll
  for (int i = 0; i < ntile; ++i) {
    f32x16 p0, p1; qkt<false>(p0, p1, K_lds + i * SHM_K, qr, r32, hi);
#pragma unroll
    for (int r = 0; r < 16; ++r) { const int s = 64 * i + crow(r, hi);
      const float e0 = __builtin_amdgcn_exp2f((acs_l - acs_lds[s]) * LOG2E), e1 = __builtin_amdgcn_exp2f((acs_l - acs_lds[s + 32]) * LOG2E);
      p0[r] = (s <= lrow) ? p0[r] * e0 : 0.f; p1[r] = (s + 32 <= lrow) ? p1[r] * e1 : 0.f; }
    bf16x8 pa0, pa1, pa2, pa3;
    ATT_PK4(p0, 0, pa0); ATT_PK4(p0, 8, pa1); ATT_PK4(p1, 0, pa2); ATT_PK4(p1, 8, pa3);
    pv_one<0>(o[0], vb0 + i * SHM_V, pa0, pa1, pa2, pa3); pv_one<1>(o[1], vb0 + i * SHM_V, pa0, pa1, pa2, pa3);
  }
  f32x16 o2[2] = {};
  { const bf16* Pp = PREV + ((long)(c * 24 + h) * 64 + r32) * 128 + hi * 8;
#pragma unroll
    for (int d0 = 0; d0 < 2; ++d0)
#pragma unroll
      for (int d = 0; d < 8; ++d) { const bf16x8 bfrag = ld8(Pp + d0 * 32 * 128 + d * 16);
        o2[d0] = __builtin_amdgcn_mfma_f32_32x32x16_bf16(qr[d], bfrag, o2[d0], 0, 0, 0); } }
  { const bf16* xp0 = CV + (t0 + wid * 32 + 4 * hi) * CVP + h * 64 + r32; float* yp0 = YS + (t0 + wid * 32 + 4 * hi) * 1536 + h * 64 + r32; const float* ap = acs_lds + wid * 32 + 4 * hi;
  unsigned short xs0[16], xs1[16];
#pragma unroll
  for (int r = 0; r < 16; ++r) { const int ro = (r & 3) + 8 * (r >> 2); xs0[r] = xp0[ro * CVP]; xs1[r] = xp0[ro * CVP + 32]; }
#pragma unroll
  for (int r = 0; r < 16; ++r) { const int ro = (r & 3) + 8 * (r >> 2); const float ea = __builtin_amdgcn_exp2f(ap[ro] * LOG2E);
    yp0[ro * 1536] = o[0][r] + o2[0][r] * ea + dsk * bf2f(xs0[r]); yp0[ro * 1536 + 32] = o[1][r] + o2[1][r] * ea + dsk * bf2f(xs1[r]); } }
  __syncthreads();
}
__device__ __forceinline__ void ssd_y_units(const bf16* __restrict__ CV, const float* __restrict__ ACS, const bf16* __restrict__ PREV, const float* __restrict__ dskp, float* __restrict__ YS,
                                            int u0, int ustep, char* lds, float* acs_lds) {
  const int tid = fresh_tid(), wid = tid >> 6, lane = tid & 63, r32 = lane & 31, hi = lane >> 5;
  char* V_lds = lds; char* K_lds = lds + 4 * SHM_V;
  const int lrow = wid * 32 + r32;
  const int sr = tid >> 4, sc = (tid & 15) * 8, vst0 = v_st(sr, sc), vst1 = v_st(32 + sr, sc);
  const int vb0 = (int)(uintptr_t)V_lds + v_rd_base(lane);
  const int ntile = (wid * 32 + 31) / 64 + 1;
  const int sr2 = tid >> 3, sc2 = (tid & 7) * 8, vst2 = v_st(sr2, sc2);
  bf16x8 kbn[8], xvn[4], qn[8]; float acsn = 0.f, acsln = 0.f;
#define YU_LOAD(u_) do { const int c_ = (u_) / 24, h_ = (u_) % 24, g_ = h_ / 6; const long t0_ = 256L * c_; const bf16* rp_ = CV + (t0_ + sr) * CVP; \
    _Pragma("unroll") for (int i = 0; i < 4; ++i) { kbn[2 * i] = ld8(rp_ + (size_t)(64 * i) * CVP + CV_B + g_ * 128 + sc); kbn[2 * i + 1] = ld8(rp_ + (size_t)(64 * i + 32) * CVP + CV_B + g_ * 128 + sc); \
      xvn[i] = ld8(CV + (t0_ + 64 * i + sr2) * CVP + CV_XDT + h_ * 64 + sc2); } \
    { const bf16* Qw_ = CV + (t0_ + lrow) * CVP + CV_C + g_ * 128 + hi * 8; _Pragma("unroll") for (int d0 = 0; d0 < 8; ++d0) qn[d0] = ld8(Qw_ + d0 * 16); } \
    acsn = ACS[(c_ * 24 + h_) * 256 + (tid & 255)]; acsln = ACS[(c_ * 24 + h_) * 256 + lrow]; } while (0)
  if (u0 < 768) YU_LOAD(u0);
#pragma nounroll
  for (int u = u0; u < 768; u += ustep) {
    const int c = u / 24, h = u % 24; const long t0 = 256L * c; const float dsk = dskp[h];
    bf16x8 qr[8]; const float acs_l = acsln;
#pragma unroll
    for (int d0 = 0; d0 < 8; ++d0) qr[d0] = qn[d0];
    if (tid < 256) acs_lds[tid] = acsn;
#pragma unroll
    for (int i = 0; i < 4; ++i) { const int kc = sc * 2;
      *(bf16x8*)(K_lds + i * SHM_K + KSWZ(sr, kc)) = kbn[2 * i]; *(bf16x8*)(K_lds + i * SHM_K + KSWZ(32 + sr, kc)) = kbn[2 * i + 1];
      *(bf16x8*)(V_lds + i * SHM_V + vst2) = xvn[i]; }
    __syncthreads();
    if (u + ustep < 768) YU_LOAD(u + ustep);
    f32x16 o[2] = {};
#pragma nounroll
    for (int i = 0; i < ntile; ++i) {
      f32x16 p0, p1; qkt<false>(p0, p1, K_lds + i * SHM_K, qr, r32, hi);
#pragma unroll
      for (int r = 0; r < 16; ++r) { const int s = 64 * i + crow(r, hi);
        const float e0 = __builtin_amdgcn_exp2f((acs_l - acs_lds[s]) * LOG2E), e1 = __builtin_amdgcn_exp2f((acs_l - acs_lds[s + 32]) * LOG2E);
        p0[r] = (s <= lrow) ? p0[r] * e0 : 0.f; p1[r] = (s + 32 <= lrow) ? p1[r] * e1 : 0.f; }
      bf16x8 pa0, pa1, pa2, pa3;
      ATT_PK4(p0, 0, pa0); ATT_PK4(p0, 8, pa1); ATT_PK4(p1, 0, pa2); ATT_PK4(p1, 8, pa3);
      pv_one<0>(o[0], vb0 + i * SHM_V, pa0, pa1, pa2, pa3); pv_one<1>(o[1], vb0 + i * SHM_V, pa0, pa1, pa2, pa3);
    }
    f32x16 o2[2] = {};
    { const bf16* Pp = PREV + ((long)(c * 24 + h) * 64 + r32) * 128 + hi * 8;
#pragma unroll
      for (int d0 = 0; d0 < 2; ++d0)
#pragma unroll
        for (int d = 0; d < 8; ++d) { const bf16x8 bfrag = ld8(Pp + d0 * 32 * 128 + d * 16);
          o2[d0] = __builtin_amdgcn_mfma_f32_32x32x16_bf16(qr[d], bfrag, o2[d0], 0, 0, 0); } }
    { const bf16* xp0 = CV + (t0 + wid * 32 + 4 * hi) * CVP + h * 64 + r32; float* yp0 = YS + (t0 + wid * 32 + 4 * hi) * 1536 + h * 64 + r32; const float* ap = acs_lds + wid * 32 + 4 * hi;
      unsigned short xs0[16], xs1[16];
#pragma unroll
      for (int r = 0; r < 16; ++r) { const int ro = (r & 3) + 8 * (r >> 2); xs0[r] = xp0[ro * CVP]; xs1[r] = xp0[ro * CVP + 32]; }
#pragma unroll
      for (int r = 0; r < 16; ++r) { const int ro = (r & 3) + 8 * (r >> 2); const float ea = __builtin_amdgcn_exp2f(ap[ro] * LOG2E);
        yp0[ro * 1536] = o[0][r] + o2[0][r] * ea + dsk * bf2f(xs0[r]); yp0[ro * 1536 + 32] = o[1][r] + o2[1][r] * ea + dsk * bf2f(xs1[r]); } }
    __syncthreads();
  }
#undef YU_LOAD
}
#undef KSWZ
#undef SBAR
#undef ATT_PK
#undef ATT_PK4
}
constexpr int T = 8192, DM = 2048, DFF = 7168, NEXP = 8, MEML = 256;
constexpr int N_IN0 = 5120, N_IN1 = 4864, N_IN1_REAL = 4632;
constexpr int MOE_ROWS = 72 * 256;
constexpr float LN_EPS = 1e-5f, RMS_EPS = 1e-5f, DN_ALPHA = 1.41421356237309515f;
constexpr int NWAVES = 8;
#ifndef MK_PER_PHASE
#define MK_PER_PHASE 0
#endif
constexpr int NPHASE = 24;

constexpr size_t MiB = 1u << 20;
constexpr size_t WS_CTL = 0, CTL_ZERO_BYTES = 1 * MiB;
constexpr size_t WS_ROPE = 1 * MiB, WS_KMEAN = 2 * MiB, WS_DTR = 3 * MiB, WS_ACS = 4 * MiB;
constexpr size_t WS_TOKE = 5 * MiB, WS_TOKW = 5 * MiB + 65536, WS_POS = 5 * MiB + 131072, WS_COUNTS = 5 * MiB + 262144;
constexpr size_t WS_MEMB = 6 * MiB, WS_MEMKV = 7 * MiB;
constexpr size_t WS_WMKV = 8 * MiB, WS_WIN0 = WS_WMKV + 4 * MiB, WS_WO0 = WS_WIN0 + 20 * MiB, WS_WGU0 = WS_WO0 + 8 * MiB, WS_WD0 = WS_WGU0 + 56 * MiB;
constexpr size_t WS_WIN1 = WS_WD0 + 28 * MiB, WS_WO1 = WS_WIN1 + 19 * MiB, WS_WGUE = WS_WO1 + 8 * MiB, WS_WDE = WS_WGUE + 448 * MiB, WS_WEND = WS_WDE + 224 * MiB;
constexpr size_t WS_XCUR = WS_WEND + 1 * MiB, WS_XCURB = WS_XCUR + 64 * MiB, WS_HEADS = WS_XCURB + 32 * MiB, WS_YF = WS_HEADS + 32 * MiB;
constexpr size_t WS_RA = WS_YF + 64 * MiB, WS_RB = WS_RA + 252 * MiB, WS_RC = WS_RB + 144 * MiB;
constexpr size_t WS_STATES = WS_RC + 72 * MiB, WS_PREV = WS_STATES + 24 * MiB, WS_YSSD = WS_PREV + 12 * MiB, WS_END = WS_YSSD + 48 * MiB;
static_assert((size_t)N_IN1 * DM * 2 <= 19 * MiB && (size_t)MOE_ROWS * DFF * 2 <= 252 * MiB && (size_t)MOE_ROWS * DM * 4 <= 144 * MiB && (size_t)MOE_ROWS * DM * 2 <= 72 * MiB, "ws map");
constexpr size_t WS_ROWMASK = WS_YSSD, WS_CNT = WS_YSSD + 1 * MiB, WS_SEG = WS_YSSD + 2 * MiB;
constexpr int CW_TMO = 0, CW_BAR = 4096;

constexpr int RING_OFF = 0, RING_BYTES = 131072;
constexpr int LDSCTL_OFF = RING_BYTES, MISC_OFF = LDSCTL_OFF + 320;
constexpr int LDS_BYTES = 147456;

#define GAS __attribute__((address_space(1)))
#define LAS __attribute__((address_space(3)))
typedef unsigned short bf16;
typedef unsigned v4u __attribute__((ext_vector_type(4)));
typedef unsigned v2u __attribute__((ext_vector_type(2)));
typedef float f32x4 __attribute__((ext_vector_type(4)));
typedef short bf16x8 __attribute__((ext_vector_type(8)));
typedef GAS unsigned gu32;
#define RLX_AGENT __ATOMIC_RELAXED, __HIP_MEMORY_SCOPE_AGENT
#define LDS_WAIT() asm volatile("s_waitcnt lgkmcnt(0)" ::: "memory")
__device__ __forceinline__ unsigned pk2(float lo, float hi) { unsigned r; asm volatile("v_cvt_pk_bf16_f32 %0, %1, %2" : "=v"(r) : "v"(lo), "v"(hi)); return r; }
__device__ __forceinline__ float bf2f(unsigned short b) { return __uint_as_float(((unsigned)b) << 16); }
__device__ __forceinline__ float bflo(unsigned w) { return __uint_as_float(w << 16); }
__device__ __forceinline__ float bfhi(unsigned w) { return __uint_as_float(w & 0xffff0000u); }
__device__ __forceinline__ float wave_sum(float v) {
#pragma unroll
    for (int o = 1; o < 64; o <<= 1) v += __shfl_xor(v, o);
    return v;
}
__device__ __forceinline__ float silu_f(float g) { return g * __builtin_amdgcn_rcpf(1.0f + __builtin_amdgcn_exp2f(-1.4426950408889634f * g)); }
__device__ __forceinline__ float softplus_f(float x) { return x > 20.f ? x : log1pf(__expf(x)); }
#define XB_TMO      128
#define XB_XCNT(j)  (256  + 64 * (j))
#define XB_XSUB(j)  (1280 + 64 * (j))
#define XB_XGEN(j)  (2304 + 64 * (j))
#define XB_TOP      3328
#define XB_TOPGEN   3392
#define XCD_BAR_WORDS 3456
#define XB_SPIN_CAP (1u << 18)

__device__ __forceinline__ unsigned xb_ld(unsigned* p)              { return __hip_atomic_load(p, __ATOMIC_RELAXED, __HIP_MEMORY_SCOPE_AGENT); }
__device__ __forceinline__ unsigned xb_add(unsigned* p, unsigned v) { return __hip_atomic_fetch_add(p, v, __ATOMIC_RELAXED, __HIP_MEMORY_SCOPE_AGENT); }
__device__ __forceinline__ unsigned xb_xcc_id() { return (unsigned)__builtin_amdgcn_s_getreg((3 << 11) | 20) & 0xFu; }
#define XB_SPIN(cond, bar) do { unsigned _sp = 0; while (cond) { __builtin_amdgcn_s_sleep(1); \
    if ((++_sp & 255u) == 0u) { if (xb_ld(&(bar)[XB_TMO])) break; if (_sp > XB_SPIN_CAP) { atomicAdd(&(bar)[XB_TMO], 1u); break; } } } } while (0)

struct XcdBarrier {
    unsigned* bar; unsigned x; int w;
    volatile LAS unsigned* st;
};

__device__ __forceinline__ XcdBarrier xcd_barrier_post(unsigned* bar, volatile LAS unsigned* st, int wave) {
    XcdBarrier b; b.bar = bar; b.x = xb_xcc_id(); b.st = st; b.w = wave;
    if (threadIdx.x == 0) (void)xb_add(&bar[XB_XCNT(b.x)], 1u);
    return b;
}
__device__ __forceinline__ void xcd_barrier_complete(unsigned* bar, unsigned x, unsigned& nloc, unsigned& nx) {
    const unsigned G = gridDim.x * gridDim.y * gridDim.z;
    unsigned sum, cnt, mine, sp = 0u;
    for (;;) {
        sum = 0u; cnt = 0u; mine = 0u;
#pragma unroll
        for (unsigned j = 0; j < 16; ++j) { const unsigned c = xb_ld(&bar[XB_XCNT(j)]); sum += c; cnt += (c > 0u) ? 1u : 0u; mine = (j == x) ? c : mine; }
        if (sum == G) break;
        __builtin_amdgcn_s_sleep(1);
        if ((++sp & 255u) == 0u) { if (xb_ld(&bar[XB_TMO])) break; if (sp > XB_SPIN_CAP) { atomicAdd(&bar[XB_TMO], 1u); break; } }
    }
    nloc = mine > 0u ? mine : 1u; nx = cnt > 0u ? cnt : 1u;
}

__device__ __forceinline__ void xcd_barrier(const XcdBarrier& b) {
    asm volatile("s_waitcnt vmcnt(0)" ::: "memory");
    __syncthreads();
    unsigned z_; asm volatile("s_mov_b32 %0, 0" : "=s"(z_));
    if (b.w == 0 && __builtin_amdgcn_mbcnt_hi(~0u, __builtin_amdgcn_mbcnt_lo(~0u, z_)) == 0u) {
        unsigned* bar = b.bar;
        __builtin_amdgcn_s_waitcnt(0);
        unsigned nloc = b.st[0], nx = b.st[1];
        if (nloc == 0u) { xcd_barrier_complete(bar, b.x, nloc, nx); b.st[0] = nloc; b.st[1] = nx; }
        const unsigned old = xb_add(&bar[XB_XSUB(b.x)], 1u);
        const unsigned gen = old / nloc;
        if (old + 1u == (gen + 1u) * nloc) {
            __builtin_amdgcn_fence(__ATOMIC_RELEASE, "agent");
            asm volatile("s_waitcnt vmcnt(0)" ::: "memory");
            const unsigned og = xb_add(&bar[XB_TOP], 1u);
            const unsigned tg = og / nx;
            if (og + 1u == (tg + 1u) * nx) xb_add(&bar[XB_TOPGEN], 1u);
            else XB_SPIN(xb_ld(&bar[XB_TOPGEN]) == tg, bar);
            __builtin_amdgcn_fence(__ATOMIC_ACQUIRE, "agent");
            xb_add(&bar[XB_XGEN(b.x)], 1u);
            asm volatile("s_waitcnt vmcnt(0)" ::: "memory");
        } else {
            XB_SPIN(xb_ld(&bar[XB_XGEN(b.x)]) == gen, bar);
            __builtin_amdgcn_fence(__ATOMIC_ACQUIRE, "agent");
            asm volatile("s_waitcnt vmcnt(0)" ::: "memory");
        }
    }
    __syncthreads();
}

struct Args { const void* in[29]; float* out; unsigned char* ws; int ph_lo, ph_hi; };
struct Frame {
    LAS unsigned char* lds; char* ldsg; volatile LAS unsigned* MISC; gu32* ctl;
    int tid, lane, wave, G, gw, NGW;
};

__device__ __forceinline__ int dest_row(int mode, int n) {
    if (mode == 1) return ((n >> 7) << 8) + (n & 127);
    if (mode == 2) return ((n >> 7) << 8) + 128 + (n & 127);
    if (mode == 3) return n < 4096 ? n : (n < 4120 ? 4608 + (n - 4096) : 4096 + (n - 4120));
    if (mode == 4) { const int c = n & 127; return (n < 3072 && c < 32) ? (n & ~127) + 2 * (c & 15) + (c >> 4) : n; }
    return n;
}
struct CvItem { const float* W; bf16* WT; int K, N, mode, loc, fp8; };
__device__ __forceinline__ void cv_load(const CvItem& c, f32x4 (&v)[8], int lane) {
    const int nblk = (c.N + 31) >> 5, kb = c.loc / nblk, nb = c.loc - kb * nblk, k0 = 64 * kb, n0 = 32 * nb;
    const int col = n0 + (lane & 7) * 4; const int colc = col < c.N ? col : c.N - 4;
    const int r0 = c.fp8 ? 8 * (lane >> 3) : (lane >> 3); const size_t st = c.fp8 ? (size_t)c.N : (size_t)8 * c.N;
    const float* src = c.W + (size_t)(k0 + r0) * c.N + colc;
#pragma unroll
    for (int i = 0; i < 8; ++i) v[i] = __builtin_nontemporal_load((const f32x4*)(src + (size_t)i * st));
}
__device__ __forceinline__ void cv_store(const CvItem& c, const f32x4 (&v)[8], LAS float* scr, int lane) {
    const int nblk = (c.N + 31) >> 5, kb = c.loc / nblk, nb = c.loc - kb * nblk, k0 = 64 * kb, n0 = 32 * nb;
    if (c.fp8) {
        const float sc_ = __builtin_ldexpf(1.0f, c.fp8); const int dbl = c.mode ? 1 : 0, off = (c.mode >> 1) << 7;
        const int rowb = ((n0 >> 7) << (7 + dbl)) + off + (n0 & 127) + 4 * (lane & 7);
        unsigned char* pq = (unsigned char*)c.WT + (size_t)rowb * c.K + k0 + 8 * (lane >> 3);
#pragma unroll
        for (int cc = 0; cc < 4; ++cc) { int w0 = 0, w1 = 0;
            w0 = __builtin_amdgcn_cvt_pk_fp8_f32(v[0][cc] * sc_, v[1][cc] * sc_, w0, false); w0 = __builtin_amdgcn_cvt_pk_fp8_f32(v[2][cc] * sc_, v[3][cc] * sc_, w0, true);
            w1 = __builtin_amdgcn_cvt_pk_fp8_f32(v[4][cc] * sc_, v[5][cc] * sc_, w1, false); w1 = __builtin_amdgcn_cvt_pk_fp8_f32(v[6][cc] * sc_, v[7][cc] * sc_, w1, true);
            *(v2u*)(pq + (size_t)cc * c.K) = (v2u){(unsigned)w0, (unsigned)w1}; }
        return; }
    { LAS float* wp = scr + (lane >> 3) * 33 + (lane & 7) * 4;
#pragma unroll
      for (int i = 0; i < 8; ++i) { wp[(8 * i) * 33 + 0] = v[i][0]; wp[(8 * i) * 33 + 1] = v[i][1]; wp[(8 * i) * 33 + 2] = v[i][2]; wp[(8 * i) * 33 + 3] = v[i][3]; } }
    LDS_WAIT(); asm volatile("" ::: "memory");
    const int cc = lane & 7;
#pragma unroll
    for (int j = 0; j < 4; ++j) { const int nn = (lane >> 3) + 8 * j; const LAS float* s = scr + (8 * cc) * 33 + nn;
        v4u o; o.x = pk2(s[0 * 33], s[1 * 33]); o.y = pk2(s[2 * 33], s[3 * 33]); o.z = pk2(s[4 * 33], s[5 * 33]); o.w = pk2(s[6 * 33], s[7 * 33]);
        if (n0 + nn < c.N) __builtin_nontemporal_store(o, (v4u*)(c.WT + (size_t)dest_row(c.mode, n0 + nn) * c.K + k0 + 8 * cc)); }
    LDS_WAIT(); asm volatile("" ::: "memory");
}
constexpr int CV_I_MKV = 32 * 32, CV_I_IN0 = 32 * 160, CV_I_O = 32 * 64, CV_I_GU = 32 * 224, CV_I_D = 112 * 64, CV_I_IN1 = 32 * 145;
constexpr int CV_B1 = CV_I_MKV, CV_B2 = CV_B1 + CV_I_IN0, CV_B3 = CV_B2 + CV_I_O, CV_B4 = CV_B3 + CV_I_GU, CV_B5 = CV_B4 + CV_I_GU, CV_B6 = CV_B5 + CV_I_D, CV_B7 = CV_B6 + CV_I_IN1, CV_B8 = CV_B7 + CV_I_O;
constexpr int CV_NITEMS = CV_B8 + 24 * 7168;
constexpr int CV_C1A = CV_B3 + 10 * 2048, CV_C1 = CV_C1A + 20 * 1024, CV_C2 = CV_C1 + 25 * 2048, CV_C3 = CV_C2 + 10 * 2048, CV_C4 = CV_NITEMS - 8 * 7168, CV_C4A = CV_C4 - 20 * 1280;
static_assert(CV_C1 >= CV_B8 && CV_C4A >= CV_C3 && CV_C4 >= CV_B8 + 16 * 7168, "dense weights are converted before the FFN phase, expert gate/up weights before the expert phase");
__device__ __forceinline__ CvItem cv_decode(const Args& A, int it) {
    unsigned char* ws = A.ws; CvItem c; c.fp8 = 0;
    constexpr int B1 = CV_B1, B2 = CV_B2, B3 = CV_B3, B4 = CV_B4, B5 = CV_B5, B6 = CV_B6, B7 = CV_B7, B8 = CV_B8;
    if (it < B1)      { c.W = (const float*)A.in[3];  c.K = DM; c.N = 1024; c.WT = (bf16*)(ws + WS_WMKV); c.mode = 0; c.loc = it; }
    else if (it < B2) { c.W = (const float*)A.in[4];  c.K = DM; c.N = N_IN0; c.WT = (bf16*)(ws + WS_WIN0); c.mode = 4; c.loc = it - B1; }
    else if (it < B3) { c.W = (const float*)A.in[5];  c.K = DM; c.N = DM; c.WT = (bf16*)(ws + WS_WO0); c.mode = 0; c.loc = it - B2; }
    else if (it < B4) { c.W = (const float*)A.in[8];  c.K = DM; c.N = DFF; c.WT = (bf16*)(ws + WS_WGU0); c.mode = 1; c.loc = it - B3; c.fp8 = 6; }
    else if (it < B5) { c.W = (const float*)A.in[9];  c.K = DM; c.N = DFF; c.WT = (bf16*)(ws + WS_WGU0); c.mode = 2; c.loc = it - B4; c.fp8 = 6; }
    else if (it < B6) { c.W = (const float*)A.in[10]; c.K = DFF; c.N = DM; c.WT = (bf16*)(ws + WS_WD0); c.mode = 0; c.loc = it - B5; c.fp8 = 7; }
    else if (it < B7) { c.W = (const float*)A.in[13]; c.K = DM; c.N = N_IN1_REAL; c.WT = (bf16*)(ws + WS_WIN1); c.mode = 3; c.loc = it - B6; }
    else if (it < B8) { c.W = (const float*)A.in[20]; c.K = DM; c.N = DM; c.WT = (bf16*)(ws + WS_WO1); c.mode = 0; c.loc = it - B7; }
    else { const int r = it - B8, r2 = r / 7168, kind = r2 >> 3, e = r2 & 7; c.loc = r - r2 * 7168;
        if (kind == 0)      { c.W = (const float*)A.in[24] + (size_t)e * DM * DFF; c.K = DM; c.N = DFF; c.WT = (bf16*)(ws + WS_WGUE + (size_t)e * 2 * DFF * DM); c.mode = 1; c.fp8 = 6; }
        else if (kind == 1) { c.W = (const float*)A.in[25] + (size_t)e * DM * DFF; c.K = DM; c.N = DFF; c.WT = (bf16*)(ws + WS_WGUE + (size_t)e * 2 * DFF * DM); c.mode = 2; c.fp8 = 6; }
        else                { c.W = (const float*)A.in[26] + (size_t)e * DFF * DM; c.K = DFF; c.N = DM; c.WT = (bf16*)(ws + WS_WDE + (size_t)e * DM * DFF); c.mode = 0; c.fp8 = 7; } }
    return c;
}
__device__ __forceinline__ void convert_items(Frame& F, const Args& A, int lo_, int hi_, int gwl, int ngwl) {
    LAS float* scr = (LAS float*)(F.lds + RING_OFF + F.wave * 16384);
    int it = lo_ + gwl; if (it >= hi_) return;
    f32x4 va[8], vb[8], vc[8], vd[8];
#define CV_LD(buf, idx) do { if ((idx) < hi_) { const CvItem c_ = cv_decode(A, (idx)); cv_load(c_, buf, F.lane); } } while (0)
#define CV_ST(buf, idx) do { const CvItem c_ = cv_decode(A, (idx)); cv_store(c_, buf, scr, F.lane); } while (0)
    CV_LD(va, it); CV_LD(vb, it + ngwl); CV_LD(vc, it + 2 * ngwl); CV_LD(vd, it + 3 * ngwl);
    for (;;) {
        CV_ST(va, it); CV_LD(va, it + 4 * ngwl); if (it + ngwl >= hi_) break;
        CV_ST(vb, it + ngwl); CV_LD(vb, it + 5 * ngwl); if (it + 2 * ngwl >= hi_) break;
        CV_ST(vc, it + 2 * ngwl); CV_LD(vc, it + 6 * ngwl); if (it + 3 * ngwl >= hi_) break;
        CV_ST(vd, it + 3 * ngwl); CV_LD(vd, it + 7 * ngwl); if (it + 4 * ngwl >= hi_) break;
        it += 4 * ngwl;
    }
#undef CV_LD
#undef CV_ST
}
__device__ __forceinline__ void p0_prologue(Frame& F, const Args& A) {
    unsigned char* ws = A.ws;
    convert_items(F, A, 0, CV_B3, F.gw, F.NGW);
    const int gid = blockIdx.x * 512 + F.tid, NT_ = F.G * 512;
    { const float* x = (const float*)A.in[0]; const float* mem = (const float*)A.in[1]; bf16* xb = (bf16*)(ws + WS_XCURB); bf16* mb = (bf16*)(ws + WS_MEMB);
      constexpr int NX8 = T * DM / 8, NM8 = MEML * DM / 8;
      for (int i0 = gid; i0 < NX8 + NM8; i0 += 4 * NT_) { f32x4 a[4], b[4];
#pragma unroll
          for (int q = 0; q < 4; ++q) { const int i = i0 + q * NT_; const int ic = i < NX8 + NM8 ? i : i0; const bool ix = ic < NX8; const int j = ix ? ic : ic - NX8; const float* s = (ix ? x : mem) + (size_t)j * 8;
              a[q] = __builtin_nontemporal_load((const f32x4*)s); b[q] = __builtin_nontemporal_load((const f32x4*)(s + 4)); }
#pragma unroll
          for (int q = 0; q < 4; ++q) { const int i = i0 + q * NT_; if (i < NX8 + NM8) { const bool ix = i < NX8; const int j = ix ? i : i - NX8;
              v4u o = {pk2(a[q][0], a[q][1]), pk2(a[q][2], a[q][3]), pk2(b[q][0], b[q][1]), pk2(b[q][2], b[q][3])};
              *(v4u*)((ix ? xb : mb) + (size_t)j * 8) = o; } } } }
    { v4u z = {0u, 0u, 0u, 0u}; v4u* p = (v4u*)((bf16*)(ws + WS_WIN1) + (size_t)N_IN1_REAL * DM); constexpr int NZ = (N_IN1 - N_IN1_REAL) * DM / 8;
      for (int i = gid; i < NZ; i += NT_) p[i] = z; }
    { const int* pos = (const int*)A.in[2]; float* rope = (float*)(ws + WS_ROPE);
      for (int i = gid; i < T * 16; i += NT_) { const int t = i >> 4, j = i & 15;
          const float inv = (float)exp(-((double)j / 16.0) * 13.122363377404328);
          const float ang = (float)pos[t] * inv;
          double rev = (double)ang * 0.15915494309189535; rev -= floor(rev);
          const double x = rev * 6.283185307179586; const double q = rint(x * 0.6366197723675814); const double y = x - q * 1.5707963267948966; const double y2 = y * y;
          const double sn = y * (1.0 + y2 * (-1.0 / 6 + y2 * (1.0 / 120 + y2 * (-1.0 / 5040 + y2 * (1.0 / 362880 + y2 * (-1.0 / 39916800 + y2 * (1.0 / 6227020800.0)))))));
          const double cs = 1.0 + y2 * (-0.5 + y2 * (1.0 / 24 + y2 * (-1.0 / 720 + y2 * (1.0 / 40320 + y2 * (-1.0 / 3628800 + y2 * (1.0 / 479001600.0))))));
          const int qi = ((int)q) & 3; double s, c;
          if (qi == 0) { s = sn; c = cs; } else if (qi == 1) { s = cs; c = -sn; } else if (qi == 2) { s = -sn; c = -cs; } else { s = -cs; c = sn; }
          rope[2 * i] = (float)c; rope[2 * i + 1] = (float)s; } }
}

__device__ __forceinline__ void rot8(v4u& a, v4u& b, const float* __restrict__ cs) {
    unsigned ao[4], bo[4]; const unsigned aw[4] = {a.x, a.y, a.z, a.w}, bw[4] = {b.x, b.y, b.z, b.w};
#pragma unroll
    for (int q = 0; q < 4; ++q) { const f32x4 t = *(const f32x4*)(cs + 4 * q);
        const float x1a = bflo(aw[q]), x1b = bfhi(aw[q]), x2a = bflo(bw[q]), x2b = bfhi(bw[q]);
        ao[q] = pk2(x1a * t[0] - x2a * t[1], x1b * t[2] - x2b * t[3]); bo[q] = pk2(x2a * t[0] + x1a * t[1], x2b * t[2] + x1b * t[3]); }
    a = (v4u){ao[0], ao[1], ao[2], ao[3]}; b = (v4u){bo[0], bo[1], bo[2], bo[3]};
}
__device__ __forceinline__ void p2_rotary_kmean(Frame& F, unsigned char* ws) {
    bf16* QKVM = (bf16*)(ws + WS_RB); const float* rope = (const float*)(ws + WS_ROPE); float* KMEAN = (float*)(ws + WS_KMEAN);
    { const int gid = blockIdx.x * 512 + F.tid, NT_ = F.G * 512;
      for (int i = gid; i < T * 24; i += NT_) { const int t = i / 24, r = i - t * 24, h = r >> 1, c = r & 1;
          bf16* p = QKVM + (size_t)t * N_IN0 + h * 128 + 8 * c; v4u a = *(v4u*)p, b = *(v4u*)(p + 16);
          rot8(a, b, rope + ((size_t)t * 16 + 8 * c) * 2); *(v4u*)p = a; *(v4u*)(p + 16) = b; } }
    LAS float* red = (LAS float*)(F.lds);
    for (int it = blockIdx.x; it < 32 * 12; it += F.G) { const int b = it / 12, h = it - b * 12;
        const int rgp = F.tid >> 4, c = F.tid & 15;
        float s[16];
#pragma unroll
        for (int q = 0; q < 16; ++q) s[q] = 0.f;
        if (c < 2 || c >= 4) {
            v4u ra[8], rb[8];
#pragma unroll
            for (int rr = 0; rr < 8; ++rr) { const int t = 256 * b + rgp * 8 + rr; const bf16* p = QKVM + (size_t)t * N_IN0 + 1536 + h * 128 + 8 * c; ra[rr] = *(const v4u*)p; rb[rr] = *(const v4u*)(p + (c < 2 ? 16 : 0)); }
#pragma unroll
            for (int rr = 0; rr < 8; ++rr) { const int t = 256 * b + rgp * 8 + rr; bf16* p = QKVM + (size_t)t * N_IN0 + 1536 + h * 128 + 8 * c;
                v4u a = ra[rr];
                if (c < 2) { v4u bq = rb[rr]; rot8(a, bq, rope + ((size_t)t * 16 + 8 * c) * 2); *(v4u*)p = a; *(v4u*)(p + 16) = bq;
                    s[8] += bflo(bq.x); s[9] += bfhi(bq.x); s[10] += bflo(bq.y); s[11] += bfhi(bq.y); s[12] += bflo(bq.z); s[13] += bfhi(bq.z); s[14] += bflo(bq.w); s[15] += bfhi(bq.w); }
                s[0] += bflo(a.x); s[1] += bfhi(a.x); s[2] += bflo(a.y); s[3] += bfhi(a.y); s[4] += bflo(a.z); s[5] += bfhi(a.z); s[6] += bflo(a.w); s[7] += bfhi(a.w); }
        }
        __syncthreads();
        if (c < 2 || c >= 4) {
#pragma unroll
            for (int q = 0; q < 8; ++q) red[rgp * 128 + 8 * c + q] = s[q];
            if (c < 2) {
#pragma unroll
                for (int q = 0; q < 8; ++q) red[rgp * 128 + 16 + 8 * c + q] = s[8 + q]; }
        }
        __syncthreads();
        if (F.tid < 128) { float a = 0.f;
#pragma unroll
            for (int g = 0; g < 32; ++g) a += red[g * 128 + F.tid];
            KMEAN[(size_t)(h * 32 + b) * 128 + F.tid] = a * (1.0f / 256.0f); }
    }
    __syncthreads();
}

template <bool ROUTER, bool RES_F32, bool X8 = false>
__device__ __forceinline__ void ln_rows(Frame& F, const void* res, const bf16* __restrict__ y, const float* __restrict__ gam, const float* __restrict__ bet,
                                        bf16* outb, const float* __restrict__ wr, int* __restrict__ toke, float* __restrict__ tokw, unsigned char* out8 = nullptr) {
    if (ROUTER) {
        LAS float* wt = (LAS float*)(F.lds);
        f32x4 w8[8];
#pragma unroll
        for (int q = 0; q < 8; ++q) w8[q] = *(const f32x4*)(wr + (size_t)(F.tid + q * 512) * 4);
#pragma unroll
        for (int q = 0; q < 8; ++q) { const int i = F.tid + q * 512; const int d = i >> 1, hf = i & 1;
            wt[(4 * hf + 0) * 2048 + d] = w8[q][0]; wt[(4 * hf + 1) * 2048 + d] = w8[q][1]; wt[(4 * hf + 2) * 2048 + d] = w8[q][2]; wt[(4 * hf + 3) * 2048 + d] = w8[q][3]; }
        __syncthreads();
    }
    f32x4 nx[8]; v2u nxb[8], ny[8];
#define LN_LOAD(row) do { _Pragma("unroll") for (int j = 0; j < 8; ++j) { \
        if (RES_F32) nx[j] = ((const f32x4*)((const float*)res + (size_t)(row) * DM) + F.lane)[64 * j]; else nxb[j] = ((const v2u*)((const bf16*)res + (size_t)(row) * DM) + F.lane)[64 * j]; \
        ny[j] = ((const v2u*)(y + (size_t)(row) * DM) + F.lane)[64 * j]; } } while (0)
    if (F.gw < T) LN_LOAD(F.gw);
    for (int m = F.gw; m < T; m += F.NGW) {
        f32x4 v[8]; float s = 0.f;
#pragma unroll
        for (int j = 0; j < 8; ++j) { const f32x4 xr = RES_F32 ? nx[j] : (f32x4){bflo(nxb[j].x), bfhi(nxb[j].x), bflo(nxb[j].y), bfhi(nxb[j].y)};
            const f32x4 yr = {bflo(ny[j].x), bfhi(ny[j].x), bflo(ny[j].y), bfhi(ny[j].y)};
            v[j] = xr * DN_ALPHA + yr; s += (v[j][0] + v[j][1]) + (v[j][2] + v[j][3]); }
        if (m + F.NGW < T) LN_LOAD(m + F.NGW);
        const float mean = wave_sum(s) * (1.f / DM); float s2 = 0.f;
#pragma unroll
        for (int j = 0; j < 8; ++j) { v[j] = v[j] - mean; s2 += (v[j][0] * v[j][0] + v[j][1] * v[j][1]) + (v[j][2] * v[j][2] + v[j][3] * v[j][3]); }
        const float rstd = 1.f / sqrtf(wave_sum(s2) * (1.f / DM) + LN_EPS);
        v2u* ob = (v2u*)(outb + (size_t)m * DM) + F.lane;
#pragma unroll
        for (int j = 0; j < 8; ++j) { const f32x4 g4 = ((const f32x4*)gam)[F.lane + 64 * j], b4 = ((const f32x4*)bet)[F.lane + 64 * j];
            v[j] = v[j] * rstd * g4 + b4;
            ob[64 * j] = (v2u){pk2(v[j][0], v[j][1]), pk2(v[j][2], v[j][3])};
            if (X8) { int w8_ = 0; w8_ = __builtin_amdgcn_cvt_pk_fp8_f32(v[j][0], v[j][1], w8_, false); w8_ = __builtin_amdgcn_cvt_pk_fp8_f32(v[j][2], v[j][3], w8_, true);
                ((unsigned*)(out8 + (size_t)m * DM))[F.lane + 64 * j] = (unsigned)w8_; } }
        if (ROUTER) {
            float lg[8];
#pragma unroll
            for (int e = 0; e < 8; ++e) lg[e] = 0.f;
            const LAS f32x4* wl = (const LAS f32x4*)(F.lds) + F.lane;
#pragma unroll
            for (int j = 0; j < 8; ++j)
#pragma unroll
                for (int e = 0; e < 8; ++e) { const f32x4 w4 = wl[e * 512 + 64 * j]; lg[e] += (v[j][0] * w4[0] + v[j][1] * w4[1]) + (v[j][2] * w4[2] + v[j][3] * w4[3]); }
#pragma unroll
            for (int e = 0; e < 8; ++e) lg[e] = wave_sum(lg[e]);
            float b0 = lg[0]; int i0 = 0;
#pragma unroll
            for (int e = 1; e < 8; ++e) if (lg[e] > b0) { b0 = lg[e]; i0 = e; }
            float b1 = -__builtin_inff(); int i1 = 0;
#pragma unroll
            for (int e = 0; e < 8; ++e) if (e != i0 && lg[e] > b1) { b1 = lg[e]; i1 = e; }
            if (F.lane == 0) { const float e1 = __expf(b1 - b0); const float w0 = 1.f / (1.f + e1); toke[m] = i0 | (i1 << 8); tokw[2 * m] = w0; tokw[2 * m + 1] = e1 * w0; }
        }
    }
#undef LN_LOAD
}

__device__ __forceinline__ void p10_conv(Frame& F, const Args& A) {
    unsigned char* ws = A.ws; const bf16* H1 = (const bf16*)(ws + WS_RB); bf16* CV = (bf16*)(ws + WS_RC); const float* DTR = (const float*)(ws + WS_DTR); float* ACS = (float*)(ws + WS_ACS);
    const float* cw = (const float*)A.in[14]; const float* cb = (const float*)A.in[15]; const float* dtb = (const float*)A.in[16]; const float* alog = (const float*)A.in[17];
    const int gid = blockIdx.x * 512 + F.tid, NT_ = F.G * 512;
    for (int i = gid; i < (T / 16) * 320; i += NT_) { const int tb = i / 320, cg = i - tb * 320, ch0 = 8 * cg, t0 = 16 * tb;
        v4u xr[19];
#pragma unroll
        for (int r = 0; r < 19; ++r) { const int tt = t0 - 3 + r; const v4u ld_ = *(const v4u*)(H1 + (size_t)(tt < 0 ? 0 : tt) * N_IN1 + 1536 + ch0); xr[r] = (tt >= 0) ? ld_ : (v4u){0u, 0u, 0u, 0u}; }
        float w[4][8], bias[8];
#pragma unroll
        for (int k = 0; k < 4; ++k) { const f32x4 w0 = *(const f32x4*)(cw + k * 2560 + ch0), w1 = *(const f32x4*)(cw + k * 2560 + ch0 + 4);
            w[k][0] = w0[0]; w[k][1] = w0[1]; w[k][2] = w0[2]; w[k][3] = w0[3]; w[k][4] = w1[0]; w[k][5] = w1[1]; w[k][6] = w1[2]; w[k][7] = w1[3]; }
        { const f32x4 b0 = *(const f32x4*)(cb + ch0), b1 = *(const f32x4*)(cb + ch0 + 4);
          bias[0] = b0[0]; bias[1] = b0[1]; bias[2] = b0[2]; bias[3] = b0[3]; bias[4] = b1[0]; bias[5] = b1[1]; bias[6] = b1[2]; bias[7] = b1[3]; }
        const bool isx = ch0 < 1536; const int hd = isx ? (ch0 >> 6) : 0; const float dbias = dtb[hd];
        float dtr[16];
#pragma unroll
        for (int r = 0; r < 16; ++r) dtr[r] = DTR[(size_t)(t0 + r) * 32 + hd];
#pragma unroll
        for (int r = 0; r < 16; ++r) { float acc[8];
#pragma unroll
            for (int q = 0; q < 8; ++q) acc[q] = bias[q];
#pragma unroll
            for (int k = 0; k < 4; ++k) { const v4u xv = xr[r + k];
                acc[0] += w[k][0] * bflo(xv.x); acc[1] += w[k][1] * bfhi(xv.x); acc[2] += w[k][2] * bflo(xv.y); acc[3] += w[k][3] * bfhi(xv.y);
                acc[4] += w[k][4] * bflo(xv.z); acc[5] += w[k][5] * bfhi(xv.z); acc[6] += w[k][6] * bflo(xv.w); acc[7] += w[k][7] * bfhi(xv.w); }
#pragma unroll
            for (int q = 0; q < 8; ++q) acc[q] = silu_f(acc[q]);
            const size_t t = (size_t)(t0 + r);
            *(v4u*)(CV + t * 4096 + ch0) = (v4u){pk2(acc[0], acc[1]), pk2(acc[2], acc[3]), pk2(acc[4], acc[5]), pk2(acc[6], acc[7])};
            if (isx) { const float dt = softplus_f(dtr[r] + dbias);
                *(v4u*)(CV + t * 4096 + 2560 + ch0) = (v4u){pk2(acc[0] * dt, acc[1] * dt), pk2(acc[2] * dt, acc[3] * dt), pk2(acc[4] * dt, acc[5] * dt), pk2(acc[6] * dt, acc[7] * dt)}; }
        }
    }
    for (int it = F.gw; it < 32 * 24; it += F.NGW) { const int c = it / 24, h = it - c * 24; const float a = -__expf(alog[h]); const float bias = dtb[h];
        float v[4]; float run = 0.f;
#pragma unroll
        for (int q = 0; q < 4; ++q) { const int t = 256 * c + 4 * F.lane + q; run += softplus_f(DTR[(size_t)t * 32 + h] + bias) * a; v[q] = run; }
        float incl = run;
#pragma unroll
        for (int o = 1; o < 64; o <<= 1) { const float u = __shfl_up(incl, o); if (F.lane >= o) incl += u; }
        const float excl = incl - run;
        *(f32x4*)(ACS + (size_t)(c * 24 + h) * 256 + 4 * F.lane) = (f32x4){v[0] + excl, v[1] + excl, v[2] + excl, v[3] + excl};
    }
}

__device__ __forceinline__ void p12_scan(Frame& F, unsigned char* ws) {
    const float* __restrict__ STATES = (const float*)(ws + WS_STATES); bf16* __restrict__ PREV = (bf16*)(ws + WS_PREV); const float* __restrict__ ACS = (const float*)(ws + WS_ACS);
    const int gid = blockIdx.x * 512 + F.tid, NT_ = F.G * 512;
    for (int i = gid; i < 24 * 64 * 32; i += NT_) { const int h = i >> 11;
        f32x4 carry = {0.f, 0.f, 0.f, 0.f};
#pragma unroll 8
        for (int c = 0; c < 32; ++c) {
            *(v2u*)(PREV + ((size_t)c * 24 * 64 * 32 + i) * 4) = (v2u){pk2(carry[0], carry[1]), pk2(carry[2], carry[3])};
            const float dec = __expf(ACS[(size_t)(c * 24 + h) * 256 + 255]);
            const f32x4 st = *(const f32x4*)(STATES + ((size_t)c * 24 * 64 * 32 + i) * 4);
            carry = carry * dec + st; }
    }
}

__device__ __forceinline__ void p14_gated_norm(Frame& F, const Args& A) {
    unsigned char* ws = A.ws; const float* YS = (const float*)(ws + WS_YSSD); const bf16* H1 = (const bf16*)(ws + WS_RB); bf16* HEADS = (bf16*)(ws + WS_HEADS); const float* ng = (const float*)A.in[19];
    f32x4 ny[6]; v2u nz[6];
#define GN_LOAD(row) do { _Pragma("unroll") for (int j = 0; j < 6; ++j) { ny[j] = *((const f32x4*)(YS + (size_t)(row) * 1536) + F.lane + 64 * j); nz[j] = *((const v2u*)(H1 + (size_t)(row) * N_IN1) + F.lane + 64 * j); } } while (0)
    if (F.gw < T) GN_LOAD(F.gw);
    for (int m = F.gw; m < T; m += F.NGW) {
        f32x4 v[6]; float s2 = 0.f; f32x4 cy[6]; v2u cz[6];
#pragma unroll
        for (int j = 0; j < 6; ++j) { cy[j] = ny[j]; cz[j] = nz[j]; }
        if (m + F.NGW < T) GN_LOAD(m + F.NGW);
#pragma unroll
        for (int j = 0; j < 6; ++j) { const f32x4 yv = cy[j]; const v2u zz = cz[j];
            v[j] = (f32x4){yv[0] * silu_f(bflo(zz.x)), yv[1] * silu_f(bfhi(zz.x)), yv[2] * silu_f(bflo(zz.y)), yv[3] * silu_f(bfhi(zz.y))};
            s2 += (v[j][0] * v[j][0] + v[j][1] * v[j][1]) + (v[j][2] * v[j][2] + v[j][3] * v[j][3]); }
        const float rstd = 1.f / sqrtf(wave_sum(s2) * (1.f / 1536.f) + RMS_EPS);
#pragma unroll
        for (int j = 0; j < 6; ++j) { const f32x4 g4 = ((const f32x4*)ng)[F.lane + 64 * j]; const f32x4 o = v[j] * rstd * g4;
            *((v2u*)(HEADS + (size_t)m * DM) + F.lane + 64 * j) = (v2u){pk2(o[0], o[1]), pk2(o[2], o[3])}; }
    }
}

__device__ __forceinline__ void p17_sort_gather(Frame& F, unsigned char* ws) {
    const int* TOKE = (const int*)(ws + WS_TOKE); int* POS = (int*)(ws + WS_POS); int* COUNTS = (int*)(ws + WS_COUNTS);
    const bf16* XB = (const bf16*)(ws + WS_XCURB); bf16* XG = (bf16*)(ws + WS_RC);
    LAS unsigned long long* wtot = (LAS unsigned long long*)(F.lds);
    LAS int* posl = (LAS int*)(F.lds + 256);
    int te[16];
    { const int4* p = (const int4*)(TOKE + 16 * F.tid);
#pragma unroll
      for (int q = 0; q < 4; ++q) { const int4 v = p[q]; te[4 * q] = v.x; te[4 * q + 1] = v.y; te[4 * q + 2] = v.z; te[4 * q + 3] = v.w; } }
    unsigned long long ca = 0ull, cb = 0ull;
#pragma unroll
    for (int q = 0; q < 16; ++q) {
#pragma unroll
        for (int k = 0; k < 2; ++k) { const int e = (te[q] >> (8 * k)) & 0xff; const unsigned long long one = 1ull << (16 * (e & 3)); if (e < 4) ca += one; else cb += one; } }
    unsigned long long ia = ca, ib = cb;
#pragma unroll
    for (int o = 1; o < 64; o <<= 1) { const unsigned long long ua = __shfl_up(ia, o), ub = __shfl_up(ib, o); if (F.lane >= o) { ia += ua; ib += ub; } }
    if (F.lane == 63) { wtot[F.wave * 2] = ia; wtot[F.wave * 2 + 1] = ib; }
    __syncthreads();
    unsigned long long pa = 0ull, pb = 0ull, ta = 0ull, tb = 0ull;
#pragma unroll
    for (int w = 0; w < 8; ++w) { const unsigned long long xa = wtot[w * 2], xb = wtot[w * 2 + 1]; if (w < F.wave) { pa += xa; pb += xb; } ta += xa; tb += xb; }
    const unsigned long long ea = pa + ia - ca, eb = pb + ib - cb;
    int cnt[8], pst[8];
#pragma unroll
    for (int e = 0; e < 8; ++e) cnt[e] = (int)(((e < 4 ? ta : tb) >> (16 * (e & 3))) & 0xffffull);
    pst[0] = 0;
#pragma unroll
    for (int e = 1; e < 8; ++e) pst[e] = pst[e - 1] + ((cnt[e - 1] + 255) & ~255);
    if (blockIdx.x == 0 && F.tid < 8) { int c = 0;
#pragma unroll
        for (int e = 0; e < 8; ++e) c = (F.tid == e) ? cnt[e] : c;
        COUNTS[F.tid] = c; }
    const int b = blockIdx.x;
    for (int tb0 = b * 32; tb0 < T; tb0 += F.G * 32) {
        __syncthreads();
        if ((F.tid >> 1) == (tb0 >> 5)) {
            unsigned long long ra = ea, rb = eb;
#pragma unroll
            for (int q = 0; q < 16; ++q) {
#pragma unroll
                for (int k = 0; k < 2; ++k) { const int e = (te[q] >> (8 * k)) & 0xff; const int sh = 16 * (e & 3);
                    const int off = (int)(((e < 4 ? ra : rb) >> sh) & 0xffffull); int ps = 0;
#pragma unroll
                    for (int x = 0; x < 8; ++x) ps = (x == e) ? pst[x] : ps;
                    const int pos = ps + off; if (e < 4) ra += 1ull << sh; else rb += 1ull << sh;
                    const int tok = 16 * F.tid + q; POS[2 * tok + k] = pos; posl[(tok - tb0) * 2 + k] = pos; } }
        }
        __syncthreads();
        for (int i0 = F.tid; i0 < 64 * 256; i0 += 512 * 8) { v4u tmp[8];
#pragma unroll
            for (int q = 0; q < 8; ++q) { const int i = i0 + q * 512; const int r = i >> 8, ch = i & 255; tmp[q] = *((const v4u*)(XB + (size_t)(tb0 + (r >> 1)) * DM) + ch); }
#pragma unroll
            for (int q = 0; q < 8; ++q) { const int i = i0 + q * 512; const int r = i >> 8, ch = i & 255; const v4u t_ = tmp[q]; int w0 = 0, w1 = 0;
                w0 = __builtin_amdgcn_cvt_pk_fp8_f32(bflo(t_.x), bfhi(t_.x), w0, false); w0 = __builtin_amdgcn_cvt_pk_fp8_f32(bflo(t_.y), bfhi(t_.y), w0, true);
                w1 = __builtin_amdgcn_cvt_pk_fp8_f32(bflo(t_.z), bfhi(t_.z), w1, false); w1 = __builtin_amdgcn_cvt_pk_fp8_f32(bflo(t_.w), bfhi(t_.w), w1, true);
                *((v2u*)((unsigned char*)XG + (size_t)posl[r] * DM) + ch) = (v2u){(unsigned)w0, (unsigned)w1}; } }
    }
    __syncthreads();
}

__device__ __forceinline__ void p20_final(Frame& F, const Args& A) {
    unsigned char* ws = A.ws; const bf16* X = (const bf16*)(ws + WS_XCURB); const bf16* YM = (const bf16*)(ws + WS_RB); const int* POS = (const int*)(ws + WS_POS); const float* TOKW = (const float*)(ws + WS_TOKW);
    const float* gam = (const float*)A.in[27]; const float* bet = (const float*)A.in[28]; float* out = A.out;
    v2u nxa[8], nya[8], nyb[8]; float nw0 = 0.f, nw1 = 0.f;
#define FN_LOAD(row) do { const int p0_ = POS[2 * (row)], p1_ = POS[2 * (row) + 1]; nw0 = TOKW[2 * (row)]; nw1 = TOKW[2 * (row) + 1]; \
        const v2u* xr_ = (const v2u*)(X + (size_t)(row) * DM) + F.lane; const v2u* y0_ = (const v2u*)(YM + (size_t)p0_ * DM) + F.lane; const v2u* y1_ = (const v2u*)(YM + (size_t)p1_ * DM) + F.lane; \
        _Pragma("unroll") for (int j = 0; j < 8; ++j) { nxa[j] = xr_[64 * j]; nya[j] = y0_[64 * j]; nyb[j] = y1_[64 * j]; } } while (0)
    if (F.gw < T) FN_LOAD(F.gw);
    for (int m = F.gw; m < T; m += F.NGW) {
        const float w0 = nw0, w1 = nw1;
        v2u xa[8], ya[8], yb[8];
#pragma unroll
        for (int j = 0; j < 8; ++j) { xa[j] = nxa[j]; ya[j] = nya[j]; yb[j] = nyb[j]; }
        if (m + F.NGW < T) FN_LOAD(m + F.NGW);
        f32x4 v[8]; float s = 0.f;
#pragma unroll
        for (int j = 0; j < 8; ++j) { const f32x4 xv = {bflo(xa[j].x), bfhi(xa[j].x), bflo(xa[j].y), bfhi(xa[j].y)}, a = {bflo(ya[j].x), bfhi(ya[j].x), bflo(ya[j].y), bfhi(ya[j].y)}, b = {bflo(yb[j].x), bfhi(yb[j].x), bflo(yb[j].y), bfhi(yb[j].y)};
            v[j] = xv * DN_ALPHA + (a * w0 + b * w1); s += (v[j][0] + v[j][1]) + (v[j][2] + v[j][3]); }
        const float mean = wave_sum(s) * (1.f / DM); float s2 = 0.f;
#pragma unroll
        for (int j = 0; j < 8; ++j) { v[j] = v[j] - mean; s2 += (v[j][0] * v[j][0] + v[j][1] * v[j][1]) + (v[j][2] * v[j][2] + v[j][3] * v[j][3]); }
        const float rstd = 1.f / sqrtf(wave_sum(s2) * (1.f / DM) + LN_EPS);
        f32x4* of = (f32x4*)(out + (size_t)m * DM) + F.lane;
#pragma unroll
        for (int j = 0; j < 8; ++j) { const f32x4 g4 = ((const f32x4*)gam)[F.lane + 64 * j], b4 = ((const f32x4*)bet)[F.lane + 64 * j]; of[64 * j] = v[j] * rstd * g4 + b4; }
    }
}
__global__ void __launch_bounds__(NWAVES * 64, 2) mega_fwd(Args args) {
    extern __shared__ __attribute__((aligned(16))) unsigned char lds[];
    Frame F;
    F.lds = (LAS unsigned char*)lds; F.ldsg = (char*)lds;
    F.MISC = (volatile LAS unsigned*)(F.lds + MISC_OFF);
    F.tid = threadIdx.x; F.lane = F.tid & 63; F.wave = __builtin_amdgcn_readfirstlane(F.tid >> 6); const int wid_s = F.wave;
#define FRESH_TID(var) int var = fresh_tid()
    F.G = gridDim.x; F.gw = blockIdx.x * NWAVES + F.wave; F.NGW = F.G * NWAVES;
    unsigned char* ws = args.ws;
    F.ctl = (gu32*)(ws + WS_CTL);
    for (int u = F.tid; u < (LDS_BYTES - LDSCTL_OFF) / 4; u += NWAVES * 64) ((LAS unsigned*)(F.lds + LDSCTL_OFF))[u] = 0u;
    __syncthreads();
    if (F.lane == 0) ((LAS int*)(F.lds + WTAB_OFF))[(unsigned)__builtin_amdgcn_s_getreg((5 << 11) | 4) & 63u] = wid_s;
    __syncthreads();
#if MK_PER_PHASE
#define GRID_BAR() do { } while (0)
#else
    XcdBarrier bar = xcd_barrier_post((unsigned*)(F.ctl + CW_BAR), F.MISC + 8, wid_s);
#define GRID_BAR() xcd_barrier(bar)
#endif
#ifndef PROBE_PHASE
#define PROBE_PHASE -1
#endif
#ifndef PROBE_REPS
#define PROBE_REPS 2
#endif
#define REPS(k) (((k) == PROBE_PHASE) ? PROBE_REPS : 1)
#define HOSTED_GEMM(EPI, RW, CLO, CMID, CHI, WLO) HOSTED_GEMM_O(EPI, pg8::StaticOrder, RW, CLO, CMID, CHI, WLO)
#define HOSTED_GEMM_O(EPI, ORD, RW, CLO, CMID, CHI, WLO) do { const int rw_ = (RW); \
        pg8::RangeOrder<ORD> R1_{S, 0, rw_}, R2_{S, rw_, 1 << 20}; \
        pg8::gemm_phase<EPI, pg8::RangeOrder<ORD>, true, true>(F.lds + RING_OFF, g, R1_, E); \
        { FRESH_TID(tx_); F.tid = tx_; F.lane = tx_ & 63; F.wave = wid_s; F.gw = blockIdx.x * NWAVES + F.wave; } \
        __syncthreads(); convert_items(F, args, (CLO), (CMID), F.gw, F.NGW); \
        if ((int)blockIdx.x >= (WLO)) convert_items(F, args, (CMID), (CHI), F.gw - (WLO) * NWAVES, F.NGW - (WLO) * NWAVES); \
        __syncthreads(); \
        pg8::gemm_phase<EPI, pg8::RangeOrder<ORD>, true, true>(F.lds + RING_OFF, g, R2_, E); } while (0)
#define HOSTED_GEMM8(EPI, SC, RW, CLO, CMID, CHI, WLO) HOSTED_GEMM8_O(EPI, pg8::StaticOrder, SC, RW, CLO, CMID, CHI, WLO)
#define HOSTED_GEMM8_O(EPI, ORD, SC, RW, CLO, CMID, CHI, WLO) do { const int rw_ = (RW);     \
        pg8::RangeOrder<ORD> R1_{S, 0, rw_}, R2_{S, rw_, 1 << 20}; \
        { FRESH_TID(t8_); pg8::gemm_phase<EPI, pg8::RangeOrder<ORD>, true, true, SC>(F.lds + RING_OFF, g, R1_, E, t8_); } \
        { FRESH_TID(tx_); F.tid = tx_; F.lane = tx_ & 63; F.wave = wid_s; F.gw = blockIdx.x * NWAVES + F.wave; } \
        __syncthreads(); convert_items(F, args, (CLO), (CMID), F.gw, F.NGW); \
        if ((int)blockIdx.x >= (WLO)) convert_items(F, args, (CMID), (CHI), F.gw - (WLO) * NWAVES, F.NGW - (WLO) * NWAVES); \
        __syncthreads(); \
        { FRESH_TID(t8_); pg8::gemm_phase<EPI, pg8::RangeOrder<ORD>, true, true, SC>(F.lds + RING_OFF, g, R2_, E, t8_); } \
        { FRESH_TID(tx_); F.tid = tx_; F.lane = tx_ & 63; F.wave = wid_s; F.gw = blockIdx.x * NWAVES + F.wave; } } while (0)
    const int lo = args.ph_lo, hi = args.ph_hi;
#define IN(k) (lo <= (k) && (k) < hi)
#define REFRAME() { FRESH_TID(tx_); F.tid = tx_; F.lane = tx_ & 63; F.wave = wid_s; F.gw = blockIdx.x * NWAVES + F.wave; }
#define SEAM(k) do { if (IN(k) && IN((k) + 1)) GRID_BAR(); REFRAME(); } while (0)
    bf16* const XCURB = (bf16*)(ws + WS_XCURB); bf16* const YB = (bf16*)(ws + WS_YF); bf16* const HEADS = (bf16*)(ws + WS_HEADS); float* const YF = (float*)(ws + WS_YF);
    bf16* const QKVM = (bf16*)(ws + WS_RB); bf16* const H1 = (bf16*)(ws + WS_RB); bf16* const MEMKV = (bf16*)(ws + WS_MEMKV);

    if (IN(0)) for (int rep_ = 0; rep_ < REPS(0); ++rep_) { if (rep_) GRID_BAR(); p0_prologue(F, args); } SEAM(0);

    if (IN(1)) {
        { pg8::Gemm g{XCURB, (const bf16*)(ws + WS_WIN0), T, N_IN0, DM, DM}; pg8::StaticOrder S; S.init(T, N_IN0, F.G, (int)blockIdx.x);
          pg8::EpiQKV E{QKVM, N_IN0, (const float*)(ws + WS_ROPE), (float*)(ws + WS_KMEAN)};
          HOSTED_GEMM(pg8::EpiQKV, (int)(blockIdx.x % 3), CV_B3, CV_C1A, CV_C1, 128); }
        { pg8::Gemm g{(const bf16*)(ws + WS_MEMB), (const bf16*)(ws + WS_WMKV), MEML, 1024, DM, DM}; pg8::StaticOrder S; S.init(MEML, 1024, F.G, (int)((blockIdx.x + 4) % F.G));
          pg8::EpiBf16<0> E{MEMKV, 1024, nullptr, 0, 0, 1.f};
          pg8::gemm_phase<pg8::EpiBf16<0>, pg8::StaticOrder, true, true>(F.lds + RING_OFF, g, S, E); }
    } SEAM(1);


    if (IN(3)) {
        const float* KMEAN = (const float*)(ws + WS_KMEAN);
        for (int u = blockIdx.x; u < 384; u += F.G) { const int b = u / 12, h = u % 12;
            att::moba_gate_unit(QKVM + (size_t)(256 * b) * N_IN0 + h * 128, KMEAN + (size_t)h * 32 * 256, b, h, (unsigned*)(ws + WS_ROWMASK), (unsigned char*)(ws + WS_SEG), (int*)(ws + WS_CNT), F.ldsg); }
    } SEAM(3);

    if (IN(4)) {
        const unsigned* ROWMASK = (const unsigned*)(ws + WS_ROWMASK); const unsigned char* SEG = (const unsigned char*)(ws + WS_SEG); const int* CNT = (const int*)(ws + WS_CNT);
        bf16* PARTO = (bf16*)(ws + WS_RA); float* PARTML = (float*)(ws + WS_RA + 128 * MiB);
        char* scr = F.ldsg + 132096;
        LAS int* ipre = (LAS int*)(F.lds + 135168);
        int* segp = (int*)(F.ldsg + 137216);
        { int ng = 0;
          if (F.tid < 384) { const int j = F.tid & 31; int tot = 0; const int4* cp = (const int4*)(CNT + F.tid * 32); int4 cv[8];
#pragma unroll
              for (int q = 0; q < 8; ++q) cv[q] = cp[q];
#pragma unroll
              for (int q = 0; q < 8; ++q) { tot += (4 * q + 0 > j ? cv[q].x : 0) + (4 * q + 1 > j ? cv[q].y : 0) + (4 * q + 2 > j ? cv[q].z : 0) + (4 * q + 3 > j ? cv[q].w : 0); }
              ng = (256 + tot + 511) >> 9; }
          int incl = ng;
#pragma unroll
          for (int o = 1; o < 64; o <<= 1) { const int v = __shfl_up(incl, o); if (F.lane >= o) incl += v; }
          if (F.lane == 63) ipre[400 + F.wave] = incl;
          __syncthreads();
          int wbase = 0;
#pragma unroll
          for (int w = 0; w < 8; ++w) wbase += (w < F.wave) ? ipre[400 + w] : 0;
          if (F.tid < 384) ipre[F.tid + 1] = wbase + incl;
          if (F.tid == 0) ipre[0] = 0;
          __syncthreads(); }
        const int NIG = ipre[384];
#pragma nounroll
        for (int it = blockIdx.x; it < NIG; it += F.G) {
            int lo_ = 0, hi_ = 384;
            while (hi_ - lo_ > 1) { const int mid = (lo_ + hi_) >> 1; if (ipre[mid] <= it) lo_ = mid; else hi_ = mid; }
            const int hj = lo_, h = hj >> 5, j = hj & 31, chunk = it - ipre[hj];
            __syncthreads();
            if (F.tid < 64) { const int b = F.tid; const int c = (b > j && b < 32) ? CNT[hj * 32 + b] : 0; int incl = c;
#pragma unroll
                for (int o = 1; o < 64; o <<= 1) { const int v = __shfl_up(incl, o); if (F.lane >= o) incl += v; }
                if (b < 33) segp[b] = incl - c; }
            __syncthreads();
            const int R = 256 + segp[32]; const int row0 = chunk * 512; const int rowend = (row0 + 512 < R) ? row0 + 512 : R;
            att::moba_kv_item(QKVM, h, j, row0, rowend, segp, ROWMASK, SEG, PARTO, PARTML, F.ldsg, scr);
        }
#pragma nounroll
        for (int m = blockIdx.x; m < 128; m += F.G) { const int mh = m & 3, qb = m >> 2;
            att::attn_unit<false, N_IN0, 1024, DM>(QKVM + (size_t)(256 * qb) * N_IN0 + 4608 + mh * 128, MEMKV + mh * 128, MEMKV + 512 + mh * 128, HEADS + (size_t)(256 * qb) * DM + 1536 + mh * 128,
                                                   4, 0, nullptr, F.ldsg); }
    } SEAM(4);

    if (IN(5)) {
        const unsigned* ROWMASK = (const unsigned*)(ws + WS_ROWMASK); const bf16* PARTO = (const bf16*)(ws + WS_RA); const float* PARTML = (const float*)(ws + WS_RA + 128 * MiB);
        constexpr float C = 0.088388347648318440f * 1.4426950408889634f;
        const int gid = blockIdx.x * 512 + F.tid, NT_ = F.G * 512;
        for (int i = gid; i < T * 12 * 16; i += NT_) { const int th = i >> 4, c = i & 15; const int t = th / 12, h = th - t * 12;
            const unsigned rmask = ROWMASK[th];
            const float2* ml = (const float2*)PARTML + (size_t)th * 4; const v4u* po = (const v4u*)(PARTO + (size_t)th * 512) + c;
            float2 ms[4]; v4u pv[4];
#pragma unroll
            for (int s = 0; s < 4; ++s) { ms[s] = ml[s]; pv[s] = po[s * 16]; }
            const int cnt = __popc(rmask);
            float M = ms[3].x;
#pragma unroll
            for (int s = 0; s < 3; ++s) M = (s < cnt) ? fmaxf(M, ms[s].x) : M;
            float den = 0.f; float acc[8];
#pragma unroll
            for (int q = 0; q < 8; ++q) acc[q] = 0.f;
#pragma unroll
            for (int s = 0; s < 4; ++s) { const bool use = (s == 3) || (s < cnt); const float w = use ? ms[s].y * __builtin_amdgcn_exp2f((ms[s].x - M) * C) : 0.f; den += w; const v4u v = pv[s];
                acc[0] += use ? bflo(v.x) * w : 0.f; acc[1] += use ? bfhi(v.x) * w : 0.f; acc[2] += use ? bflo(v.y) * w : 0.f; acc[3] += use ? bfhi(v.y) * w : 0.f;
                acc[4] += use ? bflo(v.z) * w : 0.f; acc[5] += use ? bfhi(v.z) * w : 0.f; acc[6] += use ? bflo(v.w) * w : 0.f; acc[7] += use ? bfhi(v.w) * w : 0.f; }
            const float rd = 1.0f / den;
            *((v4u*)(HEADS + (size_t)t * DM + h * 128) + c) = (v4u){pk2(acc[0] * rd, acc[1] * rd), pk2(acc[2] * rd, acc[3] * rd), pk2(acc[4] * rd, acc[5] * rd), pk2(acc[6] * rd, acc[7] * rd)}; }
    } SEAM(5);

    if (IN(6)) for (int rep_ = 0; rep_ < REPS(6); ++rep_) { if (rep_) GRID_BAR(); pg8::Gemm g{HEADS, (const bf16*)(ws + WS_WO0), T, DM, DM, DM}; pg8::StaticOrder S; S.init(T, DM, F.G, (int)blockIdx.x);
        pg8::EpiBf16<0> E{YB, DM, nullptr, 0, 0, 1.f};
        pg8::gemm_phase<pg8::EpiBf16<0>, pg8::StaticOrder, true, true>(F.lds + RING_OFF, g, S, E); } SEAM(6);

    if (IN(7)) { ln_rows<false, true, true>(F, args.in[0], YB, (const float*)args.in[6], (const float*)args.in[7], XCURB, nullptr, nullptr, nullptr, ws + WS_XCUR); } SEAM(7);

    { FRESH_TID(tx_); F.tid = tx_; F.lane = tx_ & 63; F.wave = wid_s; F.gw = blockIdx.x * NWAVES + F.wave; }
    if (IN(8)) for (int rep_ = 0; rep_ < REPS(8); ++rep_) { if (rep_) GRID_BAR(); pg8::Gemm g{(const bf16*)(ws + WS_XCUR), (const bf16*)(ws + WS_WGU0), T, 2 * DFF, DM / 2, DM / 2}; pg8::StaticOrder S; S.init(T, 2 * DFF, F.G, (int)blockIdx.x);
        pg8::EpiSwiGLU8 E{ws + WS_RA, DFF};
        HOSTED_GEMM8(pg8::EpiSwiGLU8, 124, (int)(blockIdx.x & 7), CV_C1, CV_C2, CV_C2, 0); } SEAM(8);

    if (IN(9)) for (int rep_ = 0; rep_ < REPS(9); ++rep_) { if (rep_) GRID_BAR(); pg8::Gemm g{(const bf16*)(ws + WS_RA), (const bf16*)(ws + WS_WD0), T, DM, DFF / 2, DFF / 2}; pg8::StaticOrder S; S.init(T, DM, F.G, (int)blockIdx.x);
        pg8::EpiBf16<0> E{YB, DM, nullptr, 0, 0, 1.f};
        HOSTED_GEMM8(pg8::EpiBf16<0>, 122, (int)(blockIdx.x & 1), CV_C2, CV_C3, CV_C3, 0); } SEAM(9);

    if (IN(10)) { ln_rows<false, false>(F, XCURB, YB, (const float*)args.in[11], (const float*)args.in[12], XCURB, nullptr, nullptr, nullptr); } SEAM(10);

    if (IN(11)) { pg8::Gemm g{XCURB, (const bf16*)(ws + WS_WIN1), T, N_IN1, DM, DM}; pg8::StaticOrder S; S.init(T, N_IN1, F.G, (int)blockIdx.x);
        pg8::EpiIn1 E{H1, N_IN1, (float*)(ws + WS_DTR), 18};
        HOSTED_GEMM(pg8::EpiIn1, (int)(blockIdx.x % 3), CV_C3, CV_C4A, CV_C4, 96); } SEAM(11);

    if (IN(12)) { p10_conv(F, args); } SEAM(12);

    if (IN(13)) {
        const bf16* CV = (const bf16*)(ws + WS_RC); const float* ACS = (const float*)(ws + WS_ACS); float* STATES = (float*)(ws + WS_STATES);
        for (int u = blockIdx.x; u < 32 * 24; u += F.G) att::ssd_state_unit2(CV, ACS, STATES, u / 24, u % 24, F.ldsg, (float*)(F.ldsg + 132096));
        for (int m = blockIdx.x; m < 128; m += F.G) { const int mh = m & 3, qb = m >> 2;
            att::attn_unit<false, N_IN1, 1024, DM>(H1 + (size_t)(256 * qb) * N_IN1 + 4096 + mh * 128, MEMKV + mh * 128, MEMKV + 512 + mh * 128, HEADS + (size_t)(256 * qb) * DM + 1536 + mh * 128,
                                  4, 0, nullptr, F.ldsg); }
    } SEAM(13);

    if (IN(14)) { p12_scan(F, ws); } SEAM(14);

    if (IN(15)) { const bf16* CV = (const bf16*)(ws + WS_RC); const float* ACS = (const float*)(ws + WS_ACS); const bf16* PREV = (const bf16*)(ws + WS_PREV); const float* dsk = (const float*)args.in[18];
        att::ssd_y_units(CV, ACS, PREV, dsk, (float*)(ws + WS_YSSD), (int)blockIdx.x, F.G, F.ldsg, (float*)(F.ldsg + 132096)); } SEAM(15);

    if (IN(16)) { p14_gated_norm(F, args); } SEAM(16);

    if (IN(17)) { pg8::Gemm g{HEADS, (const bf16*)(ws + WS_WO1), T, DM, DM, DM}; pg8::StaticOrder S; S.init(T, DM, F.G, (int)blockIdx.x);
        pg8::EpiBf16<0> E{YB, DM, nullptr, 0, 0, 1.f};
        pg8::gemm_phase<pg8::EpiBf16<0>, pg8::StaticOrder, true, true>(F.lds + RING_OFF, g, S, E); } SEAM(17);

    if (IN(18)) { ln_rows<true, false>(F, XCURB, YB, (const float*)args.in[21], (const float*)args.in[22], XCURB, (const float*)args.in[23], (int*)(ws + WS_TOKE), (float*)(ws + WS_TOKW)); } SEAM(18);

    if (IN(19)) { p17_sort_gather(F, ws); } SEAM(19);

    { FRESH_TID(tx_); F.tid = tx_; F.lane = tx_ & 63; F.wave = wid_s; F.gw = blockIdx.x * NWAVES + F.wave; }
    if (IN(20)) for (int rep_ = 0; rep_ < REPS(20); ++rep_) { if (rep_) GRID_BAR(); int cnt[8];
#pragma unroll
        for (int e = 0; e < 8; ++e) cnt[e] = __builtin_amdgcn_readfirstlane(((const int*)(ws + WS_COUNTS))[e]);
        pg8::MoeOrder S; S.init(cnt, 56, F.G, (int)blockIdx.x, 1 << 20);
        pg8::Gemm g{(const bf16*)(ws + WS_RC), (const bf16*)(ws + WS_WGUE), MOE_ROWS, 8 * 2 * DFF, DM / 2, DM / 2};
        pg8::EpiSwiGLU8 E{ws + WS_RA, DFF};
        HOSTED_GEMM8_O(pg8::EpiSwiGLU8, pg8::MoeOrder, 124, (int)(blockIdx.x % 13) + 1, CV_C4, CV_NITEMS, CV_NITEMS, 0); } SEAM(20);

    { FRESH_TID(tx_); F.tid = tx_; F.lane = tx_ & 63; F.wave = wid_s; F.gw = blockIdx.x * NWAVES + F.wave; }
    if (IN(21)) for (int rep_ = 0; rep_ < REPS(21); ++rep_) { if (rep_) GRID_BAR(); int cnt[8];
#pragma unroll
        for (int e = 0; e < 8; ++e) cnt[e] = __builtin_amdgcn_readfirstlane(((const int*)(ws + WS_COUNTS))[e]);
        pg8::MoeOrder S; S.init(cnt, 8, F.G, (int)blockIdx.x, 2);
        { pg8::Gemm g{(const bf16*)(ws + WS_RA), (const bf16*)(ws + WS_WDE), MOE_ROWS, 8 * DM, DFF / 2, DFF / 2};
          pg8::EpiBf16Mod E{(bf16*)(ws + WS_RB), DM};
          { FRESH_TID(t8_); pg8::gemm_phase<pg8::EpiBf16Mod, pg8::MoeOrder, true, true, 122>(F.lds + RING_OFF, g, S, E, t8_); } }
        const int rem = S.per - 2 * (F.G >> 3);
        if (rem > 0) { const int SP = rem <= 4 ? 7 : 4;

          pg8::MoeSplitOrder S2; S2.init(S, 2, SP, DFF / 2);
          pg8::Gemm g{(const bf16*)(ws + WS_RA), (const bf16*)(ws + WS_WDE), MOE_ROWS, 8 * DM, DFF / 2 / SP, DFF / 2};
          pg8::EpiF32Mod E{(float*)(ws + WS_YF), 256};
          { FRESH_TID(t8_); pg8::gemm_phase<pg8::EpiF32Mod, pg8::MoeSplitOrder, true, true, 122>(F.lds + RING_OFF, g, S2, E, t8_); } } } SEAM(21);

    if (IN(22)) { int cnt[8];
#pragma unroll
        for (int e = 0; e < 8; ++e) cnt[e] = __builtin_amdgcn_readfirstlane(((const int*)(ws + WS_COUNTS))[e]);
        pg8::MoeOrder S; S.init(cnt, 8, F.G, (int)blockIdx.x, 2);
        const int rem = S.per - 2 * (F.G >> 3); const int SP = rem <= 4 ? 7 : 4;
          bf16* YM = (bf16*)(ws + WS_RB); const float* YF = (const float*)(ws + WS_YF);
        for (int it = blockIdx.x; it < 8 * rem * 4; it += F.G) { const int x = it / (4 * rem), r2 = it - x * 4 * rem, u = r2 >> 2, qt = r2 & 3;
            pg8::Unit un; S.decode(x * S.per + 2 * (F.G >> 3) + u, un);
            const float* pp = YF + (size_t)(x * 32 + u * SP) * 65536 + qt * 64 * 256; bf16* op = YM + (size_t)(un.opm * 256 + qt * 64) * DM + un.opn * 256;
            for (int i = F.tid; i < 64 * 64; i += NWAVES * 64) { const int r = i >> 6, c4 = i & 63; const float* q = pp + r * 256 + c4 * 4; f32x4 a;
                if (SP == 7) { f32x4 x[7];
#pragma unroll
                    for (int s = 0; s < 7; ++s) x[s] = *(const f32x4*)(q + (size_t)s * 65536);
                    a = ((x[0] + x[1]) + (x[2] + x[3])) + ((x[4] + x[5]) + x[6]); }
                else { f32x4 x[4];
#pragma unroll
                    for (int s = 0; s < 4; ++s) x[s] = *(const f32x4*)(q + (size_t)s * 65536);
                    a = (x[0] + x[1]) + (x[2] + x[3]); }
                *(v2u*)(op + (size_t)r * DM + c4 * 4) = (v2u){pk2(a[0], a[1]), pk2(a[2], a[3])}; } }
    } SEAM(22);


    if (IN(23)) { p20_final(F, args); }
#undef IN
#undef SEAM
#undef GRID_BAR
}

extern "C" void kernel_launch(void* const* d_in, const int* in_sizes, int n_in, void* d_out, int out_size, void* d_ws, size_t ws_size, hipStream_t stream) {
    static int grid = 0;
    if (grid == 0) {
        if (n_in != 29 || in_sizes[0] != T * DM || out_size != T * DM || ws_size < WS_END) {
            fprintf(stderr, "kernel_launch: unexpected shapes: n_in %d in0 %d out %d ws %zu (need %zu)\n", n_in, n_in > 0 ? in_sizes[0] : -1, out_size, ws_size, (size_t)WS_END); grid = -1; return; }
        int dev = 0, cus = 0, per_cu = 0;
        if (hipGetDevice(&dev) != hipSuccess || hipDeviceGetAttribute(&cus, hipDeviceAttributeMultiprocessorCount, dev) != hipSuccess) { grid = -1; return; }
        if (hipFuncSetAttribute((const void*)mega_fwd, hipFuncAttributeMaxDynamicSharedMemorySize, LDS_BYTES) != hipSuccess) { fprintf(stderr, "kernel_launch: hipFuncSetAttribute failed\n"); grid = -1; return; }
        if (hipOccupancyMaxActiveBlocksPerMultiprocessor(&per_cu, (const void*)mega_fwd, NWAVES * 64, LDS_BYTES) != hipSuccess || per_cu < 1)
            fprintf(stderr, "kernel_launch: occupancy query reports %d workgroups per CU\n", per_cu);
        (void)hipGetLastError();
        grid = cus;
    }
    if (grid < 0) return;
    if (hipMemsetAsync((char*)d_ws + WS_CTL, 0, CTL_ZERO_BYTES, stream) != hipSuccess) return;
    Args a{};
    for (int i = 0; i < 29; ++i) a.in[i] = d_in[i];
    a.out = (float*)d_out; a.ws = (unsigned char*)d_ws;
#if MK_PER_PHASE
    for (int p = 0; p < NPHASE; ++p) { a.ph_lo = p; a.ph_hi = p + 1; hipLaunchKernelGGL(mega_fwd, dim3(grid), dim3(NWAVES * 64), LDS_BYTES, stream, a); }
#else
    a.ph_lo = 0; a.ph_hi = NPHASE;
    hipLaunchKernelGGL(mega_fwd, dim3(grid), dim3(NWAVES * 64), LDS_BYTES, stream, a);
#endif
    const hipError_t le = hipPeekAtLastError();
    if (le != hipSuccess) fprintf(stderr, "kernel_launch: launch failed: %s\n", hipGetErrorName(le));
}
```

```cpp
#include <hip/hip_runtime.h>
#include <cstdio>
#include <cstdint>
#include <cmath>
constexpr int WTAB_OFF = 131072 + 512;
__device__ __forceinline__ int fresh_tid() {
    extern __shared__ __attribute__((aligned(16))) unsigned char lds_dyn_[];
    unsigned z_; asm volatile("s_mov_b32 %0, 0" : "=s"(z_));
    const unsigned key = (unsigned)__builtin_amdgcn_s_getreg((5 << 11) | 4) & 63u;
    const int wid = __builtin_amdgcn_readfirstlane(((const __attribute__((address_space(3))) int*)((__attribute__((address_space(3))) unsigned char*)lds_dyn_ + WTAB_OFF))[key + z_]);
    return wid * 64 + (int)__builtin_amdgcn_mbcnt_hi(~0u, __builtin_amdgcn_mbcnt_lo(~0u, z_));
}
namespace pg8 {
#define PG8_LAS __attribute__((address_space(3)))
typedef unsigned short bf16_t;
typedef short bf16x8 __attribute__((ext_vector_type(8)));
typedef float f32x4 __attribute__((ext_vector_type(4)));
typedef unsigned u32x4 __attribute__((ext_vector_type(4)));
constexpr int BM = 256, BK = 64, HALF = 128, HTB = HALF * BK * 2  , STAGE_BYTES = 8 * HTB, NXCD = 8, WGM = 8;

__host__ __device__ __forceinline__ int lds_byte(int r, int c) { const int st = (r >> 4) * 2 + (c >> 5), rr = r & 15, cc = c & 31, ob = rr * 64 + cc * 2; return st * 1024 + (ob ^ (((ob >> 9) & 1) << 5)); }
__host__ __device__ __forceinline__ void stage_rc(int b, int& R, int& C) { const int st = b / 1024, sb = b % 1024, swz = sb ^ (((sb >> 9) & 1) << 5); R = (st >> 1) * 16 + swz / 64; C = (st & 1) * 32 + (swz % 64) / 2; }
__host__ __device__ __forceinline__ int perm32(int rho) { const int n = rho >> 4, i = rho & 15; return 8 * (i >> 2) + 4 * n + (i & 3); }

struct Unit { int pm, pn, kofs, opm, opn; };
struct Gemm { const bf16_t* A; const bf16_t* Bt; int M, N, K, ld; };

struct StaticOrder {
    int nM, nN, nwg, G, c;
    __host__ __device__ void init(int M, int N, int G_, int c_) { nM = M / BM; nN = N / BM; nwg = nM * nN; G = G_; c = c_; }
    __host__ __device__ bool next(int i, Unit& u) const {
        const long L = (long)i * G + c; if (L >= nwg) return false;
        int wgid = (int)L; { const int q = nwg / NXCD, r = nwg % NXCD, xcd = wgid % NXCD, off = wgid / NXCD; wgid = (xcd < r ? xcd * (q + 1) : r * (q + 1) + (xcd - r) * q) + off; }
        const int nig = WGM * nN, gid = wgid / nig, fm = gid * WGM, gsz = (nM - fm) < WGM ? (nM - fm) : WGM;
        u.pm = fm + ((wgid % nig) % gsz); u.pn = (wgid % nig) / gsz; u.kofs = 0; u.opm = u.pm; u.opn = u.pn; return true;
    }
    __device__ __forceinline__ void a_ready(const Unit&) const {}
    __device__ __forceinline__ void done(const Unit&) const {}
};

__device__ __forceinline__ unsigned cvt_pk_bf16(float lo, float hi) { unsigned r; asm volatile("v_cvt_pk_bf16_f32 %0, %1, %2" : "=v"(r) : "v"(lo), "v"(hi)); return r; }
typedef float f32x2 __attribute__((ext_vector_type(2)));
__device__ __forceinline__ f32x2 gelu_pk(f32x2 v) {
    const f32x2 av = __builtin_elementwise_abs(v), d = av * 0.2316418882f + 1.0f;
    f32x2 t; t.x = __builtin_amdgcn_rcpf(d.x); t.y = __builtin_amdgcn_rcpf(d.y);
    f32x2 q = t * 0.5307027145f + (-0.7265760135f); q = q * t + 0.7107068705f; q = q * t + (-0.142248368f); q = q * t + 0.127414796f; q = q * t;
    const f32x2 s = (v * v) * (-0.72134752044f);
    f32x2 e; e.x = __builtin_amdgcn_exp2f(s.x); e.y = __builtin_amdgcn_exp2f(s.y);
    const f32x2 m = v * (q * e), r = v - m;
    f32x2 o; o.x = v.x < 0.f ? m.x : r.x; o.y = v.y < 0.f ? m.y : r.y; return o;
}

template <int ACT  > struct EpiBf16 {
    static constexpr bool PERM = true, AFTER_DRAIN = false; static_assert(ACT == 0 || ACT == 1, "EpiBf16: ACT is 0 (none) or 1 (gelu_pk)");
    bf16_t* O; int ldc; const float* bias; int split_cols; size_t split_stride; float scale0;
    __device__ __forceinline__ void operator()(const f32x4 (&acc)[2][2][4][2], const Unit& u, int wr, int wc, int fr, int fq) const {
        const int row0 = u.pm * BM + wr * 64 + fr; int colt = u.pn * BM; bf16_t* base = O;
        float sc = 1.f; if (split_cols) { const int t = colt / split_cols; base += (size_t)t * split_stride; colt -= t * split_cols; if (t == 0) sc = scale0; }
        const int col0 = colt + wc * 32 + 8 * fq, bcol0 = u.pn * BM + wc * 32 + 8 * fq;
        f32x4 bv[2][2];
#pragma unroll
        for (int bj = 0; bj < 2; ++bj)
#pragma unroll
            for (int n = 0; n < 2; ++n) bv[bj][n] = bias ? *(const f32x4*)(bias + bcol0 + bj * HALF + 4 * n) : (f32x4){0.f, 0.f, 0.f, 0.f};
#pragma unroll
        for (int ai = 0; ai < 2; ++ai)
#pragma unroll
            for (int m = 0; m < 4; ++m) { bf16_t* rowp = base + (size_t)(row0 + ai * HALF + m * 16) * ldc + col0;
#pragma unroll
                for (int bj = 0; bj < 2; ++bj) { f32x4 v0 = acc[ai][bj][m][0] + bv[bj][0], v1 = acc[ai][bj][m][1] + bv[bj][1];
                    if (ACT == 1) { f32x2 a = gelu_pk((f32x2){v0[0], v0[1]}), b = gelu_pk((f32x2){v0[2], v0[3]}), c = gelu_pk((f32x2){v1[0], v1[1]}), d = gelu_pk((f32x2){v1[2], v1[3]});
                        v0 = (f32x4){a.x, a.y, b.x, b.y}; v1 = (f32x4){c.x, c.y, d.x, d.y}; }
                    v0 = v0 * sc; v1 = v1 * sc; u32x4 w; w.x = cvt_pk_bf16(v0[0], v0[1]); w.y = cvt_pk_bf16(v0[2], v0[3]); w.z = cvt_pk_bf16(v1[0], v1[1]); w.w = cvt_pk_bf16(v1[2], v1[3]);
                    *(u32x4*)(rowp + bj * HALF) = w; } }
    }
};
struct EpiF32 {
    static constexpr bool PERM = false, AFTER_DRAIN = false;
    float* C; int ldc; const float* bias;
    __device__ __forceinline__ void operator()(const f32x4 (&acc)[2][2][4][2], const Unit& u, int wr, int wc, int fr, int fq) const {
        const int row0 = u.pm * BM + wr * 64 + fr, col0 = u.pn * BM + wc * 32 + 4 * fq;
        f32x4 bv[2][2];
#pragma unroll
        for (int bj = 0; bj < 2; ++bj)
#pragma unroll
            for (int n = 0; n < 2; ++n) bv[bj][n] = bias ? *(const f32x4*)(bias + col0 + bj * HALF + n * 16) : (f32x4){0.f, 0.f, 0.f, 0.f};
#pragma unroll
        for (int ai = 0; ai < 2; ++ai)
#pragma unroll
            for (int m = 0; m < 4; ++m) { float* rowp = C + (size_t)(row0 + ai * HALF + m * 16) * ldc + col0;
#pragma unroll
                for (int bj = 0; bj < 2; ++bj)
#pragma unroll
                    for (int n = 0; n < 2; ++n) *(f32x4*)(rowp + bj * HALF + n * 16) = acc[ai][bj][m][n] + bv[bj][n]; }
    }
};
__device__ __forceinline__ float silu_f(float g) { return g * __builtin_amdgcn_rcpf(1.0f + __builtin_amdgcn_exp2f(-1.4426950408889634f * g)); }
struct EpiSwiGLU {
    static constexpr bool PERM = true, AFTER_DRAIN = false;
    bf16_t* O; int ldc;
    __device__ __forceinline__ void operator()(const f32x4 (&acc)[2][2][4][2], const Unit& u, int wr, int wc, int fr, int fq) const {
        const int row0 = u.opm * BM + wr * 64 + fr, col0 = u.opn * HALF + wc * 32 + 8 * fq;
#pragma unroll
        for (int ai = 0; ai < 2; ++ai)
#pragma unroll
            for (int m = 0; m < 4; ++m) { bf16_t* rowp = O + (size_t)(row0 + ai * HALF + m * 16) * ldc + col0;
                const f32x4 g0 = acc[ai][0][m][0], g1 = acc[ai][0][m][1], u0 = acc[ai][1][m][0], u1 = acc[ai][1][m][1];
                f32x4 h0, h1;
#pragma unroll
                for (int j = 0; j < 4; ++j) { h0[j] = silu_f(g0[j]) * u0[j]; h1[j] = silu_f(g1[j]) * u1[j]; }
                u32x4 w; w.x = cvt_pk_bf16(h0[0], h0[1]); w.y = cvt_pk_bf16(h0[2], h0[3]); w.z = cvt_pk_bf16(h1[0], h1[1]); w.w = cvt_pk_bf16(h1[2], h1[3]);
                *(u32x4*)rowp = w; }
    }
};
struct EpiSwiGLU8 {
    static constexpr bool PERM = true, AFTER_DRAIN = false;
    unsigned char* O; int ldc;
    __device__ __forceinline__ void operator()(const f32x4 (&acc)[2][2][4][2], const Unit& u, int wr, int wc, int fr, int fq) const {
        const int row0 = u.opm * BM + wr * 64 + fr, col0 = u.opn * HALF + wc * 32 + 8 * fq;
#pragma unroll
        for (int ai = 0; ai < 2; ++ai)
#pragma unroll
            for (int m = 0; m < 4; ++m) { unsigned char* rowp = O + (size_t)(row0 + ai * HALF + m * 16) * ldc + col0;
                const f32x4 g0 = acc[ai][0][m][0], g1 = acc[ai][0][m][1], u0 = acc[ai][1][m][0], u1 = acc[ai][1][m][1];
                f32x4 h0, h1;
#pragma unroll
                for (int j = 0; j < 4; ++j) { h0[j] = __builtin_fminf(__builtin_fmaxf(silu_f(g0[j]) * u0[j] * 8.0f, -448.0f), 448.0f); h1[j] = __builtin_fminf(__builtin_fmaxf(silu_f(g1[j]) * u1[j] * 8.0f, -448.0f), 448.0f); }
                int w0 = 0, w1 = 0;
                w0 = __builtin_amdgcn_cvt_pk_fp8_f32(h0[0], h0[1], w0, false); w0 = __builtin_amdgcn_cvt_pk_fp8_f32(h0[2], h0[3], w0, true);
                w1 = __builtin_amdgcn_cvt_pk_fp8_f32(h1[0], h1[1], w1, false); w1 = __builtin_amdgcn_cvt_pk_fp8_f32(h1[2], h1[3], w1, true);
                typedef unsigned v2u_ __attribute__((ext_vector_type(2)));
                *(v2u_*)rowp = (v2u_){(unsigned)w0, (unsigned)w1}; }
    }
};
struct EpiF32Mod {
    static constexpr bool PERM = false, AFTER_DRAIN = false;
    float* C; int ldc;
    __device__ __forceinline__ void operator()(const f32x4 (&acc)[2][2][4][2], const Unit& u, int wr, int wc, int fr, int fq) const {
        const int row0 = u.opm * BM + wr * 64 + fr, col0 = u.opn * BM + wc * 32 + 4 * fq;
#pragma unroll
        for (int ai = 0; ai < 2; ++ai)
#pragma unroll
            for (int m = 0; m < 4; ++m) { float* rowp = C + (size_t)(row0 + ai * HALF + m * 16) * ldc + col0;
#pragma unroll
                for (int bj = 0; bj < 2; ++bj)
#pragma unroll
                    for (int n = 0; n < 2; ++n) *(f32x4*)(rowp + bj * HALF + n * 16) = acc[ai][bj][m][n]; }
    }
};
struct EpiBf16Mod {
    static constexpr bool PERM = true, AFTER_DRAIN = false;
    bf16_t* O; int ldc;
    __device__ __forceinline__ void operator()(const f32x4 (&acc)[2][2][4][2], const Unit& u, int wr, int wc, int fr, int fq) const {
        const int row0 = u.opm * BM + wr * 64 + fr, col0 = u.opn * BM + wc * 32 + 8 * fq;
#pragma unroll
        for (int ai = 0; ai < 2; ++ai)
#pragma unroll
            for (int m = 0; m < 4; ++m) { bf16_t* rowp = O + (size_t)(row0 + ai * HALF + m * 16) * ldc + col0;
#pragma unroll
                for (int bj = 0; bj < 2; ++bj) { const f32x4 v0 = acc[ai][bj][m][0], v1 = acc[ai][bj][m][1];
                    u32x4 w; w.x = cvt_pk_bf16(v0[0], v0[1]); w.y = cvt_pk_bf16(v0[2], v0[3]); w.z = cvt_pk_bf16(v1[0], v1[1]); w.w = cvt_pk_bf16(v1[2], v1[3]);
                    *(u32x4*)(rowp + bj * HALF) = w; } }
    }
};
struct EpiQKV {
    static constexpr bool PERM = true, AFTER_DRAIN = false;
    bf16_t* O; int ldc; const float* rope; float* kpart;
    __device__ __forceinline__ void operator()(const f32x4 (&acc)[2][2][4][2], const Unit& u, int wr, int wc, int fr, int fq) const {
        const int row0 = u.pm * BM + wr * 64 + fr; const int col0 = u.pn * BM + wc * 32 + 8 * fq;
        const bool rot = (u.pn < 12) && (wc == 0), isk = (u.pn >= 6) && (u.pn < 12);
        f32x4 cs_[2][2];
#pragma unroll
        for (int bj = 0; bj < 2; ++bj)
#pragma unroll
            for (int n = 0; n < 2; ++n) cs_[bj][n] = (f32x4){0.f, 0.f, 0.f, 0.f};
#pragma unroll
        for (int ai = 0; ai < 2; ++ai)
#pragma unroll
            for (int m = 0; m < 4; ++m) { const int t = row0 + ai * HALF + m * 16; bf16_t* rowp = O + (size_t)t * ldc + col0;
                f32x4 c4[2];
                if (rot) { c4[0] = *(const f32x4*)(rope + ((size_t)t * 16 + 4 * fq) * 2); c4[1] = *(const f32x4*)(rope + ((size_t)t * 16 + 4 * fq + 2) * 2); }
#pragma unroll
                for (int bj = 0; bj < 2; ++bj) { f32x4 v[2];
#pragma unroll
                    for (int n = 0; n < 2; ++n) { v[n] = acc[ai][bj][m][n];
                        if (rot) { const f32x4 x = v[n], c = c4[n]; v[n] = (f32x4){x[0] * c[0] - x[1] * c[1], x[1] * c[0] + x[0] * c[1], x[2] * c[2] - x[3] * c[3], x[3] * c[2] + x[2] * c[3]}; }
                        cs_[bj][n] += v[n]; }
                    u32x4 w; w.x = cvt_pk_bf16(v[0][0], v[0][1]); w.y = cvt_pk_bf16(v[0][2], v[0][3]); w.z = cvt_pk_bf16(v[1][0], v[1][1]); w.w = cvt_pk_bf16(v[1][2], v[1][3]);
                    *(u32x4*)(rowp + bj * HALF) = w; } }
        if (isk) {
#pragma unroll
            for (int bj = 0; bj < 2; ++bj)
#pragma unroll
                for (int n = 0; n < 2; ++n)
#pragma unroll
                    for (int j = 0; j < 4; ++j) { float s = cs_[bj][n][j]; s += __shfl_xor(s, 1); s += __shfl_xor(s, 2); s += __shfl_xor(s, 4); s += __shfl_xor(s, 8); cs_[bj][n][j] = s; }
            if (fr == 0) {
#pragma unroll
                for (int bj = 0; bj < 2; ++bj) { float* kp = kpart + ((size_t)((2 * (u.pn - 6) + bj) * 32 + u.pm) * 2 + wr) * 128 + wc * 32 + 8 * fq;
                    *(f32x4*)kp = cs_[bj][0]; *(f32x4*)(kp + 4) = cs_[bj][1]; } }
        }
    }
};
struct EpiIn1 {
    static constexpr bool PERM = true, AFTER_DRAIN = false;
    bf16_t* O; int ldc; float* DT; int dt_pn;
    __device__ __forceinline__ void operator()(const f32x4 (&acc)[2][2][4][2], const Unit& u, int wr, int wc, int fr, int fq) const {
        const int row0 = u.pm * BM + wr * 64 + fr; const int col0 = u.pn * BM + wc * 32 + 8 * fq;
#pragma unroll
        for (int ai = 0; ai < 2; ++ai)
#pragma unroll
            for (int m = 0; m < 4; ++m) { bf16_t* rowp = O + (size_t)(row0 + ai * HALF + m * 16) * ldc + col0;
#pragma unroll
                for (int bj = 0; bj < 2; ++bj) { const f32x4 v0 = acc[ai][bj][m][0], v1 = acc[ai][bj][m][1];
                    u32x4 w; w.x = cvt_pk_bf16(v0[0], v0[1]); w.y = cvt_pk_bf16(v0[2], v0[3]); w.z = cvt_pk_bf16(v1[0], v1[1]); w.w = cvt_pk_bf16(v1[2], v1[3]);
                    *(u32x4*)(rowp + bj * HALF) = w; } }
        if (u.pn == dt_pn && wc == 0 && fq < 3) {
#pragma unroll
            for (int ai = 0; ai < 2; ++ai)
#pragma unroll
                for (int m = 0; m < 4; ++m) { float* dp = DT + (size_t)(row0 + ai * HALF + m * 16) * 32 + 8 * fq;
                    *(f32x4*)dp = acc[ai][0][m][0]; *(f32x4*)(dp + 4) = acc[ai][0][m][1]; }
        }
    }
};
struct MoeOrder {
    int G, c, npn, per, imax; int tp[9];
    __device__ __forceinline__ void init(const int* counts, int npn_, int G_, int c_, int imax_) { G = G_; c = c_; npn = npn_; imax = imax_; tp[0] = 0;
#pragma unroll
        for (int e = 0; e < 8; ++e) tp[e + 1] = tp[e] + ((counts[e] + 255) >> 8);
        per = tp[8] * npn / 8; }
    __device__ __forceinline__ void decode(int L, Unit& u) const {
        int e = 0;
#pragma unroll
        for (int k = 1; k < 8; ++k) e += (L >= tp[k] * npn) ? 1 : 0;
        int tpe = 0, tpn = 0;
#pragma unroll
        for (int k = 0; k < 8; ++k) { if (k == e) { tpe = tp[k]; tpn = tp[k + 1]; } }
        const int r = L - tpe * npn, nt = tpn - tpe; const int pn = r / nt, pml = r - pn * nt;
        u.pm = tpe + pml; u.pn = e * npn + pn; u.kofs = 0; u.opm = u.pm; u.opn = pn; }
    __device__ __forceinline__ bool next(int i, Unit& u) const {
        const int s = i * (G >> 3) + (c >> 3); if (i >= imax || s >= per) return false;
        decode((c & 7) * per + s, u); return true; }
    __device__ __forceinline__ void a_ready(const Unit&) const {}
    __device__ __forceinline__ void done(const Unit&) const {}
};
struct MoeSplitOrder {
    MoeOrder base; int first, S, kpiece;
    __device__ __forceinline__ void init(const MoeOrder& b, int done_rounds, int S_, int Ktot) { base = b; first = done_rounds * (b.G >> 3); S = S_; kpiece = Ktot / S_; }
    __device__ __forceinline__ bool next(int i, Unit& u) const {
        const int q = base.c >> 3; if (i > 0 || first + q / S >= base.per) return false;
        base.decode((base.c & 7) * base.per + first + q / S, u); u.kofs = (q % S) * kpiece; u.opm = (base.c & 7) * 32 + q; u.opn = 0; return true; }
    __device__ __forceinline__ void a_ready(const Unit&) const {}
    __device__ __forceinline__ void done(const Unit&) const {}
};
template <class Base> struct RangeOrder {
    Base b; int i0, i1;
    __device__ __forceinline__ bool next(int i, Unit& u) const { return (i0 + i < i1) && b.next(i0 + i, u); }
    __device__ __forceinline__ void a_ready(const Unit&) const {}
    __device__ __forceinline__ void done(const Unit&) const {}
};
template <class Epi, class Sched, bool ALIGN_EPI = false, bool SP2 = false, int FP8 = 0>
__device__ __forceinline__ void gemm_phase(PG8_LAS unsigned char* lds, const Gemm g, const Sched& S, const Epi& E, int tid_in = -1) {
    int tid_ = fresh_tid(); (void)tid_in; asm volatile("" : "+v"(tid_));
    const int tid = tid_, wid = __builtin_amdgcn_readfirstlane(tid >> 6), lane = tid & 63, wr = wid >> 2, wc = wid & 3, fr = lane & 15, fq = lane >> 4;
    const int K = g.ld, nt = g.K / BK;
    unsigned voffA[2], voffB[2];
#pragma unroll
    for (int i = 0; i < 2; ++i) { int R, C; stage_rc(tid * 16 + i * 8192, R, C); const int Rb = Epi::PERM ? ((R & ~31) + perm32(R & 31)) : R;
        voffA[i] = (unsigned)(R * K + C) * 2u; voffB[i] = (unsigned)(Rb * K + C) * 2u; }
    const size_t kstep = (size_t)(BK * 2);
    const size_t hstep = (size_t)HALF * K * 2;
    const size_t tstep = 2 * hstep;
    const unsigned ldsw = (unsigned)wid * 1024u;
    const int aoff = lds_byte(wr * 64 + fr, fq * 8), boff = lds_byte(wc * 32 + fr, fq * 8);
#define PG8_SA(b, h) (((b) * 2 + (h)) * HTB)
#define PG8_SB(b, h) ((4 + (b) * 2 + (h)) * HTB)
#define PG8_STAGE(bufoff, gbase, voff) do { _Pragma("unroll") for (int _i = 0; _i < 2; ++_i) { unsigned vo_ = (voff)[_i]; if constexpr (FP8 != 0) asm volatile("" : "+v"(vo_));     \
        __builtin_amdgcn_global_load_lds((const unsigned*)((const char*)(gbase) + vo_), (PG8_LAS unsigned*)(lds + (bufoff) + ldsw + _i * 8192), 16, 0, 0); } } while (0)
#define PG8_LDA(dst, b, h) do { if constexpr (FP8 == 0) { _Pragma("unroll") for (int m = 0; m < 4; ++m) _Pragma("unroll") for (int k = 0; k < 2; ++k) dst[m][k] = *(const PG8_LAS bf16x8*)(lds + PG8_SA(b, h) + aoff + m * 2048 + k * 1024); } \
    else { _Pragma("unroll") for (int m = 0; m < 4; ++m) { const v4i_ l_ = *(const PG8_LAS v4i_*)(lds + PG8_SA(b, h) + aoff + m * 2048), h_ = *(const PG8_LAS v4i_*)(lds + PG8_SA(b, h) + aoff + m * 2048 + 1024); \
        dst##8[m] = __builtin_shufflevector(l_, h_, 0, 1, 2, 3, 4, 5, 6, 7); } } } while (0)
#define PG8_LDB(dst, b, h) do { if constexpr (FP8 == 0) { _Pragma("unroll") for (int n = 0; n < 2; ++n) _Pragma("unroll") for (int k = 0; k < 2; ++k) dst[n][k] = *(const PG8_LAS bf16x8*)(lds + PG8_SB(b, h) + boff + n * 2048 + k * 1024); } \
    else { _Pragma("unroll") for (int n = 0; n < 2; ++n) { const v4i_ l_ = *(const PG8_LAS v4i_*)(lds + PG8_SB(b, h) + boff + n * 2048), h_ = *(const PG8_LAS v4i_*)(lds + PG8_SB(b, h) + boff + n * 2048 + 1024); \
        dst##8[n] = __builtin_shufflevector(l_, h_, 0, 1, 2, 3, 4, 5, 6, 7); } } } while (0)
#define PG8_MMA(ai, bj, At, Bt) do { __builtin_amdgcn_s_setprio(1); if constexpr (FP8 == 0) { _Pragma("unroll") for (int m = 0; m < 4; ++m) _Pragma("unroll") for (int n = 0; n < 2; ++n) _Pragma("unroll") for (int k = 0; k < 2; ++k) \
        acc[ai][bj][m][n] = __builtin_amdgcn_mfma_f32_16x16x32_bf16(Bt[n][k], At[m][k], acc[ai][bj][m][n], 0, 0, 0); } \
    else { _Pragma("unroll") for (int m = 0; m < 4; ++m) _Pragma("unroll") for (int n = 0; n < 2; ++n) \
        acc[ai][bj][m][n] = __builtin_amdgcn_mfma_scale_f32_16x16x128_f8f6f4(Bt##8[n], At##8[m], acc[ai][bj][m][n], 0, 0, 0, FP8 * 0x01010101, 0, FP8 * 0x01010101); } \
    __builtin_amdgcn_s_setprio(0); } while (0)
#define PG8_WAIT_V(n) asm volatile("s_waitcnt vmcnt(" #n ")" ::: "memory")
#define PG8_WAIT_L(n) asm volatile("s_waitcnt lgkmcnt(" #n ")" ::: "memory")
#define PG8_BAR __builtin_amdgcn_s_barrier()
#define PG8_SCHED __builtin_amdgcn_sched_barrier(0)
    Unit cur, nxt; int ui = 0;
    if (!S.next(0, cur)) return;
    f32x4 acc[2][2][4][2];
#pragma unroll
    for (int a = 0; a < 2; ++a)
#pragma unroll
        for (int b = 0; b < 2; ++b)
#pragma unroll
            for (int m = 0; m < 4; ++m)
#pragma unroll
                for (int n = 0; n < 2; ++n) acc[a][b][m][n] = (f32x4){0.f, 0.f, 0.f, 0.f};
    typedef int v4i_ __attribute__((ext_vector_type(4))); typedef int v8i_ __attribute__((ext_vector_type(8)));
    bf16x8 At[4][2], B0[2][2], B1[2][2];
    v8i_ At8[4], B08[2], B18[2];
    const char* cA = (const char*)g.A + (size_t)cur.pm * tstep + (size_t)cur.kofs * 2; const char* cB = (const char*)g.Bt + (size_t)cur.pn * tstep + (size_t)cur.kofs * 2;
    S.a_ready(cur);
    if constexpr (SP2) {
        PG8_STAGE(PG8_SB(0, 0), cB, voffB); PG8_STAGE(PG8_SB(0, 1), cB + hstep, voffB); PG8_STAGE(PG8_SA(0, 0), cA, voffA); PG8_STAGE(PG8_SA(0, 1), cA + hstep, voffA);
        if (wr == 1) PG8_BAR;
        PG8_WAIT_V(2); PG8_BAR;
        PG8_STAGE(PG8_SB(1, 0), cB + kstep, voffB); PG8_STAGE(PG8_SA(1, 0), cA + kstep, voffA); PG8_STAGE(PG8_SB(1, 1), cB + hstep + kstep, voffB);
        PG8_WAIT_V(6); PG8_BAR;
    } else {
        PG8_STAGE(PG8_SB(0, 0), cB, voffB); PG8_STAGE(PG8_SA(0, 0), cA, voffA); PG8_STAGE(PG8_SB(0, 1), cB + hstep, voffB); PG8_STAGE(PG8_SA(0, 1), cA + hstep, voffA);
        if (wr == 1) PG8_BAR;
        PG8_WAIT_V(4); PG8_BAR;
        PG8_STAGE(PG8_SB(1, 0), cB + kstep, voffB); PG8_STAGE(PG8_SA(1, 0), cA + kstep, voffA); PG8_STAGE(PG8_SB(1, 1), cB + hstep + kstep, voffB);
        PG8_WAIT_V(6); PG8_BAR;
    }
    for (;;) {
        const bool has_next = S.next(ui + 1, nxt);
        const char* nA = has_next ? (const char*)g.A + (size_t)nxt.pm * tstep + (size_t)nxt.kofs * 2 : cA; const char* nB = has_next ? (const char*)g.Bt + (size_t)nxt.pn * tstep + (size_t)nxt.kofs * 2 : cB;
        for (int t = 0; t < nt; t += 2) {
            const bool last = (t == nt - 2);
            const char* a1 = cA + (size_t)(t + 1) * kstep;
            const char* a2 = last ? nA : cA + (size_t)(t + 2) * kstep; const char* b2 = last ? nB : cB + (size_t)(t + 2) * kstep;
            const char* a3 = a2 + kstep; const char* b3 = b2 + kstep;
            if constexpr (FP8 != 0) { asm volatile("" : "+s"(a1), "+s"(a2), "+s"(b2), "+s"(a3), "+s"(b3)); }
            if (last && has_next) S.a_ready(nxt);
            if constexpr (SP2) {
            PG8_LDB(B0, 0, 0); PG8_LDB(B1, 0, 1); PG8_SCHED; PG8_LDA(At, 0, 0); PG8_STAGE(PG8_SA(1, 1), a1 + hstep, voffA);
            PG8_WAIT_V(8); PG8_WAIT_L(0); PG8_BAR; PG8_MMA(0, 0, At, B0); PG8_MMA(0, 1, At, B1); PG8_BAR; PG8_SCHED;
            PG8_LDA(At, 0, 1); PG8_STAGE(PG8_SB(0, 0), b2, voffB); PG8_STAGE(PG8_SB(0, 1), b2 + hstep, voffB); PG8_STAGE(PG8_SA(0, 0), a2, voffA);
            PG8_WAIT_V(8); PG8_WAIT_L(0); PG8_BAR; PG8_MMA(1, 0, At, B0); PG8_MMA(1, 1, At, B1); PG8_BAR; PG8_SCHED;
            PG8_LDB(B0, 1, 0); PG8_LDB(B1, 1, 1); PG8_SCHED; PG8_LDA(At, 1, 0); PG8_STAGE(PG8_SA(0, 1), a2 + hstep, voffA);
            PG8_WAIT_V(8); PG8_WAIT_L(0); PG8_BAR; PG8_MMA(0, 0, At, B0); PG8_MMA(0, 1, At, B1); PG8_BAR; PG8_SCHED;
            PG8_LDA(At, 1, 1); PG8_STAGE(PG8_SB(1, 0), b3, voffB); PG8_STAGE(PG8_SB(1, 1), b3 + hstep, voffB); PG8_STAGE(PG8_SA(1, 0), a3, voffA);
            PG8_WAIT_V(8); PG8_WAIT_L(0); PG8_BAR; PG8_MMA(1, 0, At, B0); PG8_MMA(1, 1, At, B1); PG8_BAR; PG8_SCHED;
            } else {
            PG8_LDB(B0, 0, 0); PG8_SCHED; PG8_LDA(At, 0, 0); PG8_STAGE(PG8_SA(1, 1), a1 + hstep, voffA);
            PG8_WAIT_L(8); PG8_BAR; PG8_WAIT_L(0); PG8_MMA(0, 0, At, B0); PG8_BAR; PG8_SCHED;
            PG8_LDB(B1, 0, 1); PG8_STAGE(PG8_SB(0, 0), b2, voffB);
            PG8_BAR; PG8_WAIT_L(0); PG8_MMA(0, 1, At, B1); PG8_BAR;
            PG8_LDA(At, 0, 1); PG8_STAGE(PG8_SA(0, 0), a2, voffA);
            PG8_BAR; PG8_WAIT_L(0); PG8_MMA(1, 0, At, B0); PG8_BAR; PG8_SCHED;
            PG8_STAGE(PG8_SB(0, 1), b2 + hstep, voffB);
            PG8_WAIT_V(6); PG8_BAR; PG8_MMA(1, 1, At, B1); PG8_BAR;
            PG8_LDB(B0, 1, 0); PG8_SCHED; PG8_LDA(At, 1, 0); PG8_STAGE(PG8_SA(0, 1), a2 + hstep, voffA);
            PG8_WAIT_L(8); PG8_BAR; PG8_WAIT_L(0); PG8_MMA(0, 0, At, B0); PG8_BAR; PG8_SCHED;
            PG8_LDB(B1, 1, 1); PG8_STAGE(PG8_SB(1, 0), b3, voffB);
            PG8_BAR; PG8_WAIT_L(0); PG8_MMA(0, 1, At, B1); PG8_BAR;
            PG8_LDA(At, 1, 1); PG8_STAGE(PG8_SA(1, 0), a3, voffA);
            PG8_BAR; PG8_WAIT_L(0); PG8_MMA(1, 0, At, B0); PG8_BAR; PG8_SCHED;
            PG8_STAGE(PG8_SB(1, 1), b3 + hstep, voffB);
            PG8_WAIT_V(6); PG8_BAR; PG8_MMA(1, 1, At, B1); PG8_BAR;
            }
        }
        if constexpr (ALIGN_EPI) { if (wr == 0) PG8_BAR; }
        if constexpr (!Epi::AFTER_DRAIN) { int fr_ = fr, fq_ = fq; if constexpr (FP8 != 0) asm volatile("" : "+v"(fr_), "+v"(fq_));
            E(acc, cur, wr, wc, fr_, fq_); S.done(cur); }
        if (!has_next) break;
#pragma unroll
        for (int a = 0; a < 2; ++a)
#pragma unroll
            for (int b = 0; b < 2; ++b)
#pragma unroll
                for (int m = 0; m < 4; ++m)
#pragma unroll
                    for (int n = 0; n < 2; ++n) acc[a][b][m][n] = (f32x4){0.f, 0.f, 0.f, 0.f};
        cur = nxt; cA = nA; cB = nB; ++ui;
        if constexpr (ALIGN_EPI) { if (wr == 1) PG8_BAR; }
    }
    PG8_WAIT_V(0);
    if constexpr (!ALIGN_EPI) { if (wr == 0) PG8_BAR; }
    PG8_BAR;
    if constexpr (Epi::AFTER_DRAIN) { E.fused(acc, cur, wr, wc, fr, fq, lds, wid, lane); S.done(cur); }
#undef PG8_SA
#undef PG8_SB
#undef PG8_STAGE
#undef PG8_LDA
#undef PG8_LDB
#undef PG8_MMA
#undef PG8_WAIT_V
#undef PG8_WAIT_L
#undef PG8_BAR
#undef PG8_SCHED
}
}

namespace att {
using bf16x8 = __attribute__((ext_vector_type(8))) short;
using s16x4  = __attribute__((ext_vector_type(4))) short;
using f32x16 = __attribute__((ext_vector_type(16))) float;
using f32x4  = __attribute__((ext_vector_type(4))) float;
using u32x4  = __attribute__((ext_vector_type(4))) unsigned;
using u32x2  = __attribute__((ext_vector_type(2))) unsigned;
typedef unsigned short bf16;
constexpr int   D = 128, NW = 8, QBLK = 32, KVBLK = 64;
constexpr float SCALE = 0.088388347648318440f;
constexpr float THR = 8.f;
constexpr float NEG = -1e30f;
constexpr int SHM_V = KVBLK * D * 2, SHM_K = KVBLK * D * 2;
constexpr int SHM_ATTN = 2 * SHM_V + 2 * SHM_K + NW * 64 * 4;
constexpr int ACS_OFF = SHM_ATTN;
#define KSWZ(row, colB) ((row) * 256 + ((colB) ^ (((row) & 7) << 4)))
#define SBAR() __builtin_amdgcn_sched_barrier(0)
__device__ __forceinline__ int crow(int r, int hi) { return (r & 3) + 8 * (r >> 2) + 4 * hi; }
__device__ __forceinline__ unsigned cvtpk(float lo, float hi) { unsigned r; asm volatile("v_cvt_pk_bf16_f32 %0, %1, %2" : "=v"(r) : "v"(lo), "v"(hi)); return r; }
__device__ __forceinline__ float bf2f(unsigned short b) { return __uint_as_float(((unsigned)b) << 16); }
__device__ __forceinline__ bf16x8 ld8(const bf16* p) { return *reinterpret_cast<const bf16x8*>(p); }

__device__ __forceinline__ int moba_lim(int idx, int qrow, unsigned rowmask, int hi) {
  const int vis = ((rowmask >> (((idx - 4) >> 2) & 31)) & 1u) ? 64 : -1;
  return ((idx < 4) ? (qrow - 64 * idx) : vis) - 4 * hi;
}
__device__ __forceinline__ void partialSM(f32x16& p0, f32x16& p1, float& m_reg, float& mn, float& alpha) {
  constexpr float C = SCALE * 1.4426950408889634f;
  float pmax = p0[0];
#pragma unroll
  for (int r = 1; r < 16; ++r) pmax = fmaxf(pmax, p0[r]);
#pragma unroll
  for (int r = 0; r < 16; ++r) pmax = fmaxf(pmax, p1[r]);
  { auto rr = __builtin_amdgcn_permlane32_swap(__float_as_uint(pmax), __float_as_uint(pmax), false, false);
    pmax = fmaxf(__uint_as_float(rr[0]), __uint_as_float(rr[1])); }
  if (__builtin_expect(__all(pmax - m_reg <= THR / SCALE), 1)) { mn = m_reg; alpha = 1.f; }
  else { mn = fmaxf(m_reg, pmax); alpha = __builtin_amdgcn_exp2f((m_reg - mn) * C); m_reg = mn; }
  const float mnC = -mn * C;
#pragma unroll
  for (int r = 0; r < 16; ++r) p0[r] = fmaf(p0[r], C, mnC);
#pragma unroll
  for (int r = 0; r < 16; ++r) p1[r] = fmaf(p1[r], C, mnC);
#pragma unroll
  for (int r = 0; r < 16; ++r) p0[r] = __builtin_amdgcn_exp2f(p0[r]);
}
#define ATT_PK4(P, BASE, OUT) do { unsigned a0 = cvtpk(P[BASE + 0], P[BASE + 1]), a1 = cvtpk(P[BASE + 2], P[BASE + 3]);   \
    unsigned b0 = cvtpk(P[BASE + 4], P[BASE + 5]), b1 = cvtpk(P[BASE + 6], P[BASE + 7]);                              \
    auto r0 = __builtin_amdgcn_permlane32_swap(a0, b0, false, false); auto r1 = __builtin_amdgcn_permlane32_swap(a1, b1, false, false); \
    u32x4 w = {r0[0], r1[0], r0[1], r1[1]}; OUT = *reinterpret_cast<bf16x8*>(&w); } while (0)
__device__ __forceinline__ void finishSM(f32x16& p0, f32x16& p1, float alpha, float& l_reg, bf16x8& pa0, bf16x8& pa1, bf16x8& pa2, bf16x8& pa3) {
#pragma unroll
  for (int r = 0; r < 16; ++r) p1[r] = __builtin_amdgcn_exp2f(p1[r]);
  float ps = 0;
#pragma unroll
  for (int r = 0; r < 16; ++r) ps += p0[r];
#pragma unroll
  for (int r = 0; r < 16; ++r) ps += p1[r];
  { auto rr = __builtin_amdgcn_permlane32_swap(__float_as_uint(ps), __float_as_uint(ps), false, false);
    ps = __uint_as_float(rr[0]) + __uint_as_float(rr[1]); }
  l_reg = l_reg * alpha + ps;
  ATT_PK4(p0, 0, pa0); ATT_PK4(p0, 8, pa1); ATT_PK4(p1, 0, pa2); ATT_PK4(p1, 8, pa3);
}
template <bool MASKED>
__device__ __forceinline__ void qkt(f32x16& p0, f32x16& p1, const char* Ks, const bf16x8* qr, int r32, int hi, int lim = 0) {
  if (MASKED) {
#pragma unroll
    for (int r = 0; r < 16; ++r) { const int cr = (r & 3) + 8 * (r >> 2); p0[r] = (cr > lim) ? NEG : 0.f; p1[r] = (cr + 32 > lim) ? NEG : 0.f; }
  } else { p0 = f32x16{}; p1 = f32x16{}; }
#pragma unroll
  for (int d0 = 0; d0 < 8; ++d0) { const int cb = (d0 * 16 + hi * 8) * 2;
    bf16x8 b0 = *reinterpret_cast<const bf16x8*>(Ks + KSWZ(r32, cb));
    bf16x8 b1 = *reinterpret_cast<const bf16x8*>(Ks + KSWZ(32 + r32, cb));
    p0 = __builtin_amdgcn_mfma_f32_32x32x16_bf16(b0, qr[d0], p0, 0, 0, 0);
    p1 = __builtin_amdgcn_mfma_f32_32x32x16_bf16(b1, qr[d0], p1, 0, 0, 0); }
}
__device__ __forceinline__ int v_st(int k, int c) { const int kk = (k & ~0xC) | ((k & 4) << 1) | ((k & 8) >> 1); return ((kk >> 3) * 4 + (c >> 5)) * 512 + ((kk & 7) * 32 + (c & 31)) * 2; }
__device__ __forceinline__ int v_rd_base(int lane) { return ((lane & 3) << 3) | (((lane >> 2) & 3) << 6) | (((lane >> 4) & 1) << 5) | (((lane >> 5) & 1) << 8); }
constexpr int v_rd_off(int d0, int ks, int half) { return d0 * 512 + ks * 4096 + half * 2048; }
template <int OFF> __device__ __forceinline__ s16x4 tr_read(int vb) {
  s16x4 r; asm volatile("ds_read_b64_tr_b16 %0, %1 offset:%2" : "=&v"(r) : "v"(vb), "i"(OFF) : "memory"); return r;
}
#define ATT_PK(L, H) (bf16x8){L[0], L[1], L[2], L[3], H[0], H[1], H[2], H[3]}
template <int D0> __device__ __forceinline__ void pv_one(f32x16& od, int vb, bf16x8 pa0, bf16x8 pa1, bf16x8 pa2, bf16x8 pa3) {
  const s16x4 l0 = tr_read<v_rd_off(D0, 0, 0)>(vb), h0 = tr_read<v_rd_off(D0, 0, 1)>(vb), l1 = tr_read<v_rd_off(D0, 1, 0)>(vb), h1 = tr_read<v_rd_off(D0, 1, 1)>(vb);
  const s16x4 l2 = tr_read<v_rd_off(D0, 2, 0)>(vb), h2 = tr_read<v_rd_off(D0, 2, 1)>(vb), l3 = tr_read<v_rd_off(D0, 3, 0)>(vb), h3 = tr_read<v_rd_off(D0, 3, 1)>(vb);
  asm volatile("s_waitcnt lgkmcnt(0)" ::: "memory"); SBAR();
  od = __builtin_amdgcn_mfma_f32_32x32x16_bf16(pa0, ATT_PK(l0, h0), od, 0, 0, 0);
  od = __builtin_amdgcn_mfma_f32_32x32x16_bf16(pa1, ATT_PK(l1, h1), od, 0, 0, 0);
  od = __builtin_amdgcn_mfma_f32_32x32x16_bf16(pa2, ATT_PK(l2, h2), od, 0, 0, 0);
  od = __builtin_amdgcn_mfma_f32_32x32x16_bf16(pa3, ATT_PK(l3, h3), od, 0, 0, 0);
}
__device__ __forceinline__ void pv_d0(f32x16* o, int vb, bf16x8 pa0, bf16x8 pa1, bf16x8 pa2, bf16x8 pa3) {
  pv_one<0>(o[0], vb, pa0, pa1, pa2, pa3); pv_one<1>(o[1], vb, pa0, pa1, pa2, pa3); pv_one<2>(o[2], vb, pa0, pa1, pa2, pa3); pv_one<3>(o[3], vb, pa0, pa1, pa2, pa3);
}
template <int KS> __device__ __forceinline__ void pv_ks(f32x16* o, int vb, bf16x8 pa) {
  const s16x4 l0 = tr_read<v_rd_off(0, KS, 0)>(vb), h0 = tr_read<v_rd_off(0, KS, 1)>(vb), l1 = tr_read<v_rd_off(1, KS, 0)>(vb), h1 = tr_read<v_rd_off(1, KS, 1)>(vb);
  const s16x4 l2 = tr_read<v_rd_off(2, KS, 0)>(vb), h2 = tr_read<v_rd_off(2, KS, 1)>(vb), l3 = tr_read<v_rd_off(3, KS, 0)>(vb), h3 = tr_read<v_rd_off(3, KS, 1)>(vb);
  asm volatile("s_waitcnt lgkmcnt(0)" ::: "memory"); SBAR();
  o[0] = __builtin_amdgcn_mfma_f32_32x32x16_bf16(pa, ATT_PK(l0, h0), o[0], 0, 0, 0);
  o[1] = __builtin_amdgcn_mfma_f32_32x32x16_bf16(pa, ATT_PK(l1, h1), o[1], 0, 0, 0);
  o[2] = __builtin_amdgcn_mfma_f32_32x32x16_bf16(pa, ATT_PK(l2, h2), o[2], 0, 0, 0);
  o[3] = __builtin_amdgcn_mfma_f32_32x32x16_bf16(pa, ATT_PK(l3, h3), o[3], 0, 0, 0);
}
__device__ __forceinline__ void pv_il(f32x16* o, int vb, bf16x8 pa0, bf16x8 pa1, bf16x8 pa2, bf16x8 pa3) {
  pv_ks<0>(o, vb, pa0); pv_ks<1>(o, vb, pa1); pv_ks<2>(o, vb, pa2); pv_ks<3>(o, vb, pa3);
}

template <bool MOBA, int ldq, int ldk, int ldo>
__device__ __forceinline__ void attn_unit(const bf16* __restrict__ Qb, const bf16* __restrict__ Kh, const bf16* __restrict__ Vh, bf16* __restrict__ Ob,
                                          int NT, int b, const float* __restrict__ kmean, char* lds) {
  const int tid = fresh_tid(), wid = tid >> 6, lane = tid & 63, r32 = lane & 31, hi = lane >> 5;
  char* V_lds = lds; char* K_lds = lds + 2 * SHM_V;
  float* ws = (float*)(lds + 2 * SHM_V + 2 * SHM_K) + wid * 64; float* li_l = ws; float* al_l = ws + 32;
  float m_reg = NEG, l_reg = 0; f32x16 o[4] = {}; bf16x8 qr[8];
  const bf16* Qw = Qb + (long)(wid * QBLK + r32) * ldq + hi * 8;
#pragma unroll
  for (int d0 = 0; d0 < 8; ++d0) qr[d0] = ld8(Qw + d0 * 16);
  const int sr = tid >> 4, sc = (tid & 15) * 8, vst0 = v_st(sr, sc), vst1 = v_st(32 + sr, sc);
  const int vb0 = (int)(uintptr_t)V_lds + v_rd_base(lane);
  const int qrow = wid * QBLK + r32;
  unsigned rowmask = 0u;
  if (MOBA) {
    { const float* km = kmean + sr * 128 + sc; const f32x4 a = *(const f32x4*)km, c4 = *(const f32x4*)(km + 4);
      u32x4 w = {cvtpk(a[0], a[1]), cvtpk(a[2], a[3]), cvtpk(c4[0], c4[1]), cvtpk(c4[2], c4[3])};
      *(u32x4*)(K_lds + KSWZ(sr, sc * 2)) = w; }
    __syncthreads();
    f32x16 g = f32x16{};
#pragma unroll
    for (int d0 = 0; d0 < 8; ++d0) { const int cb = (d0 * 16 + hi * 8) * 2;
      bf16x8 b0 = *reinterpret_cast<const bf16x8*>(K_lds + KSWZ(r32, cb));
      g = __builtin_amdgcn_mfma_f32_32x32x16_bf16(b0, qr[d0], g, 0, 0, 0); }
#pragma unroll
    for (int r = 0; r < 16; ++r) g[r] = (crow(r, hi) < b) ? g[r] : -__builtin_inff();
#pragma unroll
    for (int k = 0; k < 3; ++k) {
      float best = -__builtin_inff(); int bi = 99;
#pragma unroll
      for (int r = 0; r < 16; ++r) { const int n = crow(r, hi); const bool t = (g[r] > best) || (g[r] == best && n < bi); best = t ? g[r] : best; bi = t ? n : bi; }
      const float pv = __shfl_xor(best, 32); const int pi = __shfl_xor(bi, 32);
      const bool pt = (pv > best) || (pv == best && pi < bi);
      const int wi = pt ? pi : bi;
      if (k < b) rowmask |= 1u << (wi & 31);
#pragma unroll
      for (int r = 0; r < 16; ++r) g[r] = (crow(r, hi) == wi) ? -__builtin_inff() : g[r];
    }
    __syncthreads();
  }
  const bf16* Kp = Kh + (long)sr * ldk + sc; const bf16* Vp = Vh + (long)sr * ldk + sc;
#define TK0(idx) (MOBA ? ((idx) < 4 ? 256 * b + 64 * (idx) : 64 * ((idx) - 4)) : 64 * (idx))
#define RESC(a) do { if (__any((a) < 1.f)) { if (hi == 0) al_l[r32] = (a); asm volatile("s_waitcnt lgkmcnt(0)" ::: "memory"); \
    _Pragma("unroll") for (int d = 0; d < 4; ++d) _Pragma("unroll") for (int r = 0; r < 16; ++r) o[d][r] *= al_l[crow(r, hi)]; } } while (0)
  if constexpr (MOBA) {
    bf16x8 vs0, vs1, ks0, ks1;
#define SLOAD1(idx) do { const long ko_ = (long)(TK0(idx)) * ldk; vs0 = ld8(Vp + ko_); vs1 = ld8(Vp + ko_ + 32 * ldk); ks0 = ld8(Kp + ko_); ks1 = ld8(Kp + ko_ + 32 * ldk); } while (0)
    SLOAD1(0);
#pragma nounroll
    for (int idx = 0; idx < NT; ++idx) {
      __syncthreads();
      *(bf16x8*)(V_lds + vst0) = vs0; *(bf16x8*)(V_lds + vst1) = vs1; { const int kc = sc * 2; *(bf16x8*)(K_lds + KSWZ(sr, kc)) = ks0; *(bf16x8*)(K_lds + KSWZ(32 + sr, kc)) = ks1; }
      if (idx + 1 < NT) SLOAD1(idx + 1);
      __syncthreads();
      f32x16 p0, p1; float mn, al; bf16x8 pa0, pa1, pa2, pa3;
      qkt<true>(p0, p1, K_lds, qr, r32, hi, moba_lim(idx, qrow, rowmask, hi));
      partialSM(p0, p1, m_reg, mn, al);
      RESC(al);
      finishSM(p0, p1, al, l_reg, pa0, pa1, pa2, pa3); SBAR();
      pv_d0(o, vb0, pa0, pa1, pa2, pa3);
    }
#undef SLOAD1
  } else {
  constexpr int SDEPTH = MOBA ? 1 : 2;
  struct { bf16x8 vs0, vs1, ks0, ks1; } sr_[SDEPTH];
#define SLOAD(i, idx) do { const long ko_ = (long)(TK0(idx)) * ldk; sr_[i].vs0 = ld8(Vp + ko_); sr_[i].vs1 = ld8(Vp + ko_ + 32 * ldk); \
    sr_[i].ks0 = ld8(Kp + ko_); sr_[i].ks1 = ld8(Kp + ko_ + 32 * ldk); } while (0)
#define SWRITE(bb, i) do { *(bf16x8*)(V_lds + (bb) * SHM_V + vst0) = sr_[i].vs0;          \
    *(bf16x8*)(V_lds + (bb) * SHM_V + vst1) = sr_[i].vs1; const int kc = sc * 2;               \
    *(bf16x8*)(K_lds + (bb) * SHM_K + KSWZ(sr, kc)) = sr_[i].ks0;                       \
    *(bf16x8*)(K_lds + (bb) * SHM_K + KSWZ(32 + sr, kc)) = sr_[i].ks1; } while (0)
#define SWAIT() do { if constexpr (SDEPTH == 2) asm volatile("s_waitcnt vmcnt(4)" ::: "memory"); else asm volatile("s_waitcnt vmcnt(0)" ::: "memory"); } while (0)
#define QKT(P0, P1, KS, idx) qkt<MOBA>(P0, P1, KS, qr, r32, hi, MOBA ? moba_lim((idx), qrow, rowmask, hi) : 0)
  f32x16 pA0, pA1, pB0, pB1; float mnA, mnB, alA, alB; bf16x8 pa0, pa1, pa2, pa3;
  constexpr int SE = 0, SO = SDEPTH - 1;
  SLOAD(SE, 0); asm volatile("s_waitcnt vmcnt(0)" ::: "memory"); SWRITE(0, SE); __syncthreads();
  QKT(pA0, pA1, K_lds, 0); partialSM(pA0, pA1, m_reg, mnA, alA);
  SLOAD(SO, 1); if constexpr (SDEPTH == 2) { if (2 < NT) SLOAD(SE, 2); }
  SWAIT(); SWRITE(1, SO); __syncthreads();
  for (int j = 1; j + 1 < NT; j += 2) {
    SBAR(); QKT(pB0, pB1, K_lds + SHM_K, j);
    finishSM(pA0, pA1, alA, l_reg, pa0, pa1, pa2, pa3); SBAR();
    SLOAD(SO, j + SDEPTH); SBAR();
    pv_d0(o, vb0, pa0, pa1, pa2, pa3); partialSM(pB0, pB1, m_reg, mnB, alB);
    __syncthreads(); SWAIT(); SWRITE(0, SE);
    RESC(alB); __syncthreads();
    SBAR(); QKT(pA0, pA1, K_lds, j + 1);
    finishSM(pB0, pB1, alB, l_reg, pa0, pa1, pa2, pa3); SBAR();
    if (SDEPTH == 1 || j + 3 < NT) SLOAD(SE, j + 1 + SDEPTH); SBAR();
    pv_d0(o, vb0 + SHM_V, pa0, pa1, pa2, pa3); partialSM(pA0, pA1, m_reg, mnA, alA);
    __syncthreads(); SWAIT(); SWRITE(1, SO);
    RESC(alA); __syncthreads();
  }
  SBAR(); QKT(pB0, pB1, K_lds + SHM_K, NT - 1);
  finishSM(pA0, pA1, alA, l_reg, pa0, pa1, pa2, pa3); SBAR();
  pv_d0(o, vb0, pa0, pa1, pa2, pa3); partialSM(pB0, pB1, m_reg, mnB, alB);
  __syncthreads(); RESC(alB);
  finishSM(pB0, pB1, alB, l_reg, pa0, pa1, pa2, pa3); SBAR();
  pv_d0(o, vb0 + SHM_V, pa0, pa1, pa2, pa3);
  }
  if (hi == 0) li_l[r32] = l_reg; asm volatile("s_waitcnt lgkmcnt(0)" ::: "memory");
  float rli[16];
#pragma unroll
  for (int r = 0; r < 16; ++r) rli[r] = __builtin_amdgcn_rcpf(li_l[crow(r, hi)]);
  bf16* Ow = Ob + (long)(wid * QBLK) * ldo;
#pragma unroll
  for (int r = 0; r < 16; ++r) { const int orow = crow(r, hi);
#pragma unroll
    for (int d0 = 0; d0 < 4; ++d0) Ow[(long)orow * ldo + d0 * 32 + r32] = (bf16)(cvtpk(o[d0][r] * rli[r], 0.f) & 0xffffu); }
  __syncthreads();
#undef TK0
#undef SLOAD
#undef SWRITE
#undef SWAIT
#undef RESC
#undef QKT
}

__device__ __forceinline__ void moba_gate_unit(const bf16* __restrict__ Qb, const float* __restrict__ kmean, int b, int h, unsigned* __restrict__ ROWMASK, unsigned char* __restrict__ SEG, int* __restrict__ CNT, char* lds) {
  const int tid = fresh_tid(), wid = tid >> 6, lane = tid & 63, r32 = lane & 31, hi = lane >> 5;
  char* K_lds = lds + 2 * SHM_V; int* cw = (int*)(lds + ACS_OFF);
  constexpr int ldq = 5120;
  bf16x8 qr[8];
  const bf16* Qw = Qb + (long)(wid * QBLK + r32) * ldq + hi * 8;
#pragma unroll
  for (int d0 = 0; d0 < 8; ++d0) qr[d0] = ld8(Qw + d0 * 16);
  const int sr = tid >> 4, sc = (tid & 15) * 8;
  unsigned rowmask = 0u;
  { const float* km = kmean + (size_t)sr * 256 + sc;
    const f32x4 a = (*(const f32x4*)km + *(const f32x4*)(km + 128)) * (1.0f / 256.0f), c4 = (*(const f32x4*)(km + 4) + *(const f32x4*)(km + 132)) * (1.0f / 256.0f);
    u32x4 w = {cvtpk(a[0], a[1]), cvtpk(a[2], a[3]), cvtpk(c4[0], c4[1]), cvtpk(c4[2], c4[3])};
    *(u32x4*)(K_lds + KSWZ(sr, sc * 2)) = w; }
  __syncthreads();
  f32x16 g = f32x16{};
#pragma unroll
  for (int d0 = 0; d0 < 8; ++d0) { const int cb = (d0 * 16 + hi * 8) * 2;
    bf16x8 b0 = *reinterpret_cast<const bf16x8*>(K_lds + KSWZ(r32, cb));
    g = __builtin_amdgcn_mfma_f32_32x32x16_bf16(b0, qr[d0], g, 0, 0, 0); }
#pragma unroll
  for (int r = 0; r < 16; ++r) g[r] = (crow(r, hi) < b) ? g[r] : -__builtin_inff();
#pragma unroll
  for (int k = 0; k < 3; ++k) {
    float best = -__builtin_inff(); int bi = 99;
#pragma unroll
    for (int r = 0; r < 16; ++r) { const int n = crow(r, hi); const bool t = (g[r] > best) || (g[r] == best && n < bi); best = t ? g[r] : best; bi = t ? n : bi; }
    const float pv = __shfl_xor(best, 32); const int pi = __shfl_xor(bi, 32);
    const bool pt = (pv > best) || (pv == best && pi < bi);
    const int wi = pt ? pi : bi;
    if (k < b) rowmask |= 1u << (wi & 31);
#pragma unroll
    for (int r = 0; r < 16; ++r) g[r] = (crow(r, hi) == wi) ? -__builtin_inff() : g[r];
  }
  if (hi == 0) ROWMASK[(size_t)(256 * b + wid * QBLK + r32) * 12 + h] = rowmask;
  int mycnt = 0;
  for (int j = 0; j < b; ++j) { const unsigned long long bal = __ballot(((rowmask >> j) & 1u) && hi == 0); const int c = __popcll(bal); if (lane == j) mycnt = c; }
  if (lane < 32) cw[wid * 32 + lane] = mycnt;
  __syncthreads();
  int off = 0, tot = 0;
  if (lane < 32) {
#pragma unroll
    for (int w = 0; w < 8; ++w) { const int c = cw[w * 32 + lane]; off += (w < wid) ? c : 0; tot += c; } }
  if (wid == 0 && lane < b) CNT[(h * 32 + lane) * 32 + b] = tot;
  for (int j = 0; j < b; ++j) { const bool bit = ((rowmask >> j) & 1u) && hi == 0; const unsigned long long bal = __ballot(bit); const int base = __shfl(off, j);
    if (bit) { const int rank = __popcll(bal & ((1ull << lane) - 1ull)); SEG[((size_t)(h * 32 + j) * 32 + b) * 256 + base + rank] = (unsigned char)(wid * QBLK + r32); } }
  __syncthreads();
}
template <bool OWN>
__device__ __forceinline__ void attn_part_unit(const bf16* __restrict__ Qw, const bf16* __restrict__ Kh, const bf16* __restrict__ Vh, int dst, bf16* __restrict__ PARTO, float* __restrict__ PARTML, char* lds) {
  constexpr int ldk = 5120, NT = 4;
  const int tid = fresh_tid(), wid = tid >> 6, lane = tid & 63, r32 = lane & 31, hi = lane >> 5;
  char* V_lds = lds; char* K_lds = lds + 2 * SHM_V;
  float* ws = (float*)(lds + 2 * SHM_V + 2 * SHM_K) + wid * 64; float* li_l = ws; float* al_l = ws + 32; int* dst_l = (int*)(lds + ACS_OFF) + wid * 32;
  float m_reg = NEG, l_reg = 0; f32x16 o[4] = {}; bf16x8 qr[8];
#pragma unroll
  for (int d0 = 0; d0 < 8; ++d0) qr[d0] = ld8(Qw + d0 * 16);
  const int sr = tid >> 4, sc = (tid & 15) * 8, vst0 = v_st(sr, sc), vst1 = v_st(32 + sr, sc);
  const int vb0 = (int)(uintptr_t)V_lds + v_rd_base(lane);
  const int qrow = wid * QBLK + r32;
  const bf16* Kp = Kh + (long)sr * ldk + sc; const bf16* Vp = Vh + (long)sr * ldk + sc;
#define RESC(a) do { if (__any((a) < 1.f)) { if (hi == 0) al_l[r32] = (a); asm volatile("s_waitcnt lgkmcnt(0)" ::: "memory"); \
    _Pragma("unroll") for (int d = 0; d < 4; ++d) _Pragma("unroll") for (int r = 0; r < 16; ++r) o[d][r] *= al_l[crow(r, hi)]; } } while (0)
  if constexpr (OWN) {
    bf16x8 vs0, vs1, ks0, ks1;
#define SLOAD1(idx) do { const long ko_ = (long)(64 * (idx)) * ldk; vs0 = ld8(Vp + ko_); vs1 = ld8(Vp + ko_ + 32 * ldk); ks0 = ld8(Kp + ko_); ks1 = ld8(Kp + ko_ + 32 * ldk); } while (0)
    SLOAD1(0);
#pragma nounroll
    for (int idx = 0; idx < NT; ++idx) {
      __syncthreads();
      *(bf16x8*)(V_lds + vst0) = vs0; *(bf16x8*)(V_lds + vst1) = vs1; { const int kc = sc * 2; *(bf16x8*)(K_lds + KSWZ(sr, kc)) = ks0; *(bf16x8*)(K_lds + KSWZ(32 + sr, kc)) = ks1; }
      if (idx + 1 < NT) SLOAD1(idx + 1);
      __syncthreads();
      f32x16 p0, p1; float mn, al; bf16x8 pa0, pa1, pa2, pa3;
      qkt<true>(p0, p1, K_lds, qr, r32, hi, qrow - 64 * idx - 4 * hi);
      partialSM(p0, p1, m_reg, mn, al);
      RESC(al);
      finishSM(p0, p1, al, l_reg, pa0, pa1, pa2, pa3); SBAR();
      pv_d0(o, vb0, pa0, pa1, pa2, pa3);
    }
#undef SLOAD1
  } else {
    struct { bf16x8 vs0, vs1, ks0, ks1; } sr_[2];
#define SLOAD(i, idx) do { const long ko_ = (long)(64 * (idx)) * ldk; sr_[i].vs0 = ld8(Vp + ko_); sr_[i].vs1 = ld8(Vp + ko_ + 32 * ldk); \
    sr_[i].ks0 = ld8(Kp + ko_); sr_[i].ks1 = ld8(Kp + ko_ + 32 * ldk); } while (0)
#define SWRITE(bb, i) do { *(bf16x8*)(V_lds + (bb) * SHM_V + vst0) = sr_[i].vs0;          \
    *(bf16x8*)(V_lds + (bb) * SHM_V + vst1) = sr_[i].vs1; const int kc = sc * 2;               \
    *(bf16x8*)(K_lds + (bb) * SHM_K + KSWZ(sr, kc)) = sr_[i].ks0;                       \
    *(bf16x8*)(K_lds + (bb) * SHM_K + KSWZ(32 + sr, kc)) = sr_[i].ks1; } while (0)
#define SWAIT() asm volatile("s_waitcnt vmcnt(4)" ::: "memory")
    f32x16 pA0, pA1, pB0, pB1; float mnA, mnB, alA, alB; bf16x8 pa0, pa1, pa2, pa3;
    SLOAD(0, 0); asm volatile("s_waitcnt vmcnt(0)" ::: "memory"); SWRITE(0, 0); __syncthreads();
    qkt<false>(pA0, pA1, K_lds, qr, r32, hi); partialSM(pA0, pA1, m_reg, mnA, alA);
    SLOAD(1, 1); SLOAD(0, 2);
    SWAIT(); SWRITE(1, 1); __syncthreads();
    SBAR(); qkt<false>(pB0, pB1, K_lds + SHM_K, qr, r32, hi);
    finishSM(pA0, pA1, alA, l_reg, pa0, pa1, pa2, pa3); SBAR();
    SLOAD(1, 3); SBAR();
    pv_d0(o, vb0, pa0, pa1, pa2, pa3); partialSM(pB0, pB1, m_reg, mnB, alB);
    __syncthreads(); SWAIT(); SWRITE(0, 0);
    RESC(alB); __syncthreads();
    SBAR(); qkt<false>(pA0, pA1, K_lds, qr, r32, hi);
    finishSM(pB0, pB1, alB, l_reg, pa0, pa1, pa2, pa3); SBAR();
    pv_d0(o, vb0 + SHM_V, pa0, pa1, pa2, pa3); partialSM(pA0, pA1, m_reg, mnA, alA);
    __syncthreads(); asm volatile("s_waitcnt vmcnt(0)" ::: "memory"); SWRITE(1, 1);
    RESC(alA); __syncthreads();
    SBAR(); qkt<false>(pB0, pB1, K_lds + SHM_K, qr, r32, hi);
    finishSM(pA0, pA1, alA, l_reg, pa0, pa1, pa2, pa3); SBAR();
    pv_d0(o, vb0, pa0, pa1, pa2, pa3); partialSM(pB0, pB1, m_reg, mnB, alB);
    __syncthreads(); RESC(alB);
    finishSM(pB0, pB1, alB, l_reg, pa0, pa1, pa2, pa3); SBAR();
    pv_d0(o, vb0 + SHM_V, pa0, pa1, pa2, pa3);
#undef SLOAD
#undef SWRITE
#undef SWAIT
  }
#undef RESC
  if (hi == 0) { li_l[r32] = l_reg; dst_l[r32] = dst; if (dst >= 0) { PARTML[2 * (size_t)dst] = m_reg; PARTML[2 * (size_t)dst + 1] = l_reg; } }
  asm volatile("s_waitcnt lgkmcnt(0)" ::: "memory");
#pragma unroll
  for (int r = 0; r < 16; ++r) { const int row = crow(r, hi); const int d = dst_l[row]; const float rl = __builtin_amdgcn_rcpf(li_l[row]);
    if (d >= 0) { bf16* op = PARTO + (size_t)d * 128 + r32;
#pragma unroll
      for (int d0 = 0; d0 < 4; ++d0) op[d0 * 32] = (bf16)(cvtpk(o[d0][r] * rl, 0.f) & 0xffffu); } }
  __syncthreads();
}

__device__ __forceinline__ void moba_kv_item(const bf16* __restrict__ QKVM, int h, int j, int row0, int rowend, const int* segp, const unsigned* __restrict__ ROWMASK, const unsigned char* __restrict__ SEG,
                                             bf16* __restrict__ PARTO, float* __restrict__ PARTML, char* lds, char* scr) {
  constexpr int ld = 5120;
  const int tid = fresh_tid(), wid = tid >> 6, lane = tid & 63, r32 = lane & 31, hi = lane >> 5;
  char* V_lds = lds; char* K_lds = lds + 4 * SHM_V;
  float* ws = (float*)scr + wid * 64; float* li_l = ws; float* al_l = ws + 32; int* dst_l = (int*)(scr + 2048) + wid * 32;
  {
    const int sr = tid >> 4, sc = (tid & 15) * 8, vst0 = v_st(sr, sc), vst1 = v_st(32 + sr, sc);
    const bf16* Kp = QKVM + (size_t)(256 * j + sr) * ld + 1536 + h * 128 + sc; const bf16* Vp = Kp + 1536;
    bf16x8 kv[16];
#pragma unroll
    for (int i = 0; i < 4; ++i) { kv[4 * i] = ld8(Kp + (size_t)(64 * i) * ld); kv[4 * i + 1] = ld8(Kp + (size_t)(64 * i + 32) * ld); kv[4 * i + 2] = ld8(Vp + (size_t)(64 * i) * ld); kv[4 * i + 3] = ld8(Vp + (size_t)(64 * i + 32) * ld); }
#pragma unroll
    for (int i = 0; i < 4; ++i) { const int kc = sc * 2;
      *(bf16x8*)(K_lds + i * SHM_K + KSWZ(sr, kc)) = kv[4 * i]; *(bf16x8*)(K_lds + i * SHM_K + KSWZ(32 + sr, kc)) = kv[4 * i + 1];
      *(bf16x8*)(V_lds + i * SHM_V + vst0) = kv[4 * i + 2]; *(bf16x8*)(V_lds + i * SHM_V + vst1) = kv[4 * i + 3]; } }
  __syncthreads();
  const int vb0 = (int)(uintptr_t)V_lds + v_rd_base(lane);
  const int nwu = (rowend - row0 + 31) >> 5;
#pragma nounroll
  for (int wu = wid; wu < nwu; wu += NW) {
    const int r = row0 + wu * 32 + r32; const bool own = r < 256; const bool valid = r < rowend;
    int t, dst;
    if (own) { t = 256 * j + r; dst = (t * 12 + h) * 4 + 3; }
    else { const int rg = valid ? r - 256 : 0; int b = j + 1; while (b < 31 && rg >= segp[b + 1]) ++b;
      t = 256 * b + SEG[((size_t)(h * 32 + j) * 32 + b) * 256 + (rg - segp[b])];
      const unsigned rm = ROWMASK[(size_t)t * 12 + h]; dst = valid ? (t * 12 + h) * 4 + __popc(rm & ((1u << j) - 1u)) : -1; }
    bf16x8 qr[8];
    { const bf16* Qw = QKVM + (size_t)t * ld + h * 128 + hi * 8;
#pragma unroll
      for (int d0 = 0; d0 < 8; ++d0) qr[d0] = ld8(Qw + d0 * 16); }
    float m_reg = NEG, l_reg = 0; f32x16 o[4] = {};
    const int limbase = own ? (r - 4 * hi) : 4096;
    const int ntl = own ? ((row0 + wu * 32 + 31) >> 6) + 1 : 4;
#pragma nounroll
    for (int idx = 0; idx < ntl; ++idx) {
      f32x16 p0, p1; float mn, al; bf16x8 pa0, pa1, pa2, pa3;
      qkt<true>(p0, p1, K_lds + idx * SHM_K, qr, r32, hi, limbase - 64 * idx);
      partialSM(p0, p1, m_reg, mn, al);
      if (__any(al < 1.f)) { if (hi == 0) al_l[r32] = al; asm volatile("s_waitcnt lgkmcnt(0)" ::: "memory");
#pragma unroll
        for (int d = 0; d < 4; ++d)
#pragma unroll
          for (int rr = 0; rr < 16; ++rr) o[d][rr] *= al_l[crow(rr, hi)]; }
      finishSM(p0, p1, al, l_reg, pa0, pa1, pa2, pa3); SBAR();
      pv_il(o, vb0 + idx * SHM_V, pa0, pa1, pa2, pa3);
    }
    if (hi == 0) { li_l[r32] = l_reg; dst_l[r32] = dst; if (dst >= 0) { PARTML[2 * (size_t)dst] = m_reg; PARTML[2 * (size_t)dst + 1] = l_reg; } }
    asm volatile("s_waitcnt lgkmcnt(0)" ::: "memory");
#pragma unroll
    for (int rr = 0; rr < 16; ++rr) { const int row = crow(rr, hi); const int d = dst_l[row]; const float rl = __builtin_amdgcn_rcpf(li_l[row]);
      if (d >= 0) { bf16* op = PARTO + (size_t)d * 128 + r32;
#pragma unroll
        for (int d0 = 0; d0 < 4; ++d0) op[d0 * 32] = (bf16)(cvtpk(o[d0][rr] * rl, 0.f) & 0xffffu); } }
    asm volatile("s_waitcnt lgkmcnt(0)" ::: "memory");
  }
  __syncthreads();
}
constexpr int CVP = 4096, CV_B = 1536, CV_C = 2048, CV_XDT = 2560;
constexpr float LOG2E = 1.4426950408889634f;
__device__ __forceinline__ void ssd_state_unit(const bf16* __restrict__ CV, const float* __restrict__ ACS, float* __restrict__ STATES, int c, int h, char* lds) {
  const int tid = fresh_tid(), wid = tid >> 6, lane = tid & 63, r32 = lane & 31, hi = lane >> 5;
  const int g = h / 6; const long t0 = 256L * c;
  char* X_lds = lds; char* B_lds = lds + SHM_V; float* acs_lds = (float*)(lds + ACS_OFF);
  if (tid < 256) acs_lds[tid] = ACS[(c * 24 + h) * 256 + tid];
  const int sr = tid >> 4, sc = (tid & 15) * 8, vst0 = v_st(sr, sc), vst1 = v_st(32 + sr, sc);
  const int pb = wid & 1, nb = wid >> 1;
  const int xb = (int)(uintptr_t)X_lds + v_rd_base(lane) + pb * 512, bb = (int)(uintptr_t)B_lds + v_rd_base(lane) + nb * 512;
  bf16x8 xv0 = {}, xv1 = {}, kb0, kb1;
#define SLOAD(i) do { const bf16* rp = CV + (t0 + 64 * (i) + sr) * CVP; kb0 = ld8(rp + CV_B + g * 128 + sc); kb1 = ld8(rp + 32 * CVP + CV_B + g * 128 + sc); \
    if (sc < 64) { xv0 = ld8(rp + CV_XDT + h * 64 + sc); xv1 = ld8(rp + 32 * CVP + CV_XDT + h * 64 + sc); } } while (0)
  SLOAD(0);
  f32x16 acc = f32x16{};
#pragma nounroll
  for (int i = 0; i < 4; ++i) {
    __syncthreads();
    const float aend = acs_lds[255];
    if (sc < 64) {
      const float f0 = __builtin_amdgcn_exp2f((aend - acs_lds[64 * i + sr]) * LOG2E), f1 = __builtin_amdgcn_exp2f((aend - acs_lds[64 * i + 32 + sr]) * LOG2E);
      u32x4 w0, w1;
#pragma unroll
      for (int q = 0; q < 4; ++q) { w0[q] = cvtpk(bf2f((unsigned short)xv0[2 * q]) * f0, bf2f((unsigned short)xv0[2 * q + 1]) * f0);
                                    w1[q] = cvtpk(bf2f((unsigned short)xv1[2 * q]) * f1, bf2f((unsigned short)xv1[2 * q + 1]) * f1); }
      *(u32x4*)(X_lds + vst0) = w0; *(u32x4*)(X_lds + vst1) = w1;
    }
    *(bf16x8*)(B_lds + vst0) = kb0; *(bf16x8*)(B_lds + vst1) = kb1;
    if (i < 3) SLOAD(i + 1);
    __syncthreads();
    { const s16x4 al0 = tr_read<v_rd_off(0, 0, 0)>(xb), ah0 = tr_read<v_rd_off(0, 0, 1)>(xb), al1 = tr_read<v_rd_off(0, 1, 0)>(xb), ah1 = tr_read<v_rd_off(0, 1, 1)>(xb);
      const s16x4 al2 = tr_read<v_rd_off(0, 2, 0)>(xb), ah2 = tr_read<v_rd_off(0, 2, 1)>(xb), al3 = tr_read<v_rd_off(0, 3, 0)>(xb), ah3 = tr_read<v_rd_off(0, 3, 1)>(xb);
      const s16x4 bl0 = tr_read<v_rd_off(0, 0, 0)>(bb), bh0 = tr_read<v_rd_off(0, 0, 1)>(bb), bl1 = tr_read<v_rd_off(0, 1, 0)>(bb), bh1 = tr_read<v_rd_off(0, 1, 1)>(bb);
      const s16x4 bl2 = tr_read<v_rd_off(0, 2, 0)>(bb), bh2 = tr_read<v_rd_off(0, 2, 1)>(bb), bl3 = tr_read<v_rd_off(0, 3, 0)>(bb), bh3 = tr_read<v_rd_off(0, 3, 1)>(bb);
      asm volatile("s_waitcnt lgkmcnt(0)" ::: "memory"); SBAR();
      acc = __builtin_amdgcn_mfma_f32_32x32x16_bf16(ATT_PK(al0, ah0), ATT_PK(bl0, bh0), acc, 0, 0, 0);
      acc = __builtin_amdgcn_mfma_f32_32x32x16_bf16(ATT_PK(al1, ah1), ATT_PK(bl1, bh1), acc, 0, 0, 0);
      acc = __builtin_amdgcn_mfma_f32_32x32x16_bf16(ATT_PK(al2, ah2), ATT_PK(bl2, bh2), acc, 0, 0, 0);
      acc = __builtin_amdgcn_mfma_f32_32x32x16_bf16(ATT_PK(al3, ah3), ATT_PK(bl3, bh3), acc, 0, 0, 0); }
  }
#undef SLOAD
  float* Sp = STATES + ((long)(c * 24 + h) * 64 + 32 * pb) * 128 + 32 * nb + r32;
#pragma unroll
  for (int r = 0; r < 16; ++r) Sp[crow(r, hi) * 128] = acc[r];
  __syncthreads();
}
__device__ __forceinline__ void ssd_y_unit(const bf16* __restrict__ CV, const float* __restrict__ ACS, const bf16* __restrict__ PREV, float dsk, float* __restrict__ YS, int c, int h, char* lds) {
  const int tid = fresh_tid(), wid = tid >> 6, lane = tid & 63, r32 = lane & 31, hi = lane >> 5;
  const int g = h / 6; const long t0 = 256L * c;
  char* V_lds = lds; char* K_lds = lds + 2 * SHM_V; float* acs_lds = (float*)(lds + ACS_OFF);
  if (tid < 256) acs_lds[tid] = ACS[(c * 24 + h) * 256 + tid];
  const int lrow = wid * 32 + r32;
  const float acs_l = ACS[(c * 24 + h) * 256 + lrow];
  bf16x8 qr[8];
  { const bf16* Qw = CV + (t0 + lrow) * CVP + CV_C + g * 128 + hi * 8;
#pragma unroll
    for (int d0 = 0; d0 < 8; ++d0) qr[d0] = ld8(Qw + d0 * 16); }
  const int sr = tid >> 4, sc = (tid & 15) * 8, vst0 = v_st(sr, sc), vst1 = v_st(32 + sr, sc);
  const int vb0 = (int)(uintptr_t)V_lds + v_rd_base(lane);
  bf16x8 xv0 = {}, xv1 = {}, kb0, kb1;
#define SLOAD(i) do { const bf16* rp = CV + (t0 + 64 * (i) + sr) * CVP; kb0 = ld8(rp + CV_B + g * 128 + sc); kb1 = ld8(rp + 32 * CVP + CV_B + g * 128 + sc); \
    if (sc < 64) { xv0 = ld8(rp + CV_XDT + h * 64 + sc); xv1 = ld8(rp + 32 * CVP + CV_XDT + h * 64 + sc); } } while (0)
  SLOAD(0);
  f32x16 o[2] = {};
#pragma nounroll
  for (int i = 0; i < 4; ++i) {
    __syncthreads();
    { const int kc = sc * 2; *(bf16x8*)(K_lds + KSWZ(sr, kc)) = kb0; *(bf16x8*)(K_lds + KSWZ(32 + sr, kc)) = kb1; }
    if (sc < 64) { *(bf16x8*)(V_lds + vst0) = xv0; *(bf16x8*)(V_lds + vst1) = xv1; }
    if (i < 3) SLOAD(i + 1);
    __syncthreads();
    if (64 * i <= wid * 32 + 31) {
      f32x16 p0, p1; qkt<false>(p0, p1, K_lds, qr, r32, hi);
#pragma unroll
      for (int r = 0; r < 16; ++r) { const int s = 64 * i + crow(r, hi);
        const float e0 = __builtin_amdgcn_exp2f((acs_l - acs_lds[s]) * LOG2E), e1 = __builtin_amdgcn_exp2f((acs_l - acs_lds[s + 32]) * LOG2E);
        p0[r] = (s <= lrow) ? p0[r] * e0 : 0.f; p1[r] = (s + 32 <= lrow) ? p1[r] * e1 : 0.f; }
      bf16x8 pa0, pa1, pa2, pa3;
      ATT_PK4(p0, 0, pa0); ATT_PK4(p0, 8, pa1); ATT_PK4(p1, 0, pa2); ATT_PK4(p1, 8, pa3);
      pv_one<0>(o[0], vb0, pa0, pa1, pa2, pa3); pv_one<1>(o[1], vb0, pa0, pa1, pa2, pa3);
    }
  }
#undef SLOAD
  f32x16 o2[2] = {};
  { const bf16* Pp = PREV + ((long)(c * 24 + h) * 64 + r32) * 128 + hi * 8;
#pragma unroll
    for (int d0 = 0; d0 < 2; ++d0)
#pragma unroll
      for (int d = 0; d < 8; ++d) { const bf16x8 bfrag = ld8(Pp + d0 * 32 * 128 + d * 16);
        o2[d0] = __builtin_amdgcn_mfma_f32_32x32x16_bf16(qr[d], bfrag, o2[d0], 0, 0, 0); } }
  { const bf16* xp0 = CV + (t0 + wid * 32 + 4 * hi) * CVP + h * 64 + r32; float* yp0 = YS + (t0 + wid * 32 + 4 * hi) * 1536 + h * 64 + r32; const float* ap = acs_lds + wid * 32 + 4 * hi;
#pragma unroll
  for (int r = 0; r < 16; ++r) { const int ro = (r & 3) + 8 * (r >> 2); const float ea = __builtin_amdgcn_exp2f(ap[ro] * LOG2E);
    asm volatile("" ::: "memory");
#pragma unroll
    for (int d0 = 0; d0 < 2; ++d0) yp0[ro * 1536 + d0 * 32] = o[d0][r] + o2[d0][r] * ea + dsk * bf2f(xp0[ro * CVP + d0 * 32]); } }
  __syncthreads();
}
__device__ __forceinline__ void ssd_state_unit2(const bf16* __restrict__ CV, const float* __restrict__ ACS, float* __restrict__ STATES, int c, int h, char* lds, float* acs_lds) {
  const int tid = fresh_tid(), wid = tid >> 6, lane = tid & 63, r32 = lane & 31, hi = lane >> 5;
  const int g = h / 6; const long t0 = 256L * c;
  char* X_lds = lds; char* B_lds = lds + 4 * SHM_V;
  const float* acs_g = ACS + (c * 24 + h) * 256;
  const int sr = tid >> 4, sc = (tid & 15) * 8, vst0 = v_st(sr, sc), vst1 = v_st(32 + sr, sc);
  const int pb = wid & 1, nb = wid >> 1;
  const int xb = (int)(uintptr_t)X_lds + v_rd_base(lane) + pb * 512, bb = (int)(uintptr_t)B_lds + v_rd_base(lane) + nb * 512;
  { bf16x8 kb[8], xv[8]; const float aend = acs_g[255]; float f[8];
    const bf16* rp = CV + (t0 + sr) * CVP;
#pragma unroll
    for (int i = 0; i < 4; ++i) { kb[2 * i] = ld8(rp + (size_t)(64 * i) * CVP + CV_B + g * 128 + sc); kb[2 * i + 1] = ld8(rp + (size_t)(64 * i + 32) * CVP + CV_B + g * 128 + sc);
      if (sc < 64) { xv[2 * i] = ld8(rp + (size_t)(64 * i) * CVP + CV_XDT + h * 64 + sc); xv[2 * i + 1] = ld8(rp + (size_t)(64 * i + 32) * CVP + CV_XDT + h * 64 + sc);
        f[2 * i] = __builtin_amdgcn_exp2f((aend - acs_g[64 * i + sr]) * LOG2E); f[2 * i + 1] = __builtin_amdgcn_exp2f((aend - acs_g[64 * i + 32 + sr]) * LOG2E); } }
#pragma unroll
    for (int i = 0; i < 4; ++i) {
      *(bf16x8*)(B_lds + i * SHM_V + vst0) = kb[2 * i]; *(bf16x8*)(B_lds + i * SHM_V + vst1) = kb[2 * i + 1];
      if (sc < 64) { u32x4 w0, w1;
#pragma unroll
        for (int q = 0; q < 4; ++q) { w0[q] = cvtpk(bf2f((unsigned short)xv[2 * i][2 * q]) * f[2 * i], bf2f((unsigned short)xv[2 * i][2 * q + 1]) * f[2 * i]);
                                      w1[q] = cvtpk(bf2f((unsigned short)xv[2 * i + 1][2 * q]) * f[2 * i + 1], bf2f((unsigned short)xv[2 * i + 1][2 * q + 1]) * f[2 * i + 1]); }
        *(u32x4*)(X_lds + i * SHM_V + vst0) = w0; *(u32x4*)(X_lds + i * SHM_V + vst1) = w1; } } }
  __syncthreads();
  f32x16 acc = f32x16{};
#pragma unroll
  for (int i = 0; i < 4; ++i) {
    const int xo = xb + i * SHM_V, bo = bb + i * SHM_V;
    const s16x4 al0 = tr_read<v_rd_off(0, 0, 0)>(xo), ah0 = tr_read<v_rd_off(0, 0, 1)>(xo), al1 = tr_read<v_rd_off(0, 1, 0)>(xo), ah1 = tr_read<v_rd_off(0, 1, 1)>(xo);
    const s16x4 al2 = tr_read<v_rd_off(0, 2, 0)>(xo), ah2 = tr_read<v_rd_off(0, 2, 1)>(xo), al3 = tr_read<v_rd_off(0, 3, 0)>(xo), ah3 = tr_read<v_rd_off(0, 3, 1)>(xo);
    const s16x4 bl0 = tr_read<v_rd_off(0, 0, 0)>(bo), bh0 = tr_read<v_rd_off(0, 0, 1)>(bo), bl1 = tr_read<v_rd_off(0, 1, 0)>(bo), bh1 = tr_read<v_rd_off(0, 1, 1)>(bo);
    const s16x4 bl2 = tr_read<v_rd_off(0, 2, 0)>(bo), bh2 = tr_read<v_rd_off(0, 2, 1)>(bo), bl3 = tr_read<v_rd_off(0, 3, 0)>(bo), bh3 = tr_read<v_rd_off(0, 3, 1)>(bo);
    asm volatile("s_waitcnt lgkmcnt(0)" ::: "memory"); SBAR();
    acc = __builtin_amdgcn_mfma_f32_32x32x16_bf16(ATT_PK(al0, ah0), ATT_PK(bl0, bh0), acc, 0, 0, 0);
    acc = __builtin_amdgcn_mfma_f32_32x32x16_bf16(ATT_PK(al1, ah1), ATT_PK(bl1, bh1), acc, 0, 0, 0);
    acc = __builtin_amdgcn_mfma_f32_32x32x16_bf16(ATT_PK(al2, ah2), ATT_PK(bl2, bh2), acc, 0, 0, 0);
    acc = __builtin_amdgcn_mfma_f32_32x32x16_bf16(ATT_PK(al3, ah3), ATT_PK(bl3, bh3), acc, 0, 0, 0);
  }
  float* Sp = STATES + ((long)(c * 24 + h) * 64 + 32 * pb) * 128 + 32 * nb + r32;
#pragma unroll
  for (int r = 0; r < 16; ++r) Sp[crow(r, hi) * 128] = acc[r];
  __syncthreads();
}
__device__ __forceinline__ void ssd_y_unit2(const bf16* __restrict__ CV, const float* __restrict__ ACS, const bf16* __restrict__ PREV, float dsk, float* __restrict__ YS, int c, int h, char* lds, float* acs_lds) {
  const int tid = fresh_tid(), wid = tid >> 6, lane = tid & 63, r32 = lane & 31, hi = lane >> 5;
  const int g = h / 6; const long t0 = 256L * c;
  char* V_lds = lds; char* K_lds = lds + 4 * SHM_V;
  if (tid < 256) acs_lds[tid] = ACS[(c * 24 + h) * 256 + tid];
  const int lrow = wid * 32 + r32;
  const float acs_l = ACS[(c * 24 + h) * 256 + lrow];
  bf16x8 qr[8];
  { const bf16* Qw = CV + (t0 + lrow) * CVP + CV_C + g * 128 + hi * 8;
#pragma unroll
    for (int d0 = 0; d0 < 8; ++d0) qr[d0] = ld8(Qw + d0 * 16); }
  { const int sr = tid >> 4, sc = (tid & 15) * 8, vst0 = v_st(sr, sc), vst1 = v_st(32 + sr, sc);
    bf16x8 kb[8], xv[8]; const bf16* rp = CV + (t0 + sr) * CVP;
#pragma unroll
    for (int i = 0; i < 4; ++i) { kb[2 * i] = ld8(rp + (size_t)(64 * i) * CVP + CV_B + g * 128 + sc); kb[2 * i + 1] = ld8(rp + (size_t)(64 * i + 32) * CVP + CV_B + g * 128 + sc);
      if (sc < 64) { xv[2 * i] = ld8(rp + (size_t)(64 * i) * CVP + CV_XDT + h * 64 + sc); xv[2 * i + 1] = ld8(rp + (size_t)(64 * i + 32) * CVP + CV_XDT + h * 64 + sc); } }
#pragma unroll
    for (int i = 0; i < 4; ++i) { const int kc = sc * 2;
      *(bf16x8*)(K_lds + i * SHM_K + KSWZ(sr, kc)) = kb[2 * i]; *(bf16x8*)(K_lds + i * SHM_K + KSWZ(32 + sr, kc)) = kb[2 * i + 1];
      if (sc < 64) { *(bf16x8*)(V_lds + i * SHM_V + vst0) = xv[2 * i]; *(bf16x8*)(V_lds + i * SHM_V + vst1) = xv[2 * i + 1]; } } }
  __syncthreads();
  const int vb0 = (int)(uintptr_t)V_lds + v_rd_base(lane);
  f32x16 o[2] = {};
  const int ntile = (wid * 32 + 31) / 64 + 1;
#pragma nounroll
  for (int i = 0; i < ntile; ++i) {
    f32x16 p0, p1; qkt<false>(p0, p1, K_lds + i * SHM_K, qr, r32, hi);
#pragma unroll
    for (int r = 0; r < 16; ++r) { const int s = 64 * i + crow(r, hi);
      const float e0 = __builtin_amdgcn_exp2f((acs_l - acs_lds[s]) * LOG2E), e1 = __builtin_amdgcn_exp2f((acs_l - acs_lds[s + 32]) * LOG2E);
      p0[r] = (s <= lrow) ? p0[r] * e0 : 0.f; p1[r] = (s + 32 <= lrow) ? p1[r] * e1 : 0.f; }
    bf16x8 pa0, pa1, pa2, pa3;
    ATT_PK4(p0, 0, pa0); ATT_PK4(p0, 8, pa1); ATT_PK4(p1, 0, pa2); ATT_PK4(p1, 8, pa3);
    pv_one<0>(o[0], vb0 + i * SHM_V, pa0, pa1, pa2, pa3); pv_one<1>(o[1], vb0 + i * SHM_V, pa0, pa1, pa2, pa3);
  }
  f32x16 o2[2] = {};
  { const bf16* Pp = PREV + ((long)(c * 24 + h) * 64 + r32) * 128 + hi * 8;
#pragma unroll
    for (int d0 = 0; d0 < 2; ++d0)
#pragma unroll
      for (int d = 0; d < 8; ++d) { const bf16x8 bfrag = ld8(Pp + d0 * 32 * 128 + d * 16);
        o2[d0] = __builtin_amdgcn_mfma_f32_32x32x16_bf16(qr[d], bfrag, o2[d0], 0, 0, 0); } }
  { const bf16* xp0 = CV + (t0 + wid * 32 + 4 * hi) * CVP + h * 64 + r32; float* yp0 = YS + (t0 + wid * 32 + 4 * hi) * 1536 + h * 64 + r32; const float* ap = acs_lds + wid * 32 + 4 * hi;
  unsigned short xs0[16], xs1[16];
#pragma unroll
  for (int r = 0; r < 16; ++r) { const int ro = (r & 3) + 8 * (r >> 2); xs0[r] = xp0[ro * CVP]; xs1[r] = xp0[ro * CVP + 32]; }
#pragma unroll
  for (int r = 0; r < 16; ++r) { const int ro = (r & 3) + 8 * (r >> 2); const float ea = __builtin_amdgcn_exp2f(ap[ro] * LOG2E);
    yp0[ro * 1536] = o[0][r] + o2[0][r] * ea + dsk * bf2f(xs0[r]); yp0[ro * 1536 + 32] = o[1][r] + o2[1][r] * ea + dsk * bf2f(xs1[r]); } }
  __syncthreads();
}
__device__ __forceinline__ void ssd_y_units(const bf16* __restrict__ CV, const float* __restrict__ ACS, const bf16* __restrict__ PREV, const float* __restrict__ dskp, float* __restrict__ YS,
                                            int u0, int ustep, char* lds, float* acs_lds) {
  const int tid = fresh_tid(), wid = tid >> 6, lane = tid & 63, r32 = lane & 31, hi = lane >> 5;
  char* V_lds = lds; char* K_lds = lds + 4 * SHM_V;
  const int lrow = wid * 32 + r32;
  const int sr = tid >> 4, sc = (tid & 15) * 8, vst0 = v_st(sr, sc), vst1 = v_st(32 + sr, sc);
  const int vb0 = (int)(uintptr_t)V_lds + v_rd_base(lane);
  const int ntile = (wid * 32 + 31) / 64 + 1;
  const int sr2 = tid >> 3, sc2 = (tid & 7) * 8, vst2 = v_st(sr2, sc2);
  bf16x8 kbn[8], xvn[4], qn[8]; float acsn = 0.f, acsln = 0.f;
#define YU_LOAD(u_) do { const int c_ = (u_) / 24, h_ = (u_) % 24, g_ = h_ / 6; const long t0_ = 256L * c_; const bf16* rp_ = CV + (t0_ + sr) * CVP; \
    _Pragma("unroll") for (int i = 0; i < 4; ++i) { kbn[2 * i] = ld8(rp_ + (size_t)(64 * i) * CVP + CV_B + g_ * 128 + sc); kbn[2 * i + 1] = ld8(rp_ + (size_t)(64 * i + 32) * CVP + CV_B + g_ * 128 + sc); \
      xvn[i] = ld8(CV + (t0_ + 64 * i + sr2) * CVP + CV_XDT + h_ * 64 + sc2); } \
    { const bf16* Qw_ = CV + (t0_ + lrow) * CVP + CV_C + g_ * 128 + hi * 8; _Pragma("unroll") for (int d0 = 0; d0 < 8; ++d0) qn[d0] = ld8(Qw_ + d0 * 16); } \
    acsn = ACS[(c_ * 24 + h_) * 256 + (tid & 255)]; acsln = ACS[(c_ * 24 + h_) * 256 + lrow]; } while (0)
  if (u0 < 768) YU_LOAD(u0);
#pragma nounroll
  for (int u = u0; u < 768; u += ustep) {
    const int c = u / 24, h = u % 24; const long t0 = 256L * c; const float dsk = dskp[h];
    bf16x8 qr[8]; const float acs_l = acsln;
#pragma unroll
    for (int d0 = 0; d0 < 8; ++d0) qr[d0] = qn[d0];
    if (tid < 256) acs_lds[tid] = acsn;
#pragma unroll
    for (int i = 0; i < 4; ++i) { const int kc = sc * 2;
      *(bf16x8*)(K_lds + i * SHM_K + KSWZ(sr, kc)) = kbn[2 * i]; *(bf16x8*)(K_lds + i * SHM_K + KSWZ(32 + sr, kc)) = kbn[2 * i + 1];
      *(bf16x8*)(V_lds + i * SHM_V + vst2) = xvn[i]; }
    __syncthreads();
    if (u + ustep < 768) YU_LOAD(u + ustep);
    f32x16 o[2] = {};
#pragma nounroll
    for (int i = 0; i < ntile; ++i) {
      f32x16 p0, p1; qkt<false>(p0, p1, K_lds + i * SHM_K, qr, r32, hi);
#pragma unroll
      for (int r = 0; r < 16; ++r) { const int s = 64 * i + crow(r, hi);
        const float e0 = __builtin_amdgcn_exp2f((acs_l - acs_lds[s]) * LOG2E), e1 = __builtin_amdgcn_exp2f((acs_l - acs_lds[s + 32]) * LOG2E);
        p0[r] = (s <= lrow) ? p0[r] * e0 : 0.f; p1[r] = (s + 32 <= lrow) ? p1[r] * e1 : 0.f; }
      bf16x8 pa0, pa1, pa2, pa3;
      ATT_PK4(p0, 0, pa0); ATT_PK4(p0, 8, pa1); ATT_PK4(p1, 0, pa2); ATT_PK4(p1, 8, pa3);
      pv_one<0>(o[0], vb0 + i * SHM_V, pa0, pa1, pa2, pa3); pv_one<1>(o[1], vb0 + i * SHM_V, pa0, pa1, pa2, pa3);
    }
    f32x16 o2[2] = {};
    { const bf16* Pp = PREV + ((long)(c * 24 + h) * 64 + r32) * 128 + hi * 8;
#pragma unroll
      for (int d0 = 0; d0 < 2; ++d0)
#pragma unroll
        for (int d = 0; d < 8; ++d) { const bf16x8 bfrag = ld8(Pp + d0 * 32 * 128 + d * 16);
          o2[d0] = __builtin_amdgcn_mfma_f32_32x32x16_bf16(qr[d], bfrag, o2[d0], 0, 0, 0); } }
    { const bf16* xp0 = CV + (t0 + wid * 32 + 4 * hi) * CVP + h * 64 + r32; float* yp0 = YS + (t0 + wid * 32 + 4 * hi) * 1536 + h * 64 + r32; const float* ap = acs_lds + wid * 32 + 4 * hi;
      unsigned short xs0[16], xs1[16];
#pragma unroll
      for (int r = 0; r < 16; ++r) { const int ro = (r & 3) + 8 * (r >> 2); xs0[r] = xp0[ro * CVP]; xs1[r] = xp0[ro * CVP + 32]; }
#pragma unroll
      for (int r = 0; r < 16; ++r) { const int ro = (r & 3) + 8 * (r >> 2); const float ea = __builtin_amdgcn_exp2f(ap[ro] * LOG2E);
        yp0[ro * 1536] = o[0][r] + o2[0][r] * ea + dsk * bf2f(xs0[r]); yp0[ro * 1536 + 32] = o[1][r] + o2[1][r] * ea + dsk * bf2f(xs1[r]); } }
    __syncthreads();
  }
#undef YU_LOAD
}
#undef KSWZ
#undef SBAR
#undef ATT_PK
#undef ATT_PK4
}
constexpr int T = 8192, DM = 2048, DFF = 7168, NEXP = 8, MEML = 256;
constexpr int N_IN0 = 5120, N_IN1 = 4864, N_IN1_REAL = 4632;
constexpr int MOE_ROWS = 72 * 256;
constexpr float LN_EPS = 1e-5f, RMS_EPS = 1e-5f, DN_ALPHA = 1.41421356237309515f;
constexpr int NWAVES = 8;
#ifndef MK_PER_PHASE
#define MK_PER_PHASE 0
#endif
constexpr int NPHASE = 24;

constexpr size_t MiB = 1u << 20;
constexpr size_t WS_CTL = 0, CTL_ZERO_BYTES = 1 * MiB;
constexpr size_t WS_ROPE = 1 * MiB, WS_KMEAN = 2 * MiB, WS_DTR = 3 * MiB, WS_ACS = 4 * MiB;
constexpr size_t WS_TOKE = 5 * MiB, WS_TOKW = 5 * MiB + 65536, WS_POS = 5 * MiB + 131072, WS_COUNTS = 5 * MiB + 262144;
constexpr size_t WS_MEMB = 6 * MiB, WS_MEMKV = 7 * MiB;
constexpr size_t WS_WMKV = 8 * MiB, WS_WIN0 = WS_WMKV + 4 * MiB, WS_WO0 = WS_WIN0 + 20 * MiB, WS_WGU0 = WS_WO0 + 8 * MiB, WS_WD0 = WS_WGU0 + 56 * MiB;
constexpr size_t WS_WIN1 = WS_WD0 + 28 * MiB, WS_WO1 = WS_WIN1 + 19 * MiB, WS_WGUE = WS_WO1 + 8 * MiB, WS_WDE = WS_WGUE + 448 * MiB, WS_WEND = WS_WDE + 224 * MiB;
constexpr size_t WS_XCUR = WS_WEND + 1 * MiB, WS_XCURB = WS_XCUR + 64 * MiB, WS_HEADS = WS_XCURB + 32 * MiB, WS_YF = WS_HEADS + 32 * MiB;
constexpr size_t WS_RA = WS_YF + 64 * MiB, WS_RB = WS_RA + 252 * MiB, WS_RC = WS_RB + 144 * MiB;
constexpr size_t WS_STATES = WS_RC + 72 * MiB, WS_PREV = WS_STATES + 24 * MiB, WS_YSSD = WS_PREV + 12 * MiB, WS_END = WS_YSSD + 48 * MiB;
static_assert((size_t)N_IN1 * DM * 2 <= 19 * MiB && (size_t)MOE_ROWS * DFF * 2 <= 252 * MiB && (size_t)MOE_ROWS * DM * 4 <= 144 * MiB && (size_t)MOE_ROWS * DM * 2 <= 72 * MiB, "ws map");
constexpr size_t WS_ROWMASK = WS_YSSD, WS_CNT = WS_YSSD + 1 * MiB, WS_SEG = WS_YSSD + 2 * MiB;
constexpr int CW_TMO = 0, CW_BAR = 4096;

constexpr int RING_OFF = 0, RING_BYTES = 131072;
constexpr int LDSCTL_OFF = RING_BYTES, MISC_OFF = LDSCTL_OFF + 320;
constexpr int LDS_BYTES = 147456;

#define GAS __attribute__((address_space(1)))
#define LAS __attribute__((address_space(3)))
typedef unsigned short bf16;
typedef unsigned v4u __attribute__((ext_vector_type(4)));
typedef unsigned v2u __attribute__((ext_vector_type(2)));
typedef float f32x4 __attribute__((ext_vector_type(4)));
typedef short bf16x8 __attribute__((ext_vector_type(8)));
typedef GAS unsigned gu32;
#define RLX_AGENT __ATOMIC_RELAXED, __HIP_MEMORY_SCOPE_AGENT
#define LDS_WAIT() asm volatile("s_waitcnt lgkmcnt(0)" ::: "memory")
__device__ __forceinline__ unsigned pk2(float lo, float hi) { unsigned r; asm volatile("v_cvt_pk_bf16_f32 %0, %1, %2" : "=v"(r) : "v"(lo), "v"(hi)); return r; }
__device__ __forceinline__ float bf2f(unsigned short b) { return __uint_as_float(((unsigned)b) << 16); }
__device__ __forceinline__ float bflo(unsigned w) { return __uint_as_float(w << 16); }
__device__ __forceinline__ float bfhi(unsigned w) { return __uint_as_float(w & 0xffff0000u); }
__device__ __forceinline__ float wave_sum(float v) {
#pragma unroll
    for (int o = 1; o < 64; o <<= 1) v += __shfl_xor(v, o);
    return v;
}
__device__ __forceinline__ float silu_f(float g) { return g * __builtin_amdgcn_rcpf(1.0f + __builtin_amdgcn_exp2f(-1.4426950408889634f * g)); }
__device__ __forceinline__ float softplus_f(float x) { return x > 20.f ? x : log1pf(__expf(x)); }
#define XB_TMO      128
#define XB_XCNT(j)  (256  + 64 * (j))
#define XB_XSUB(j)  (1280 + 64 * (j))
#define XB_XGEN(j)  (2304 + 64 * (j))
#define XB_TOP      3328
#define XB_TOPGEN   3392
#define XCD_BAR_WORDS 3456
#define XB_SPIN_CAP (1u << 18)

__device__ __forceinline__ unsigned xb_ld(unsigned* p)              { return __hip_atomic_load(p, __ATOMIC_RELAXED, __HIP_MEMORY_SCOPE_AGENT); }
__device__ __forceinline__ unsigned xb_add(unsigned* p, unsigned v) { return __hip_atomic_fetch_add(p, v, __ATOMIC_RELAXED, __HIP_MEMORY_SCOPE_AGENT); }
__device__ __forceinline__ unsigned xb_xcc_id() { return (unsigned)__builtin_amdgcn_s_getreg((3 << 11) | 20) & 0xFu; }
#define XB_SPIN(cond, bar) do { unsigned _sp = 0; while (cond) { __builtin_amdgcn_s_sleep(1); \
    if ((++_sp & 255u) == 0u) { if (xb_ld(&(bar)[XB_TMO])) break; if (_sp > XB_SPIN_CAP) { atomicAdd(&(bar)[XB_TMO], 1u); break; } } } } while (0)

struct XcdBarrier {
    unsigned* bar; unsigned x; int w;
    volatile LAS unsigned* st;
};

__device__ __forceinline__ XcdBarrier xcd_barrier_post(unsigned* bar, volatile LAS unsigned* st, int wave) {
    XcdBarrier b; b.bar = bar; b.x = xb_xcc_id(); b.st = st; b.w = wave;
    if (threadIdx.x == 0) (void)xb_add(&bar[XB_XCNT(b.x)], 1u);
    return b;
}
__device__ __forceinline__ void xcd_barrier_complete(unsigned* bar, unsigned x, unsigned& nloc, unsigned& nx) {
    const unsigned G = gridDim.x * gridDim.y * gridDim.z;
    unsigned sum, cnt, mine, sp = 0u;
    for (;;) {
        sum = 0u; cnt = 0u; mine = 0u;
#pragma unroll
        for (unsigned j = 0; j < 16; ++j) { const unsigned c = xb_ld(&bar[XB_XCNT(j)]); sum += c; cnt += (c > 0u) ? 1u : 0u; mine = (j == x) ? c : mine; }
        if (sum == G) break;
        __builtin_amdgcn_s_sleep(1);
        if ((++sp & 255u) == 0u) { if (xb_ld(&bar[XB_TMO])) break; if (sp > XB_SPIN_CAP) { atomicAdd(&bar[XB_TMO], 1u); break; } }
    }
    nloc = mine > 0u ? mine : 1u; nx = cnt > 0u ? cnt : 1u;
}

__device__ __forceinline__ void xcd_barrier(const XcdBarrier& b) {
    asm volatile("s_waitcnt vmcnt(0)" ::: "memory");
    __syncthreads();
    unsigned z_; asm volatile("s_mov_b32 %0, 0" : "=s"(z_));
    if (b.w == 0 && __builtin_amdgcn_mbcnt_hi(~0u, __builtin_amdgcn_mbcnt_lo(~0u, z_)) == 0u) {
        unsigned* bar = b.bar;
        __builtin_amdgcn_s_waitcnt(0);
        unsigned nloc = b.st[0], nx = b.st[1];
        if (nloc == 0u) { xcd_barrier_complete(bar, b.x, nloc, nx); b.st[0] = nloc; b.st[1] = nx; }
        const unsigned old = xb_add(&bar[XB_XSUB(b.x)], 1u);
        const unsigned gen = old / nloc;
        if (old + 1u == (gen + 1u) * nloc) {
            __builtin_amdgcn_fence(__ATOMIC_RELEASE, "agent");
            asm volatile("s_waitcnt vmcnt(0)" ::: "memory");
            const unsigned og = xb_add(&bar[XB_TOP], 1u);
            const unsigned tg = og / nx;
            if (og + 1u == (tg + 1u) * nx) xb_add(&bar[XB_TOPGEN], 1u);
            else XB_SPIN(xb_ld(&bar[XB_TOPGEN]) == tg, bar);
            __builtin_amdgcn_fence(__ATOMIC_ACQUIRE, "agent");
            xb_add(&bar[XB_XGEN(b.x)], 1u);
            asm volatile("s_waitcnt vmcnt(0)" ::: "memory");
        } else {
            XB_SPIN(xb_ld(&bar[XB_XGEN(b.x)]) == gen, bar);
            __builtin_amdgcn_fence(__ATOMIC_ACQUIRE, "agent");
            asm volatile("s_waitcnt vmcnt(0)" ::: "memory");
        }
    }
    __syncthreads();
}

struct Args { const void* in[29]; float* out; unsigned char* ws; int ph_lo, ph_hi; };
struct Frame {
    LAS unsigned char* lds; char* ldsg; volatile LAS unsigned* MISC; gu32* ctl;
    int tid, lane, wave, G, gw, NGW;
};

__device__ __forceinline__ int dest_row(int mode, int n) {
    if (mode == 1) return ((n >> 7) << 8) + (n & 127);
    if (mode == 2) return ((n >> 7) << 8) + 128 + (n & 127);
    if (mode == 3) return n < 4096 ? n : (n < 4120 ? 4608 + (n - 4096) : 4096 + (n - 4120));
    if (mode == 4) { const int c = n & 127; return (n < 3072 && c < 32) ? (n & ~127) + 2 * (c & 15) + (c >> 4) : n; }
    return n;
}
struct CvItem { const float* W; bf16* WT; int K, N, mode, loc, fp8; };
__device__ __forceinline__ void cv_load(const CvItem& c, f32x4 (&v)[8], int lane) {
    const int nblk = (c.N + 31) >> 5, kb = c.loc / nblk, nb = c.loc - kb * nblk, k0 = 64 * kb, n0 = 32 * nb;
    const int col = n0 + (lane & 7) * 4; const int colc = col < c.N ? col : c.N - 4;
    const float* src = c.W + (size_t)(k0 + 8 * (lane >> 3)) * c.N + colc;
#pragma unroll
    for (int i = 0; i < 8; ++i) v[i] = __builtin_nontemporal_load((const f32x4*)(src + (size_t)i * c.N));
}
__device__ __forceinline__ void cv_store(const CvItem& c, const f32x4 (&v)[8], LAS float* scr, int lane) {
    const int nblk = (c.N + 31) >> 5, kb = c.loc / nblk, nb = c.loc - kb * nblk, k0 = 64 * kb, n0 = 32 * nb;
    if (c.fp8) {
        const float sc_ = __builtin_ldexpf(1.0f, c.fp8); const int dbl = c.mode ? 1 : 0, off = (c.mode >> 1) << 7;
        const int rowb = ((n0 >> 7) << (7 + dbl)) + off + (n0 & 127) + 4 * (lane & 7);
        unsigned char* pq = (unsigned char*)c.WT + (size_t)rowb * c.K + k0 + 8 * (lane >> 3);
#pragma unroll
        for (int cc = 0; cc < 4; ++cc) { int w0 = 0, w1 = 0;
            w0 = __builtin_amdgcn_cvt_pk_fp8_f32(v[0][cc] * sc_, v[1][cc] * sc_, w0, false); w0 = __builtin_amdgcn_cvt_pk_fp8_f32(v[2][cc] * sc_, v[3][cc] * sc_, w0, true);
            w1 = __builtin_amdgcn_cvt_pk_fp8_f32(v[4][cc] * sc_, v[5][cc] * sc_, w1, false); w1 = __builtin_amdgcn_cvt_pk_fp8_f32(v[6][cc] * sc_, v[7][cc] * sc_, w1, true);
            *(v2u*)(pq + (size_t)cc * c.K) = (v2u){(unsigned)w0, (unsigned)w1}; }
        return; }
#pragma unroll
    for (int cc = 0; cc < 4; ++cc) { const int n = n0 + 4 * (lane & 7) + cc;
        v4u o; o.x = pk2(v[0][cc], v[1][cc]); o.y = pk2(v[2][cc], v[3][cc]); o.z = pk2(v[4][cc], v[5][cc]); o.w = pk2(v[6][cc], v[7][cc]);
        if (n < c.N) __builtin_nontemporal_store(o, (v4u*)(c.WT + (size_t)dest_row(c.mode, n) * c.K + k0 + 8 * (lane >> 3))); }
}
constexpr int CV_I_MKV = 32 * 32, CV_I_IN0 = 32 * 160, CV_I_O = 32 * 64, CV_I_GU = 32 * 224, CV_I_D = 112 * 64, CV_I_IN1 = 32 * 145;
constexpr int CV_B1 = CV_I_MKV, CV_B2 = CV_B1 + CV_I_IN0, CV_B3 = CV_B2 + CV_I_O, CV_B4 = CV_B3 + CV_I_GU, CV_B5 = CV_B4 + CV_I_GU, CV_B6 = CV_B5 + CV_I_D, CV_B7 = CV_B6 + CV_I_IN1, CV_B8 = CV_B7 + CV_I_O;
constexpr int CV_NITEMS = CV_B8 + 24 * 7168;
constexpr int CV_C1A = CV_B3 + 10 * 2048, CV_C1 = CV_C1A + 20 * 1024, CV_C2 = CV_C1 + 25 * 2048, CV_C3 = CV_C2 + 10 * 2048, CV_C4 = CV_NITEMS - 8 * 7168, CV_C4A = CV_C4 - 20 * 1280;
static_assert(CV_C1 >= CV_B8 && CV_C4A >= CV_C3 && CV_C4 >= CV_B8 + 16 * 7168, "dense weights are converted before the FFN phase, expert gate/up weights before the expert phase");
__device__ __forceinline__ CvItem cv_decode(const Args& A, int it) {
    unsigned char* ws = A.ws; CvItem c; c.fp8 = 0;
    constexpr int B1 = CV_B1, B2 = CV_B2, B3 = CV_B3, B4 = CV_B4, B5 = CV_B5, B6 = CV_B6, B7 = CV_B7, B8 = CV_B8;
    if (it < B1)      { c.W = (const float*)A.in[3];  c.K = DM; c.N = 1024; c.WT = (bf16*)(ws + WS_WMKV); c.mode = 0; c.loc = it; }
    else if (it < B2) { c.W = (const float*)A.in[4];  c.K = DM; c.N = N_IN0; c.WT = (bf16*)(ws + WS_WIN0); c.mode = 4; c.loc = it - B1; }
    else if (it < B3) { c.W = (const float*)A.in[5];  c.K = DM; c.N = DM; c.WT = (bf16*)(ws + WS_WO0); c.mode = 0; c.loc = it - B2; }
    else if (it < B4) { c.W = (const float*)A.in[8];  c.K = DM; c.N = DFF; c.WT = (bf16*)(ws + WS_WGU0); c.mode = 1; c.loc = it - B3; c.fp8 = 6; }
    else if (it < B5) { c.W = (const float*)A.in[9];  c.K = DM; c.N = DFF; c.WT = (bf16*)(ws + WS_WGU0); c.mode = 2; c.loc = it - B4; c.fp8 = 6; }
    else if (it < B6) { c.W = (const float*)A.in[10]; c.K = DFF; c.N = DM; c.WT = (bf16*)(ws + WS_WD0); c.mode = 0; c.loc = it - B5; c.fp8 = 7; }
    else if (it < B7) { c.W = (const float*)A.in[13]; c.K = DM; c.N = N_IN1_REAL; c.WT = (bf16*)(ws + WS_WIN1); c.mode = 3; c.loc = it - B6; }
    else if (it < B8) { c.W = (const float*)A.in[20]; c.K = DM; c.N = DM; c.WT = (bf16*)(ws + WS_WO1); c.mode = 0; c.loc = it - B7; }
    else { const int r = it - B8, r2 = r / 7168, kind = r2 >> 3, e = r2 & 7; c.loc = r - r2 * 7168;
        if (kind == 0)      { c.W = (const float*)A.in[24] + (size_t)e * DM * DFF; c.K = DM; c.N = DFF; c.WT = (bf16*)(ws + WS_WGUE + (size_t)e * 2 * DFF * DM); c.mode = 1; c.fp8 = 6; }
        else if (kind == 1) { c.W = (const float*)A.in[25] + (size_t)e * DM * DFF; c.K = DM; c.N = DFF; c.WT = (bf16*)(ws + WS_WGUE + (size_t)e * 2 * DFF * DM); c.mode = 2; c.fp8 = 6; }
        else                { c.W = (const float*)A.in[26] + (size_t)e * DFF * DM; c.K = DFF; c.N = DM; c.WT = (bf16*)(ws + WS_WDE + (size_t)e * DM * DFF); c.mode = 0; c.fp8 = 7; } }
    return c;
}
__device__ __forceinline__ void convert_items(Frame& F, const Args& A, int lo_, int hi_, int gwl, int ngwl) {
    LAS float* scr = (LAS float*)(F.lds + RING_OFF + F.wave * 16384);
    int it = lo_ + gwl; if (it >= hi_) return;
    f32x4 va[8], vb[8], vc[8], vd[8];
#define CV_LD(buf, idx) do { if ((idx) < hi_) { const CvItem c_ = cv_decode(A, (idx)); cv_load(c_, buf, F.lane); } } while (0)
#define CV_ST(buf, idx) do { const CvItem c_ = cv_decode(A, (idx)); cv_store(c_, buf, scr, F.lane); } while (0)
    CV_LD(va, it); CV_LD(vb, it + ngwl); CV_LD(vc, it + 2 * ngwl); CV_LD(vd, it + 3 * ngwl);
    for (;;) {
        CV_ST(va, it); CV_LD(va, it + 4 * ngwl); if (it + ngwl >= hi_) break;
        CV_ST(vb, it + ngwl); CV_LD(vb, it + 5 * ngwl); if (it + 2 * ngwl >= hi_) break;
        CV_ST(vc, it + 2 * ngwl); CV_LD(vc, it + 6 * ngwl); if (it + 3 * ngwl >= hi_) break;
        CV_ST(vd, it + 3 * ngwl); CV_LD(vd, it + 7 * ngwl); if (it + 4 * ngwl >= hi_) break;
        it += 4 * ngwl;
    }
#undef CV_LD
#undef CV_ST
}
__device__ __forceinline__ void p0_prologue(Frame& F, const Args& A) {
    unsigned char* ws = A.ws;
    convert_items(F, A, 0, CV_B3, F.gw, F.NGW);
    const int gid = blockIdx.x * 512 + F.tid, NT_ = F.G * 512;
    { const float* x = (const float*)A.in[0]; const float* mem = (const float*)A.in[1]; bf16* xb = (bf16*)(ws + WS_XCURB); bf16* mb = (bf16*)(ws + WS_MEMB);
      constexpr int NX8 = T * DM / 8, NM8 = MEML * DM / 8;
      for (int i0 = gid; i0 < NX8 + NM8; i0 += 4 * NT_) { f32x4 a[4], b[4];
#pragma unroll
          for (int q = 0; q < 4; ++q) { const int i = i0 + q * NT_; const int ic = i < NX8 + NM8 ? i : i0; const bool ix = ic < NX8; const int j = ix ? ic : ic - NX8; const float* s = (ix ? x : mem) + (size_t)j * 8;
              a[q] = __builtin_nontemporal_load((const f32x4*)s); b[q] = __builtin_nontemporal_load((const f32x4*)(s + 4)); }
#pragma unroll
          for (int q = 0; q < 4; ++q) { const int i = i0 + q * NT_; if (i < NX8 + NM8) { const bool ix = i < NX8; const int j = ix ? i : i - NX8;
              v4u o = {pk2(a[q][0], a[q][1]), pk2(a[q][2], a[q][3]), pk2(b[q][0], b[q][1]), pk2(b[q][2], b[q][3])};
              *(v4u*)((ix ? xb : mb) + (size_t)j * 8) = o; } } } }
    { v4u z = {0u, 0u, 0u, 0u}; v4u* p = (v4u*)((bf16*)(ws + WS_WIN1) + (size_t)N_IN1_REAL * DM); constexpr int NZ = (N_IN1 - N_IN1_REAL) * DM / 8;
      for (int i = gid; i < NZ; i += NT_) p[i] = z; }
    { const int* pos = (const int*)A.in[2]; float* rope = (float*)(ws + WS_ROPE);
      for (int i = gid; i < T * 16; i += NT_) { const int t = i >> 4, j = i & 15;
          const float inv = (float)exp(-((double)j / 16.0) * 13.122363377404328);
          const float ang = (float)pos[t] * inv;
          double rev = (double)ang * 0.15915494309189535; rev -= floor(rev);
          const double x = rev * 6.283185307179586; const double q = rint(x * 0.6366197723675814); const double y = x - q * 1.5707963267948966; const double y2 = y * y;
          const double sn = y * (1.0 + y2 * (-1.0 / 6 + y2 * (1.0 / 120 + y2 * (-1.0 / 5040 + y2 * (1.0 / 362880 + y2 * (-1.0 / 39916800 + y2 * (1.0 / 6227020800.0)))))));
          const double cs = 1.0 + y2 * (-0.5 + y2 * (1.0 / 24 + y2 * (-1.0 / 720 + y2 * (1.0 / 40320 + y2 * (-1.0 / 3628800 + y2 * (1.0 / 479001600.0))))));
          const int qi = ((int)q) & 3; double s, c;
          if (qi == 0) { s = sn; c = cs; } else if (qi == 1) { s = cs; c = -sn; } else if (qi == 2) { s = -sn; c = -cs; } else { s = -cs; c = sn; }
          rope[2 * i] = (float)c; rope[2 * i + 1] = (float)s; } }
}

__device__ __forceinline__ void rot8(v4u& a, v4u& b, const float* __restrict__ cs) {
    unsigned ao[4], bo[4]; const unsigned aw[4] = {a.x, a.y, a.z, a.w}, bw[4] = {b.x, b.y, b.z, b.w};
#pragma unroll
    for (int q = 0; q < 4; ++q) { const f32x4 t = *(const f32x4*)(cs + 4 * q);
        const float x1a = bflo(aw[q]), x1b = bfhi(aw[q]), x2a = bflo(bw[q]), x2b = bfhi(bw[q]);
        ao[q] = pk2(x1a * t[0] - x2a * t[1], x1b * t[2] - x2b * t[3]); bo[q] = pk2(x2a * t[0] + x1a * t[1], x2b * t[2] + x1b * t[3]); }
    a = (v4u){ao[0], ao[1], ao[2], ao[3]}; b = (v4u){bo[0], bo[1], bo[2], bo[3]};
}
__device__ __forceinline__ void p2_rotary_kmean(Frame& F, unsigned char* ws) {
    bf16* QKVM = (bf16*)(ws + WS_RB); const float* rope = (const float*)(ws + WS_ROPE); float* KMEAN = (float*)(ws + WS_KMEAN);
    { const int gid = blockIdx.x * 512 + F.tid, NT_ = F.G * 512;
      for (int i = gid; i < T * 24; i += NT_) { const int t = i / 24, r = i - t * 24, h = r >> 1, c = r & 1;
          bf16* p = QKVM + (size_t)t * N_IN0 + h * 128 + 8 * c; v4u a = *(v4u*)p, b = *(v4u*)(p + 16);
          rot8(a, b, rope + ((size_t)t * 16 + 8 * c) * 2); *(v4u*)p = a; *(v4u*)(p + 16) = b; } }
    LAS float* red = (LAS float*)(F.lds);
    for (int it = blockIdx.x; it < 32 * 12; it += F.G) { const int b = it / 12, h = it - b * 12;
        const int rgp = F.tid >> 4, c = F.tid & 15;
        float s[16];
#pragma unroll
        for (int q = 0; q < 16; ++q) s[q] = 0.f;
        if (c < 2 || c >= 4) {
            v4u ra[8], rb[8];
#pragma unroll
            for (int rr = 0; rr < 8; ++rr) { const int t = 256 * b + rgp * 8 + rr; const bf16* p = QKVM + (size_t)t * N_IN0 + 1536 + h * 128 + 8 * c; ra[rr] = *(const v4u*)p; rb[rr] = *(const v4u*)(p + (c < 2 ? 16 : 0)); }
#pragma unroll
            for (int rr = 0; rr < 8; ++rr) { const int t = 256 * b + rgp * 8 + rr; bf16* p = QKVM + (size_t)t * N_IN0 + 1536 + h * 128 + 8 * c;
                v4u a = ra[rr];
                if (c < 2) { v4u bq = rb[rr]; rot8(a, bq, rope + ((size_t)t * 16 + 8 * c) * 2); *(v4u*)p = a; *(v4u*)(p + 16) = bq;
                    s[8] += bflo(bq.x); s[9] += bfhi(bq.x); s[10] += bflo(bq.y); s[11] += bfhi(bq.y); s[12] += bflo(bq.z); s[13] += bfhi(bq.z); s[14] += bflo(bq.w); s[15] += bfhi(bq.w); }
                s[0] += bflo(a.x); s[1] += bfhi(a.x); s[2] += bflo(a.y); s[3] += bfhi(a.y); s[4] += bflo(a.z); s[5] += bfhi(a.z); s[6] += bflo(a.w); s[7] += bfhi(a.w); }
        }
        __syncthreads();
        if (c < 2 || c >= 4) {
#pragma unroll
            for (int q = 0; q < 8; ++q) red[rgp * 128 + 8 * c + q] = s[q];
            if (c < 2) {
#pragma unroll
                for (int q = 0; q < 8; ++q) red[rgp * 128 + 16 + 8 * c + q] = s[8 + q]; }
        }
        __syncthreads();
        if (F.tid < 128) { float a = 0.f;
#pragma unroll
            for (int g = 0; g < 32; ++g) a += red[g * 128 + F.tid];
            KMEAN[(size_t)(h * 32 + b) * 128 + F.tid] = a * (1.0f / 256.0f); }
    }
    __syncthreads();
}

template <bool ROUTER, bool RES_F32, bool X8 = false>
__device__ __forceinline__ void ln_rows(Frame& F, const void* res, const bf16* __restrict__ y, const float* __restrict__ gam, const float* __restrict__ bet,
                                        bf16* outb, const float* __restrict__ wr, int* __restrict__ toke, float* __restrict__ tokw, unsigned char* out8 = nullptr) {
    if (ROUTER) {
        LAS float* wt = (LAS float*)(F.lds);
        f32x4 w8[8];
#pragma unroll
        for (int q = 0; q < 8; ++q) w8[q] = *(const f32x4*)(wr + (size_t)(F.tid + q * 512) * 4);
#pragma unroll
        for (int q = 0; q < 8; ++q) { const int i = F.tid + q * 512; const int d = i >> 1, hf = i & 1;
            wt[(4 * hf + 0) * 2048 + d] = w8[q][0]; wt[(4 * hf + 1) * 2048 + d] = w8[q][1]; wt[(4 * hf + 2) * 2048 + d] = w8[q][2]; wt[(4 * hf + 3) * 2048 + d] = w8[q][3]; }
        __syncthreads();
    }
    f32x4 nx[8]; v2u nxb[8], ny[8];
#define LN_LOAD(row) do { _Pragma("unroll") for (int j = 0; j < 8; ++j) { \
        if (RES_F32) nx[j] = ((const f32x4*)((const float*)res + (size_t)(row) * DM) + F.lane)[64 * j]; else nxb[j] = ((const v2u*)((const bf16*)res + (size_t)(row) * DM) + F.lane)[64 * j]; \
        ny[j] = ((const v2u*)(y + (size_t)(row) * DM) + F.lane)[64 * j]; } } while (0)
    if (F.gw < T) LN_LOAD(F.gw);
    for (int m = F.gw; m < T; m += F.NGW) {
        f32x4 v[8]; float s = 0.f;
#pragma unroll
        for (int j = 0; j < 8; ++j) { const f32x4 xr = RES_F32 ? nx[j] : (f32x4){bflo(nxb[j].x), bfhi(nxb[j].x), bflo(nxb[j].y), bfhi(nxb[j].y)};
            const f32x4 yr = {bflo(ny[j].x), bfhi(ny[j].x), bflo(ny[j].y), bfhi(ny[j].y)};
            v[j] = xr * DN_ALPHA + yr; s += (v[j][0] + v[j][1]) + (v[j][2] + v[j][3]); }
        if (m + F.NGW < T) LN_LOAD(m + F.NGW);
        const float mean = wave_sum(s) * (1.f / DM); float s2 = 0.f;
#pragma unroll
        for (int j = 0; j < 8; ++j) { v[j] = v[j] - mean; s2 += (v[j][0] * v[j][0] + v[j][1] * v[j][1]) + (v[j][2] * v[j][2] + v[j][3] * v[j][3]); }
        const float rstd = 1.f / sqrtf(wave_sum(s2) * (1.f / DM) + LN_EPS);
        v2u* ob = (v2u*)(outb + (size_t)m * DM) + F.lane;
#pragma unroll
        for (int j = 0; j < 8; ++j) { const f32x4 g4 = ((const f32x4*)gam)[F.lane + 64 * j], b4 = ((const f32x4*)bet)[F.lane + 64 * j];
            v[j] = v[j] * rstd * g4 + b4;
            ob[64 * j] = (v2u){pk2(v[j][0], v[j][1]), pk2(v[j][2], v[j][3])};
            if (X8) { int w8_ = 0; w8_ = __builtin_amdgcn_cvt_pk_fp8_f32(v[j][0], v[j][1], w8_, false); w8_ = __builtin_amdgcn_cvt_pk_fp8_f32(v[j][2], v[j][3], w8_, true);
                ((unsigned*)(out8 + (size_t)m * DM))[F.lane + 64 * j] = (unsigned)w8_; } }
        if (ROUTER) {
            float lg[8];
#pragma unroll
            for (int e = 0; e < 8; ++e) lg[e] = 0.f;
            const LAS f32x4* wl = (const LAS f32x4*)(F.lds) + F.lane;
#pragma unroll
            for (int j = 0; j < 8; ++j)
#pragma unroll
                for (int e = 0; e < 8; ++e) { const f32x4 w4 = wl[e * 512 + 64 * j]; lg[e] += (v[j][0] * w4[0] + v[j][1] * w4[1]) + (v[j][2] * w4[2] + v[j][3] * w4[3]); }
#pragma unroll
            for (int e = 0; e < 8; ++e) lg[e] = wave_sum(lg[e]);
            float b0 = lg[0]; int i0 = 0;
#pragma unroll
            for (int e = 1; e < 8; ++e) if (lg[e] > b0) { b0 = lg[e]; i0 = e; }
            float b1 = -__builtin_inff(); int i1 = 0;
#pragma unroll
            for (int e = 0; e < 8; ++e) if (e != i0 && lg[e] > b1) { b1 = lg[e]; i1 = e; }
            if (F.lane == 0) { const float e1 = __expf(b1 - b0); const float w0 = 1.f / (1.f + e1); toke[m] = i0 | (i1 << 8); tokw[2 * m] = w0; tokw[2 * m + 1] = e1 * w0; }
        }
    }
#undef LN_LOAD
}

__device__ __forceinline__ void p10_conv(Frame& F, const Args& A) {
    unsigned char* ws = A.ws; const bf16* H1 = (const bf16*)(ws + WS_RB); bf16* CV = (bf16*)(ws + WS_RC); const float* DTR = (const float*)(ws + WS_DTR); float* ACS = (float*)(ws + WS_ACS);
    const float* cw = (const float*)A.in[14]; const float* cb = (const float*)A.in[15]; const float* dtb = (const float*)A.in[16]; const float* alog = (const float*)A.in[17];
    const int gid = blockIdx.x * 512 + F.tid, NT_ = F.G * 512;
    for (int i = gid; i < (T / 16) * 320; i += NT_) { const int tb = i / 320, cg = i - tb * 320, ch0 = 8 * cg, t0 = 16 * tb;
        v4u xr[19];
#pragma unroll
        for (int r = 0; r < 19; ++r) { const int tt = t0 - 3 + r; const v4u ld_ = *(const v4u*)(H1 + (size_t)(tt < 0 ? 0 : tt) * N_IN1 + 1536 + ch0); xr[r] = (tt >= 0) ? ld_ : (v4u){0u, 0u, 0u, 0u}; }
        float w[4][8], bias[8];
#pragma unroll
        for (int k = 0; k < 4; ++k) { const f32x4 w0 = *(const f32x4*)(cw + k * 2560 + ch0), w1 = *(const f32x4*)(cw + k * 2560 + ch0 + 4);
            w[k][0] = w0[0]; w[k][1] = w0[1]; w[k][2] = w0[2]; w[k][3] = w0[3]; w[k][4] = w1[0]; w[k][5] = w1[1]; w[k][6] = w1[2]; w[k][7] = w1[3]; }
        { const f32x4 b0 = *(const f32x4*)(cb + ch0), b1 = *(const f32x4*)(cb + ch0 + 4);
          bias[0] = b0[0]; bias[1] = b0[1]; bias[2] = b0[2]; bias[3] = b0[3]; bias[4] = b1[0]; bias[5] = b1[1]; bias[6] = b1[2]; bias[7] = b1[3]; }
        const bool isx = ch0 < 1536; const int hd = isx ? (ch0 >> 6) : 0; const float dbias = dtb[hd];
        float dtr[16];
#pragma unroll
        for (int r = 0; r < 16; ++r) dtr[r] = DTR[(size_t)(t0 + r) * 32 + hd];
#pragma unroll
        for (int r = 0; r < 16; ++r) { float acc[8];
#pragma unroll
            for (int q = 0; q < 8; ++q) acc[q] = bias[q];
#pragma unroll
            for (int k = 0; k < 4; ++k) { const v4u xv = xr[r + k];
                acc[0] += w[k][0] * bflo(xv.x); acc[1] += w[k][1] * bfhi(xv.x); acc[2] += w[k][2] * bflo(xv.y); acc[3] += w[k][3] * bfhi(xv.y);
                acc[4] += w[k][4] * bflo(xv.z); acc[5] += w[k][5] * bfhi(xv.z); acc[6] += w[k][6] * bflo(xv.w); acc[7] += w[k][7] * bfhi(xv.w); }
#pragma unroll
            for (int q = 0; q < 8; ++q) acc[q] = silu_f(acc[q]);
            const size_t t = (size_t)(t0 + r);
            *(v4u*)(CV + t * 4096 + ch0) = (v4u){pk2(acc[0], acc[1]), pk2(acc[2], acc[3]), pk2(acc[4], acc[5]), pk2(acc[6], acc[7])};
            if (isx) { const float dt = softplus_f(dtr[r] + dbias);
                *(v4u*)(CV + t * 4096 + 2560 + ch0) = (v4u){pk2(acc[0] * dt, acc[1] * dt), pk2(acc[2] * dt, acc[3] * dt), pk2(acc[4] * dt, acc[5] * dt), pk2(acc[6] * dt, acc[7] * dt)}; }
        }
    }
    for (int it = F.gw; it < 32 * 24; it += F.NGW) { const int c = it / 24, h = it - c * 24; const float a = -__expf(alog[h]); const float bias = dtb[h];
        float v[4]; float run = 0.f;
#pragma unroll
        for (int q = 0; q < 4; ++q) { const int t = 256 * c + 4 * F.lane + q; run += softplus_f(DTR[(size_t)t * 32 + h] + bias) * a; v[q] = run; }
        float incl = run;
#pragma unroll
        for (int o = 1; o < 64; o <<= 1) { const float u = __shfl_up(incl, o); if (F.lane >= o) incl += u; }
        const float excl = incl - run;
        *(f32x4*)(ACS + (size_t)(c * 24 + h) * 256 + 4 * F.lane) = (f32x4){v[0] + excl, v[1] + excl, v[2] + excl, v[3] + excl};
    }
}

__device__ __forceinline__ void p12_scan(Frame& F, unsigned char* ws) {
    const float* __restrict__ STATES = (const float*)(ws + WS_STATES); bf16* __restrict__ PREV = (bf16*)(ws + WS_PREV); const float* __restrict__ ACS = (const float*)(ws + WS_ACS);
    const int gid = blockIdx.x * 512 + F.tid, NT_ = F.G * 512;
    for (int i = gid; i < 24 * 64 * 32; i += NT_) { const int h = i >> 11;
        f32x4 carry = {0.f, 0.f, 0.f, 0.f};
#pragma unroll 8
        for (int c = 0; c < 32; ++c) {
            *(v2u*)(PREV + ((size_t)c * 24 * 64 * 32 + i) * 4) = (v2u){pk2(carry[0], carry[1]), pk2(carry[2], carry[3])};
            const float dec = __expf(ACS[(size_t)(c * 24 + h) * 256 + 255]);
            const f32x4 st = *(const f32x4*)(STATES + ((size_t)c * 24 * 64 * 32 + i) * 4);
            carry = carry * dec + st; }
    }
}

__device__ __forceinline__ void p14_gated_norm(Frame& F, const Args& A) {
    unsigned char* ws = A.ws; const float* YS = (const float*)(ws + WS_YSSD); const bf16* H1 = (const bf16*)(ws + WS_RB); bf16* HEADS = (bf16*)(ws + WS_HEADS); const float* ng = (const float*)A.in[19];
    f32x4 ny[6]; v2u nz[6];
#define GN_LOAD(row) do { _Pragma("unroll") for (int j = 0; j < 6; ++j) { ny[j] = *((const f32x4*)(YS + (size_t)(row) * 1536) + F.lane + 64 * j); nz[j] = *((const v2u*)(H1 + (size_t)(row) * N_IN1) + F.lane + 64 * j); } } while (0)
    if (F.gw < T) GN_LOAD(F.gw);
    for (int m = F.gw; m < T; m += F.NGW) {
        f32x4 v[6]; float s2 = 0.f; f32x4 cy[6]; v2u cz[6];
#pragma unroll
        for (int j = 0; j < 6; ++j) { cy[j] = ny[j]; cz[j] = nz[j]; }
        if (m + F.NGW < T) GN_LOAD(m + F.NGW);
#pragma unroll
        for (int j = 0; j < 6; ++j) { const f32x4 yv = cy[j]; const v2u zz = cz[j];
            v[j] = (f32x4){yv[0] * silu_f(bflo(zz.x)), yv[1] * silu_f(bfhi(zz.x)), yv[2] * silu_f(bflo(zz.y)), yv[3] * silu_f(bfhi(zz.y))};
            s2 += (v[j][0] * v[j][0] + v[j][1] * v[j][1]) + (v[j][2] * v[j][2] + v[j][3] * v[j][3]); }
        const float rstd = 1.f / sqrtf(wave_sum(s2) * (1.f / 1536.f) + RMS_EPS);
#pragma unroll
        for (int j = 0; j < 6; ++j) { const f32x4 g4 = ((const f32x4*)ng)[F.lane + 64 * j]; const f32x4 o = v[j] * rstd * g4;
            *((v2u*)(HEADS + (size_t)m * DM) + F.lane + 64 * j) = (v2u){pk2(o[0], o[1]), pk2(o[2], o[3])}; }
    }
}

__device__ __forceinline__ void p17_sort_gather(Frame& F, unsigned char* ws) {
    const int* TOKE = (const int*)(ws + WS_TOKE); int* POS = (int*)(ws + WS_POS); int* COUNTS = (int*)(ws + WS_COUNTS);
    const bf16* XB = (const bf16*)(ws + WS_XCURB); bf16* XG = (bf16*)(ws + WS_RC);
    LAS unsigned long long* wtot = (LAS unsigned long long*)(F.lds);
    LAS int* posl = (LAS int*)(F.lds + 256);
    int te[16];
    { const int4* p = (const int4*)(TOKE + 16 * F.tid);
#pragma unroll
      for (int q = 0; q < 4; ++q) { const int4 v = p[q]; te[4 * q] = v.x; te[4 * q + 1] = v.y; te[4 * q + 2] = v.z; te[4 * q + 3] = v.w; } }
    unsigned long long ca = 0ull, cb = 0ull;
#pragma unroll
    for (int q = 0; q < 16; ++q) {
#pragma unroll
        for (int k = 0; k < 2; ++k) { const int e = (te[q] >> (8 * k)) & 0xff; const unsigned long long one = 1ull << (16 * (e & 3)); if (e < 4) ca += one; else cb += one; } }
    unsigned long long ia = ca, ib = cb;
#pragma unroll
    for (int o = 1; o < 64; o <<= 1) { const unsigned long long ua = __shfl_up(ia, o), ub = __shfl_up(ib, o); if (F.lane >= o) { ia += ua; ib += ub; } }
    if (F.lane == 63) { wtot[F.wave * 2] = ia; wtot[F.wave * 2 + 1] = ib; }
    __syncthreads();
    unsigned long long pa = 0ull, pb = 0ull, ta = 0ull, tb = 0ull;
#pragma unroll
    for (int w = 0; w < 8; ++w) { const unsigned long long xa = wtot[w * 2], xb = wtot[w * 2 + 1]; if (w < F.wave) { pa += xa; pb += xb; } ta += xa; tb += xb; }
    const unsigned long long ea = pa + ia - ca, eb = pb + ib - cb;
    int cnt[8], pst[8];
#pragma unroll
    for (int e = 0; e < 8; ++e) cnt[e] = (int)(((e < 4 ? ta : tb) >> (16 * (e & 3))) & 0xffffull);
    pst[0] = 0;
#pragma unroll
    for (int e = 1; e < 8; ++e) pst[e] = pst[e - 1] + ((cnt[e - 1] + 255) & ~255);
    if (blockIdx.x == 0 && F.tid < 8) { int c = 0;
#pragma unroll
        for (int e = 0; e < 8; ++e) c = (F.tid == e) ? cnt[e] : c;
        COUNTS[F.tid] = c; }
    const int b = blockIdx.x;
    for (int tb0 = b * 32; tb0 < T; tb0 += F.G * 32) {
        __syncthreads();
        if ((F.tid >> 1) == (tb0 >> 5)) {
            unsigned long long ra = ea, rb = eb;
#pragma unroll
            for (int q = 0; q < 16; ++q) {
#pragma unroll
                for (int k = 0; k < 2; ++k) { const int e = (te[q] >> (8 * k)) & 0xff; const int sh = 16 * (e & 3);
                    const int off = (int)(((e < 4 ? ra : rb) >> sh) & 0xffffull); int ps = 0;
#pragma unroll
                    for (int x = 0; x < 8; ++x) ps = (x == e) ? pst[x] : ps;
                    const int pos = ps + off; if (e < 4) ra += 1ull << sh; else rb += 1ull << sh;
                    const int tok = 16 * F.tid + q; POS[2 * tok + k] = pos; posl[(tok - tb0) * 2 + k] = pos; } }
        }
        __syncthreads();
        for (int i0 = F.tid; i0 < 64 * 256; i0 += 512 * 8) { v4u tmp[8];
#pragma unroll
            for (int q = 0; q < 8; ++q) { const int i = i0 + q * 512; const int r = i >> 8, ch = i & 255; tmp[q] = *((const v4u*)(XB + (size_t)(tb0 + (r >> 1)) * DM) + ch); }
#pragma unroll
            for (int q = 0; q < 8; ++q) { const int i = i0 + q * 512; const int r = i >> 8, ch = i & 255; const v4u t_ = tmp[q]; int w0 = 0, w1 = 0;
                w0 = __builtin_amdgcn_cvt_pk_fp8_f32(bflo(t_.x), bfhi(t_.x), w0, false); w0 = __builtin_amdgcn_cvt_pk_fp8_f32(bflo(t_.y), bfhi(t_.y), w0, true);
                w1 = __builtin_amdgcn_cvt_pk_fp8_f32(bflo(t_.z), bfhi(t_.z), w1, false); w1 = __builtin_amdgcn_cvt_pk_fp8_f32(bflo(t_.w), bfhi(t_.w), w1, true);
                *((v2u*)((unsigned char*)XG + (size_t)posl[r] * DM) + ch) = (v2u){(unsigned)w0, (unsigned)w1}; } }
    }
    __syncthreads();
}

__device__ __forceinline__ void p20_final(Frame& F, const Args& A) {
    unsigned char* ws = A.ws; const bf16* X = (const bf16*)(ws + WS_XCURB); const bf16* YM = (const bf16*)(ws + WS_RB); const int* POS = (const int*)(ws + WS_POS); const float* TOKW = (const float*)(ws + WS_TOKW);
    const float* gam = (const float*)A.in[27]; const float* bet = (const float*)A.in[28]; float* out = A.out;
    v2u nxa[8], nya[8], nyb[8]; float nw0 = 0.f, nw1 = 0.f;
#define FN_LOAD(row) do { const int p0_ = POS[2 * (row)], p1_ = POS[2 * (row) + 1]; nw0 = TOKW[2 * (row)]; nw1 = TOKW[2 * (row) + 1]; \
        const v2u* xr_ = (const v2u*)(X + (size_t)(row) * DM) + F.lane; const v2u* y0_ = (const v2u*)(YM + (size_t)p0_ * DM) + F.lane; const v2u* y1_ = (const v2u*)(YM + (size_t)p1_ * DM) + F.lane; \
        _Pragma("unroll") for (int j = 0; j < 8; ++j) { nxa[j] = xr_[64 * j]; nya[j] = y0_[64 * j]; nyb[j] = y1_[64 * j]; } } while (0)
    if (F.gw < T) FN_LOAD(F.gw);
    for (int m = F.gw; m < T; m += F.NGW) {
        const float w0 = nw0, w1 = nw1;
        v2u xa[8], ya[8], yb[8];
#pragma unroll
        for (int j = 0; j < 8; ++j) { xa[j] = nxa[j]; ya[j] = nya[j]; yb[j] = nyb[j]; }
        if (m + F.NGW < T) FN_LOAD(m + F.NGW);
        f32x4 v[8]; float s = 0.f;
#pragma unroll
        for (int j = 0; j < 8; ++j) { const f32x4 xv = {bflo(xa[j].x), bfhi(xa[j].x), bflo(xa[j].y), bfhi(xa[j].y)}, a = {bflo(ya[j].x), bfhi(ya[j].x), bflo(ya[j].y), bfhi(ya[j].y)}, b = {bflo(yb[j].x), bfhi(yb[j].x), bflo(yb[j].y), bfhi(yb[j].y)};
            v[j] = xv * DN_ALPHA + (a * w0 + b * w1); s += (v[j][0] + v[j][1]) + (v[j][2] + v[j][3]); }
        const float mean = wave_sum(s) * (1.f / DM); float s2 = 0.f;
#pragma unroll
        for (int j = 0; j < 8; ++j) { v[j] = v[j] - mean; s2 += (v[j][0] * v[j][0] + v[j][1] * v[j][1]) + (v[j][2] * v[j][2] + v[j][3] * v[j][3]); }
        const float rstd = 1.f / sqrtf(wave_sum(s2) * (1.f / DM) + LN_EPS);
        f32x4* of = (f32x4*)(out + (size_t)m * DM) + F.lane;
#pragma unroll
        for (int j = 0; j < 8; ++j) { const f32x4 g4 = ((const f32x4*)gam)[F.lane + 64 * j], b4 = ((const f32x4*)bet)[F.lane + 64 * j]; of[64 * j] = v[j] * rstd * g4 + b4; }
    }
}
__global__ void __launch_bounds__(NWAVES * 64, 2) mega_fwd(Args args) {
    extern __shared__ __attribute__((aligned(16))) unsigned char lds[];
    Frame F;
    F.lds = (LAS unsigned char*)lds; F.ldsg = (char*)lds;
    F.MISC = (volatile LAS unsigned*)(F.lds + MISC_OFF);
    F.tid = threadIdx.x; F.lane = F.tid & 63; F.wave = __builtin_amdgcn_readfirstlane(F.tid >> 6); const int wid_s = F.wave;
#define FRESH_TID(var) int var = fresh_tid()
    F.G = gridDim.x; F.gw = blockIdx.x * NWAVES + F.wave; F.NGW = F.G * NWAVES;
    unsigned char* ws = args.ws;
    F.ctl = (gu32*)(ws + WS_CTL);
    for (int u = F.tid; u < (LDS_BYTES - LDSCTL_OFF) / 4; u += NWAVES * 64) ((LAS unsigned*)(F.lds + LDSCTL_OFF))[u] = 0u;
    __syncthreads();
    if (F.lane == 0) ((LAS int*)(F.lds + WTAB_OFF))[(unsigned)__builtin_amdgcn_s_getreg((5 << 11) | 4) & 63u] = wid_s;
    __syncthreads();
#if MK_PER_PHASE
#define GRID_BAR() do { } while (0)
#else
    XcdBarrier bar = xcd_barrier_post((unsigned*)(F.ctl + CW_BAR), F.MISC + 8, wid_s);
#define GRID_BAR() xcd_barrier(bar)
#endif
#ifndef PROBE_PHASE
#define PROBE_PHASE -1
#endif
#ifndef PROBE_REPS
#define PROBE_REPS 2
#endif
#define REPS(k) (((k) == PROBE_PHASE) ? PROBE_REPS : 1)
#define HOSTED_GEMM(EPI, RW, CLO, CMID, CHI, WLO) HOSTED_GEMM_O(EPI, pg8::StaticOrder, RW, CLO, CMID, CHI, WLO)
#define HOSTED_GEMM_O(EPI, ORD, RW, CLO, CMID, CHI, WLO) do { const int rw_ = (RW); \
        pg8::RangeOrder<ORD> R1_{S, 0, rw_}, R2_{S, rw_, 1 << 20}; \
        pg8::gemm_phase<EPI, pg8::RangeOrder<ORD>, true, true>(F.lds + RING_OFF, g, R1_, E); \
        { FRESH_TID(tx_); F.tid = tx_; F.lane = tx_ & 63; F.wave = wid_s; F.gw = blockIdx.x * NWAVES + F.wave; } \
        __syncthreads(); convert_items(F, args, (CLO), (CMID), F.gw, F.NGW); \
        if ((int)blockIdx.x >= (WLO)) convert_items(F, args, (CMID), (CHI), F.gw - (WLO) * NWAVES, F.NGW - (WLO) * NWAVES); \
        __syncthreads(); \
        pg8::gemm_phase<EPI, pg8::RangeOrder<ORD>, true, true>(F.lds + RING_OFF, g, R2_, E); } while (0)
#define HOSTED_GEMM8(EPI, SC, RW, CLO, CMID, CHI, WLO) HOSTED_GEMM8_O(EPI, pg8::StaticOrder, SC, RW, CLO, CMID, CHI, WLO)
#define HOSTED_GEMM8_O(EPI, ORD, SC, RW, CLO, CMID, CHI, WLO) do { const int rw_ = (RW);     \
        pg8::RangeOrder<ORD> R1_{S, 0, rw_}, R2_{S, rw_, 1 << 20}; \
        { FRESH_TID(t8_); pg8::gemm_phase<EPI, pg8::RangeOrder<ORD>, true, true, SC>(F.lds + RING_OFF, g, R1_, E, t8_); } \
        { FRESH_TID(tx_); F.tid = tx_; F.lane = tx_ & 63; F.wave = wid_s; F.gw = blockIdx.x * NWAVES + F.wave; } \
        __syncthreads(); convert_items(F, args, (CLO), (CMID), F.gw, F.NGW); \
        if ((int)blockIdx.x >= (WLO)) convert_items(F, args, (CMID), (CHI), F.gw - (WLO) * NWAVES, F.NGW - (WLO) * NWAVES); \
        __syncthreads(); \
        { FRESH_TID(t8_); pg8::gemm_phase<EPI, pg8::RangeOrder<ORD>, true, true, SC>(F.lds + RING_OFF, g, R2_, E, t8_); } \
        { FRESH_TID(tx_); F.tid = tx_; F.lane = tx_ & 63; F.wave = wid_s; F.gw = blockIdx.x * NWAVES + F.wave; } } while (0)
    const int lo = args.ph_lo, hi = args.ph_hi;
#define IN(k) (lo <= (k) && (k) < hi)
#define REFRAME() { FRESH_TID(tx_); F.tid = tx_; F.lane = tx_ & 63; F.wave = wid_s; F.gw = blockIdx.x * NWAVES + F.wave; }
#define SEAM(k) do { if (IN(k) && IN((k) + 1)) GRID_BAR(); REFRAME(); } while (0)
    bf16* const XCURB = (bf16*)(ws + WS_XCURB); bf16* const YB = (bf16*)(ws + WS_YF); bf16* const HEADS = (bf16*)(ws + WS_HEADS); float* const YF = (float*)(ws + WS_YF);
    bf16* const QKVM = (bf16*)(ws + WS_RB); bf16* const H1 = (bf16*)(ws + WS_RB); bf16* const MEMKV = (bf16*)(ws + WS_MEMKV);

    if (IN(0)) for (int rep_ = 0; rep_ < REPS(0); ++rep_) { if (rep_) GRID_BAR(); p0_prologue(F, args); } SEAM(0);

    if (IN(1)) {
        { pg8::Gemm g{XCURB, (const bf16*)(ws + WS_WIN0), T, N_IN0, DM, DM}; pg8::StaticOrder S; S.init(T, N_IN0, F.G, (int)blockIdx.x);
          pg8::EpiQKV E{QKVM, N_IN0, (const float*)(ws + WS_ROPE), (float*)(ws + WS_KMEAN)};
          HOSTED_GEMM(pg8::EpiQKV, (int)(blockIdx.x % 3), CV_B3, CV_C1A, CV_C1, 128); }
        { pg8::Gemm g{(const bf16*)(ws + WS_MEMB), (const bf16*)(ws + WS_WMKV), MEML, 1024, DM, DM}; pg8::StaticOrder S; S.init(MEML, 1024, F.G, (int)((blockIdx.x + 4) % F.G));
          pg8::EpiBf16<0> E{MEMKV, 1024, nullptr, 0, 0, 1.f};
          pg8::gemm_phase<pg8::EpiBf16<0>, pg8::StaticOrder, true, true>(F.lds + RING_OFF, g, S, E); }
    } SEAM(1);


    if (IN(3)) {
        const float* KMEAN = (const float*)(ws + WS_KMEAN);
        for (int u = blockIdx.x; u < 384; u += F.G) { const int b = u / 12, h = u % 12;
            att::moba_gate_unit(QKVM + (size_t)(256 * b) * N_IN0 + h * 128, KMEAN + (size_t)h * 32 * 256, b, h, (unsigned*)(ws + WS_ROWMASK), (unsigned char*)(ws + WS_SEG), (int*)(ws + WS_CNT), F.ldsg); }
    } SEAM(3);

    if (IN(4)) {
        const unsigned* ROWMASK = (const unsigned*)(ws + WS_ROWMASK); const unsigned char* SEG = (const unsigned char*)(ws + WS_SEG); const int* CNT = (const int*)(ws + WS_CNT);
        bf16* PARTO = (bf16*)(ws + WS_RA); float* PARTML = (float*)(ws + WS_RA + 128 * MiB);
        char* scr = F.ldsg + 132096;
        LAS int* ipre = (LAS int*)(F.lds + 135168);
        int* segp = (int*)(F.ldsg + 137216);
        { int ng = 0;
          if (F.tid < 384) { const int j = F.tid & 31; int tot = 0; const int4* cp = (const int4*)(CNT + F.tid * 32); int4 cv[8];
#pragma unroll
              for (int q = 0; q < 8; ++q) cv[q] = cp[q];
#pragma unroll
              for (int q = 0; q < 8; ++q) { tot += (4 * q + 0 > j ? cv[q].x : 0) + (4 * q + 1 > j ? cv[q].y : 0) + (4 * q + 2 > j ? cv[q].z : 0) + (4 * q + 3 > j ? cv[q].w : 0); }
              ng = (256 + tot + 511) >> 9; }
          int incl = ng;
#pragma unroll
          for (int o = 1; o < 64; o <<= 1) { const int v = __shfl_up(incl, o); if (F.lane >= o) incl += v; }
          if (F.lane == 63) ipre[400 + F.wave] = incl;
          __syncthreads();
          int wbase = 0;
#pragma unroll
          for (int w = 0; w < 8; ++w) wbase += (w < F.wave) ? ipre[400 + w] : 0;
          if (F.tid < 384) ipre[F.tid + 1] = wbase + incl;
          if (F.tid == 0) ipre[0] = 0;
          __syncthreads(); }
        const int NIG = ipre[384];
#pragma nounroll
        for (int it = blockIdx.x; it < NIG; it += F.G) {
            int lo_ = 0, hi_ = 384;
            while (hi_ - lo_ > 1) { const int mid = (lo_ + hi_) >> 1; if (ipre[mid] <= it) lo_ = mid; else hi_ = mid; }
            const int hj = lo_, h = hj >> 5, j = hj & 31, chunk = it - ipre[hj];
            __syncthreads();
            if (F.tid < 64) { const int b = F.tid; const int c = (b > j && b < 32) ? CNT[hj * 32 + b] : 0; int incl = c;
#pragma unroll
                for (int o = 1; o < 64; o <<= 1) { const int v = __shfl_up(incl, o); if (F.lane >= o) incl += v; }
                if (b < 33) segp[b] = incl - c; }
            __syncthreads();
            const int R = 256 + segp[32]; const int row0 = chunk * 512; const int rowend = (row0 + 512 < R) ? row0 + 512 : R;
            att::moba_kv_item(QKVM, h, j, row0, rowend, segp, ROWMASK, SEG, PARTO, PARTML, F.ldsg, scr);
        }
#pragma nounroll
        for (int m = blockIdx.x; m < 128; m += F.G) { const int mh = m & 3, qb = m >> 2;
            att::attn_unit<false, N_IN0, 1024, DM>(QKVM + (size_t)(256 * qb) * N_IN0 + 4608 + mh * 128, MEMKV + mh * 128, MEMKV + 512 + mh * 128, HEADS + (size_t)(256 * qb) * DM + 1536 + mh * 128,
                                                   4, 0, nullptr, F.ldsg); }
    } SEAM(4);

    if (IN(5)) {
        const unsigned* ROWMASK = (const unsigned*)(ws + WS_ROWMASK); const bf16* PARTO = (const bf16*)(ws + WS_RA); const float* PARTML = (const float*)(ws + WS_RA + 128 * MiB);
        constexpr float C = 0.088388347648318440f * 1.4426950408889634f;
        const int gid = blockIdx.x * 512 + F.tid, NT_ = F.G * 512;
        for (int i = gid; i < T * 12 * 16; i += NT_) { const int th = i >> 4, c = i & 15; const int t = th / 12, h = th - t * 12;
            const unsigned rmask = ROWMASK[th];
            const float2* ml = (const float2*)PARTML + (size_t)th * 4; const v4u* po = (const v4u*)(PARTO + (size_t)th * 512) + c;
            float2 ms[4]; v4u pv[4];
#pragma unroll
            for (int s = 0; s < 4; ++s) { ms[s] = ml[s]; pv[s] = po[s * 16]; }
            const int cnt = __popc(rmask);
            float M = ms[3].x;
#pragma unroll
            for (int s = 0; s < 3; ++s) M = (s < cnt) ? fmaxf(M, ms[s].x) : M;
            float den = 0.f; float acc[8];
#pragma unroll
            for (int q = 0; q < 8; ++q) acc[q] = 0.f;
#pragma unroll
            for (int s = 0; s < 4; ++s) { const bool use = (s == 3) || (s < cnt); const float w = use ? ms[s].y * __builtin_amdgcn_exp2f((ms[s].x - M) * C) : 0.f; den += w; const v4u v = pv[s];
                acc[0] += use ? bflo(v.x) * w : 0.f; acc[1] += use ? bfhi(v.x) * w : 0.f; acc[2] += use ? bflo(v.y) * w : 0.f; acc[3] += use ? bfhi(v.y) * w : 0.f;
                acc[4] += use ? bflo(v.z) * w : 0.f; acc[5] += use ? bfhi(v.z) * w : 0.f; acc[6] += use ? bflo(v.w) * w : 0.f; acc[7] += use ? bfhi(v.w) * w : 0.f; }
            const float rd = 1.0f / den;
            *((v4u*)(HEADS + (size_t)t * DM + h * 128) + c) = (v4u){pk2(acc[0] * rd, acc[1] * rd), pk2(acc[2] * rd, acc[3] * rd), pk2(acc[4] * rd, acc[5] * rd), pk2(acc[6] * rd, acc[7] * rd)}; }
    } SEAM(5);

    if (IN(6)) for (int rep_ = 0; rep_ < REPS(6); ++rep_) { if (rep_) GRID_BAR(); pg8::Gemm g{HEADS, (const bf16*)(ws + WS_WO0), T, DM, DM, DM}; pg8::StaticOrder S; S.init(T, DM, F.G, (int)blockIdx.x);
        pg8::EpiBf16<0> E{YB, DM, nullptr, 0, 0, 1.f};
        pg8::gemm_phase<pg8::EpiBf16<0>, pg8::StaticOrder, true, true>(F.lds + RING_OFF, g, S, E); } SEAM(6);

    if (IN(7)) { ln_rows<false, true, true>(F, args.in[0], YB, (const float*)args.in[6], (const float*)args.in[7], XCURB, nullptr, nullptr, nullptr, ws + WS_XCUR); } SEAM(7);

    { FRESH_TID(tx_); F.tid = tx_; F.lane = tx_ & 63; F.wave = wid_s; F.gw = blockIdx.x * NWAVES + F.wave; }
    if (IN(8)) for (int rep_ = 0; rep_ < REPS(8); ++rep_) { if (rep_) GRID_BAR(); pg8::Gemm g{(const bf16*)(ws + WS_XCUR), (const bf16*)(ws + WS_WGU0), T, 2 * DFF, DM / 2, DM / 2}; pg8::StaticOrder S; S.init(T, 2 * DFF, F.G, (int)blockIdx.x);
        pg8::EpiSwiGLU8 E{ws + WS_RA, DFF};
        HOSTED_GEMM8(pg8::EpiSwiGLU8, 124, (int)(blockIdx.x & 7), CV_C1, CV_C2, CV_C2, 0); } SEAM(8);

    if (IN(9)) for (int rep_ = 0; rep_ < REPS(9); ++rep_) { if (rep_) GRID_BAR(); pg8::Gemm g{(const bf16*)(ws + WS_RA), (const bf16*)(ws + WS_WD0), T, DM, DFF / 2, DFF / 2}; pg8::StaticOrder S; S.init(T, DM, F.G, (int)blockIdx.x);
        pg8::EpiBf16<0> E{YB, DM, nullptr, 0, 0, 1.f};
        HOSTED_GEMM8(pg8::EpiBf16<0>, 122, (int)(blockIdx.x & 1), CV_C2, CV_C3, CV_C3, 0); } SEAM(9);

    if (IN(10)) { ln_rows<false, false>(F, XCURB, YB, (const float*)args.in[11], (const float*)args.in[12], XCURB, nullptr, nullptr, nullptr); } SEAM(10);

    if (IN(11)) { pg8::Gemm g{XCURB, (const bf16*)(ws + WS_WIN1), T, N_IN1, DM, DM}; pg8::StaticOrder S; S.init(T, N_IN1, F.G, (int)blockIdx.x);
        pg8::EpiIn1 E{H1, N_IN1, (float*)(ws + WS_DTR), 18};
        HOSTED_GEMM(pg8::EpiIn1, (int)(blockIdx.x % 3), CV_C3, CV_C4A, CV_C4, 96); } SEAM(11);

    if (IN(12)) { p10_conv(F, args); } SEAM(12);

    if (IN(13)) {
        const bf16* CV = (const bf16*)(ws + WS_RC); const float* ACS = (const float*)(ws + WS_ACS); float* STATES = (float*)(ws + WS_STATES);
        for (int u = blockIdx.x; u < 32 * 24; u += F.G) att::ssd_state_unit2(CV, ACS, STATES, u / 24, u % 24, F.ldsg, (float*)(F.ldsg + 132096));
        for (int m = blockIdx.x; m < 128; m += F.G) { const int mh = m & 3, qb = m >> 2;
            att::attn_unit<false, N_IN1, 1024, DM>(H1 + (size_t)(256 * qb) * N_IN1 + 4096 + mh * 128, MEMKV + mh * 128, MEMKV + 512 + mh * 128, HEADS + (size_t)(256 * qb) * DM + 1536 + mh * 128,
                                  4, 0, nullptr, F.ldsg); }
    } SEAM(13);

    if (IN(14)) { p12_scan(F, ws); } SEAM(14);

    if (IN(15)) { const bf16* CV = (const bf16*)(ws + WS_RC); const float* ACS = (const float*)(ws + WS_ACS); const bf16* PREV = (const bf16*)(ws + WS_PREV); const float* dsk = (const float*)args.in[18];
        att::ssd_y_units(CV, ACS, PREV, dsk, (float*)(ws + WS_YSSD), (int)blockIdx.x, F.G, F.ldsg, (float*)(F.ldsg + 132096)); } SEAM(15);

    if (IN(16)) { p14_gated_norm(F, args); } SEAM(16);

    if (IN(17)) { pg8::Gemm g{HEADS, (const bf16*)(ws + WS_WO1), T, DM, DM, DM}; pg8::StaticOrder S; S.init(T, DM, F.G, (int)blockIdx.x);
        pg8::EpiBf16<0> E{YB, DM, nullptr, 0, 0, 1.f};
        pg8::gemm_phase<pg8::EpiBf16<0>, pg8::StaticOrder, true, true>(F.lds + RING_OFF, g, S, E); } SEAM(17);

    if (IN(18)) { ln_rows<true, false>(F, XCURB, YB, (const float*)args.in[21], (const float*)args.in[22], XCURB, (const float*)args.in[23], (int*)(ws + WS_TOKE), (float*)(ws + WS_TOKW)); } SEAM(18);

    if (IN(19)) { p17_sort_gather(F, ws); } SEAM(19);

    { FRESH_TID(tx_); F.tid = tx_; F.lane = tx_ & 63; F.wave = wid_s; F.gw = blockIdx.x * NWAVES + F.wave; }
    if (IN(20)) for (int rep_ = 0; rep_ < REPS(20); ++rep_) { if (rep_) GRID_BAR(); int cnt[8];
#pragma unroll
        for (int e = 0; e < 8; ++e) cnt[e] = __builtin_amdgcn_readfirstlane(((const int*)(ws + WS_COUNTS))[e]);
        pg8::MoeOrder S; S.init(cnt, 56, F.G, (int)blockIdx.x, 1 << 20);
        pg8::Gemm g{(const bf16*)(ws + WS_RC), (const bf16*)(ws + WS_WGUE), MOE_ROWS, 8 * 2 * DFF, DM / 2, DM / 2};
        pg8::EpiSwiGLU8 E{ws + WS_RA, DFF};
        HOSTED_GEMM8_O(pg8::EpiSwiGLU8, pg8::MoeOrder, 124, (int)(blockIdx.x % 13) + 1, CV_C4, CV_NITEMS, CV_NITEMS, 0); } SEAM(20);

    { FRESH_TID(tx_); F.tid = tx_; F.lane = tx_ & 63; F.wave = wid_s; F.gw = blockIdx.x * NWAVES + F.wave; }
    if (IN(21)) for (int rep_ = 0; rep_ < REPS(21); ++rep_) { if (rep_) GRID_BAR(); int cnt[8];
#pragma unroll
        for (int e = 0; e < 8; ++e) cnt[e] = __builtin_amdgcn_readfirstlane(((const int*)(ws + WS_COUNTS))[e]);
        pg8::MoeOrder S; S.init(cnt, 8, F.G, (int)blockIdx.x, 2);
        { pg8::Gemm g{(const bf16*)(ws + WS_RA), (const bf16*)(ws + WS_WDE), MOE_ROWS, 8 * DM, DFF / 2, DFF / 2};
          pg8::EpiBf16Mod E{(bf16*)(ws + WS_RB), DM};
          { FRESH_TID(t8_); pg8::gemm_phase<pg8::EpiBf16Mod, pg8::MoeOrder, true, true, 122>(F.lds + RING_OFF, g, S, E, t8_); } }
        const int rem = S.per - 2 * (F.G >> 3);
        if (rem > 0) { const int SP = rem <= 4 ? 7 : 4;

          pg8::MoeSplitOrder S2; S2.init(S, 2, SP, DFF / 2);
          pg8::Gemm g{(const bf16*)(ws + WS_RA), (const bf16*)(ws + WS_WDE), MOE_ROWS, 8 * DM, DFF / 2 / SP, DFF / 2};
          pg8::EpiF32Mod E{(float*)(ws + WS_YF), 256};
          { FRESH_TID(t8_); pg8::gemm_phase<pg8::EpiF32Mod, pg8::MoeSplitOrder, true, true, 122>(F.lds + RING_OFF, g, S2, E, t8_); } } } SEAM(21);

    if (IN(22)) { int cnt[8];
#pragma unroll
        for (int e = 0; e < 8; ++e) cnt[e] = __builtin_amdgcn_readfirstlane(((const int*)(ws + WS_COUNTS))[e]);
        pg8::MoeOrder S; S.init(cnt, 8, F.G, (int)blockIdx.x, 2);
        const int rem = S.per - 2 * (F.G >> 3); const int SP = rem <= 4 ? 7 : 4;
          bf16* YM = (bf16*)(ws + WS_RB); const float* YF = (const float*)(ws + WS_YF);
        for (int it = blockIdx.x; it < 8 * rem * 4; it += F.G) { const int x = it / (4 * rem), r2 = it - x * 4 * rem, u = r2 >> 2, qt = r2 & 3;
            pg8::Unit un; S.decode(x * S.per + 2 * (F.G >> 3) + u, un);
            const float* pp = YF + (size_t)(x * 32 + u * SP) * 65536 + qt * 64 * 256; bf16* op = YM + (size_t)(un.opm * 256 + qt * 64) * DM + un.opn * 256;
            for (int i = F.tid; i < 64 * 64; i += NWAVES * 64) { const int r = i >> 6, c4 = i & 63; const float* q = pp + r * 256 + c4 * 4; f32x4 a;
                if (SP == 7) { f32x4 x[7];
#pragma unroll
                    for (int s = 0; s < 7; ++s) x[s] = *(const f32x4*)(q + (size_t)s * 65536);
                    a = ((x[0] + x[1]) + (x[2] + x[3])) + ((x[4] + x[5]) + x[6]); }
                else { f32x4 x[4];
#pragma unroll
                    for (int s = 0; s < 4; ++s) x[s] = *(const f32x4*)(q + (size_t)s * 65536);
                    a = (x[0] + x[1]) + (x[2] + x[3]); }
                *(v2u*)(op + (size_t)r * DM + c4 * 4) = (v2u){pk2(a[0], a[1]), pk2(a[2], a[3])}; } }
    } SEAM(22);


    if (IN(23)) { p20_final(F, args); }
#undef IN
#undef SEAM
#undef GRID_BAR
}

extern "C" void kernel_launch(void* const* d_in, const int* in_sizes, int n_in, void* d_out, int out_size, void* d_ws, size_t ws_size, hipStream_t stream) {
    static int grid = 0;
    if (grid == 0) {
        if (n_in != 29 || in_sizes[0] != T * DM || out_size != T * DM || ws_size < WS_END) {
            fprintf(stderr, "kernel_launch: unexpected shapes: n_in %d in0 %d out %d ws %zu (need %zu)\n", n_in, n_in > 0 ? in_sizes[0] : -1, out_size, ws_size, (size_t)WS_END); grid = -1; return; }
        int dev = 0, cus = 0, per_cu = 0;
        if (hipGetDevice(&dev) != hipSuccess || hipDeviceGetAttribute(&cus, hipDeviceAttributeMultiprocessorCount, dev) != hipSuccess) { grid = -1; return; }
        if (hipFuncSetAttribute((const void*)mega_fwd, hipFuncAttributeMaxDynamicSharedMemorySize, LDS_BYTES) != hipSuccess) { fprintf(stderr, "kernel_launch: hipFuncSetAttribute failed\n"); grid = -1; return; }
        if (hipOccupancyMaxActiveBlocksPerMultiprocessor(&per_cu, (const void*)mega_fwd, NWAVES * 64, LDS_BYTES) != hipSuccess || per_cu < 1)
            fprintf(stderr, "kernel_launch: occupancy query reports %d workgroups per CU\n", per_cu);
        (void)hipGetLastError();
        grid = cus;
    }
    if (grid < 0) return;
    if (hipMemsetAsync((char*)d_ws + WS_CTL, 0, CTL_ZERO_BYTES, stream) != hipSuccess) return;
    Args a{};
    for (int i = 0; i < 29; ++i) a.in[i] = d_in[i];
    a.out = (float*)d_out; a.ws = (unsigned char*)d_ws;
#if MK_PER_PHASE
    for (int p = 0; p < NPHASE; ++p) { a.ph_lo = p; a.ph_hi = p + 1; hipLaunchKernelGGL(mega_fwd, dim3(grid), dim3(NWAVES * 64), LDS_BYTES, stream, a); }
#else
    a.ph_lo = 0; a.ph_hi = NPHASE;
    hipLaunchKernelGGL(mega_fwd, dim3(grid), dim3(NWAVES * 64), LDS_BYTES, stream, a);
#endif
    const hipError_t le = hipPeekAtLastError();
    if (le != hipSuccess) fprintf(stderr, "kernel_launch: launch failed: %s\n", hipGetErrorName(le));
}
```

```cpp
#include <hip/hip_runtime.h>
#include <cstdio>
#include <cstdint>
#include <cmath>
constexpr int WTAB_OFF = 131072 + 512;
__device__ __forceinline__ int fresh_tid() {
    extern __shared__ __attribute__((aligned(16))) unsigned char lds_dyn_[];
    unsigned z_; asm volatile("s_mov_b32 %0, 0" : "=s"(z_));
    const unsigned key = (unsigned)__builtin_amdgcn_s_getreg((5 << 11) | 4) & 63u;
    const int wid = __builtin_amdgcn_readfirstlane(((const __attribute__((address_space(3))) int*)((__attribute__((address_space(3))) unsigned char*)lds_dyn_ + WTAB_OFF))[key + z_]);
    return wid * 64 + (int)__builtin_amdgcn_mbcnt_hi(~0u, __builtin_amdgcn_mbcnt_lo(~0u, z_));
}
namespace pg8 {
#define PG8_LAS __attribute__((address_space(3)))
typedef unsigned short bf16_t;
typedef short bf16x8 __attribute__((ext_vector_type(8)));
typedef float f32x4 __attribute__((ext_vector_type(4)));
typedef unsigned u32x4 __attribute__((ext_vector_type(4)));
constexpr int BM = 256, BK = 64, HALF = 128, HTB = HALF * BK * 2  , STAGE_BYTES = 8 * HTB, NXCD = 8, WGM = 8;

__host__ __device__ __forceinline__ int lds_byte(int r, int c) { const int st = (r >> 4) * 2 + (c >> 5), rr = r & 15, cc = c & 31, ob = rr * 64 + cc * 2; return st * 1024 + (ob ^ (((ob >> 9) & 1) << 5)); }
__host__ __device__ __forceinline__ void stage_rc(int b, int& R, int& C) { const int st = b / 1024, sb = b % 1024, swz = sb ^ (((sb >> 9) & 1) << 5); R = (st >> 1) * 16 + swz / 64; C = (st & 1) * 32 + (swz % 64) / 2; }
__host__ __device__ __forceinline__ int perm32(int rho) { const int n = rho >> 4, i = rho & 15; return 8 * (i >> 2) + 4 * n + (i & 3); }

struct Unit { int pm, pn, kofs, opm, opn; };
struct Gemm { const bf16_t* A; const bf16_t* Bt; int M, N, K, ld; };

struct StaticOrder {
    int nM, nN, nwg, G, c;
    __host__ __device__ void init(int M, int N, int G_, int c_) { nM = M / BM; nN = N / BM; nwg = nM * nN; G = G_; c = c_; }
    __host__ __device__ bool next(int i, Unit& u) const {
        const long L = (long)i * G + c; if (L >= nwg) return false;
        int wgid = (int)L; { const int q = nwg / NXCD, r = nwg % NXCD, xcd = wgid % NXCD, off = wgid / NXCD; wgid = (xcd < r ? xcd * (q + 1) : r * (q + 1) + (xcd - r) * q) + off; }
        const int nig = WGM * nN, gid = wgid / nig, fm = gid * WGM, gsz = (nM - fm) < WGM ? (nM - fm) : WGM;
        u.pm = fm + ((wgid % nig) % gsz); u.pn = (wgid % nig) / gsz; u.kofs = 0; u.opm = u.pm; u.opn = u.pn; return true;
    }
    __device__ __forceinline__ void a_ready(const Unit&) const {}
    __device__ __forceinline__ void done(const Unit&) const {}
};

__device__ __forceinline__ unsigned cvt_pk_bf16(float lo, float hi) { unsigned r; asm volatile("v_cvt_pk_bf16_f32 %0, %1, %2" : "=v"(r) : "v"(lo), "v"(hi)); return r; }
typedef float f32x2 __attribute__((ext_vector_type(2)));
__device__ __forceinline__ f32x2 gelu_pk(f32x2 v) {
    const f32x2 av = __builtin_elementwise_abs(v), d = av * 0.2316418882f + 1.0f;
    f32x2 t; t.x = __builtin_amdgcn_rcpf(d.x); t.y = __builtin_amdgcn_rcpf(d.y);
    f32x2 q = t * 0.5307027145f + (-0.7265760135f); q = q * t + 0.7107068705f; q = q * t + (-0.142248368f); q = q * t + 0.127414796f; q = q * t;
    const f32x2 s = (v * v) * (-0.72134752044f);
    f32x2 e; e.x = __builtin_amdgcn_exp2f(s.x); e.y = __builtin_amdgcn_exp2f(s.y);
    const f32x2 m = v * (q * e), r = v - m;
    f32x2 o; o.x = v.x < 0.f ? m.x : r.x; o.y = v.y < 0.f ? m.y : r.y; return o;
}

template <int ACT  > struct EpiBf16 {
    static constexpr bool PERM = true, AFTER_DRAIN = false; static_assert(ACT == 0 || ACT == 1, "EpiBf16: ACT is 0 (none) or 1 (gelu_pk)");
    bf16_t* O; int ldc; const float* bias; int split_cols; size_t split_stride; float scale0;
    __device__ __forceinline__ void operator()(const f32x4 (&acc)[2][2][4][2], const Unit& u, int wr, int wc, int fr, int fq) const {
        const int row0 = u.pm * BM + wr * 64 + fr; int colt = u.pn * BM; bf16_t* base = O;
        float sc = 1.f; if (split_cols) { const int t = colt / split_cols; base += (size_t)t * split_stride; colt -= t * split_cols; if (t == 0) sc = scale0; }
        const int col0 = colt + wc * 32 + 8 * fq, bcol0 = u.pn * BM + wc * 32 + 8 * fq;
        f32x4 bv[2][2];
#pragma unroll
        for (int bj = 0; bj < 2; ++bj)
#pragma unroll
            for (int n = 0; n < 2; ++n) bv[bj][n] = bias ? *(const f32x4*)(bias + bcol0 + bj * HALF + 4 * n) : (f32x4){0.f, 0.f, 0.f, 0.f};
#pragma unroll
        for (int ai = 0; ai < 2; ++ai)
#pragma unroll
            for (int m = 0; m < 4; ++m) { bf16_t* rowp = base + (size_t)(row0 + ai * HALF + m * 16) * ldc + col0;
#pragma unroll
                for (int bj = 0; bj < 2; ++bj) { f32x4 v0 = acc[ai][bj][m][0] + bv[bj][0], v1 = acc[ai][bj][m][1] + bv[bj][1];
                    if (ACT == 1) { f32x2 a = gelu_pk((f32x2){v0[0], v0[1]}), b = gelu_pk((f32x2){v0[2], v0[3]}), c = gelu_pk((f32x2){v1[0], v1[1]}), d = gelu_pk((f32x2){v1[2], v1[3]});
                        v0 = (f32x4){a.x, a.y, b.x, b.y}; v1 = (f32x4){c.x, c.y, d.x, d.y}; }
                    v0 = v0 * sc; v1 = v1 * sc; u32x4 w; w.x = cvt_pk_bf16(v0[0], v0[1]); w.y = cvt_pk_bf16(v0[2], v0[3]); w.z = cvt_pk_bf16(v1[0], v1[1]); w.w = cvt_pk_bf16(v1[2], v1[3]);
                    *(u32x4*)(rowp + bj * HALF) = w; } }
    }
};
struct EpiF32 {
    static constexpr bool PERM = false, AFTER_DRAIN = false;
    float* C; int ldc; const float* bias;
    __device__ __forceinline__ void operator()(const f32x4 (&acc)[2][2][4][2], const Unit& u, int wr, int wc, int fr, int fq) const {
        const int row0 = u.pm * BM + wr * 64 + fr, col0 = u.pn * BM + wc * 32 + 4 * fq;
        f32x4 bv[2][2];
#pragma unroll
        for (int bj = 0; bj < 2; ++bj)
#pragma unroll
            for (int n = 0; n < 2; ++n) bv[bj][n] = bias ? *(const f32x4*)(bias + col0 + bj * HALF + n * 16) : (f32x4){0.f, 0.f, 0.f, 0.f};
#pragma unroll
        for (int ai = 0; ai < 2; ++ai)
#pragma unroll
            for (int m = 0; m < 4; ++m) { float* rowp = C + (size_t)(row0 + ai * HALF + m * 16) * ldc + col0;
#pragma unroll
                for (int bj = 0; bj < 2; ++bj)
#pragma unroll
                    for (int n = 0; n < 2; ++n) *(f32x4*)(rowp + bj * HALF + n * 16) = acc[ai][bj][m][n] + bv[bj][n]; }
    }
};
__device__ __forceinline__ float silu_f(float g) { return g * __builtin_amdgcn_rcpf(1.0f + __builtin_amdgcn_exp2f(-1.4426950408889634f * g)); }
struct EpiSwiGLU {
    static constexpr bool PERM = true, AFTER_DRAIN = false;
    bf16_t* O; int ldc;
    __device__ __forceinline__ void operator()(const f32x4 (&acc)[2][2][4][2], const Unit& u, int wr, int wc, int fr, int fq) const {
        const int row0 = u.opm * BM + wr * 64 + fr, col0 = u.opn * HALF + wc * 32 + 8 * fq;
#pragma unroll
        for (int ai = 0; ai < 2; ++ai)
#pragma unroll
            for (int m = 0; m < 4; ++m) { bf16_t* rowp = O + (size_t)(row0 + ai * HALF + m * 16) * ldc + col0;
                const f32x4 g0 = acc[ai][0][m][0], g1 = acc[ai][0][m][1], u0 = acc[ai][1][m][0], u1 = acc[ai][1][m][1];
                f32x4 h0, h1;
#pragma unroll
                for (int j = 0; j < 4; ++j) { h0[j] = silu_f(g0[j]) * u0[j]; h1[j] = silu_f(g1[j]) * u1[j]; }
                u32x4 w; w.x = cvt_pk_bf16(h0[0], h0[1]); w.y = cvt_pk_bf16(h0[2], h0[3]); w.z = cvt_pk_bf16(h1[0], h1[1]); w.w = cvt_pk_bf16(h1[2], h1[3]);
                *(u32x4*)rowp = w; }
    }
};
struct EpiSwiGLU8 {
    static constexpr bool PERM = true, AFTER_DRAIN = false;
    unsigned char* O; int ldc;
    __device__ __forceinline__ void operator()(const f32x4 (&acc)[2][2][4][2], const Unit& u, int wr, int wc, int fr, int fq) const {
        const int row0 = u.opm * BM + wr * 64 + fr, col0 = u.opn * HALF + wc * 32 + 8 * fq;
#pragma unroll
        for (int ai = 0; ai < 2; ++ai)
#pragma unroll
            for (int m = 0; m < 4; ++m) { unsigned char* rowp = O + (size_t)(row0 + ai * HALF + m * 16) * ldc + col0;
                const f32x4 g0 = acc[ai][0][m][0], g1 = acc[ai][0][m][1], u0 = acc[ai][1][m][0], u1 = acc[ai][1][m][1];
                f32x4 h0, h1;
#pragma unroll
                for (int j = 0; j < 4; ++j) { h0[j] = __builtin_fminf(__builtin_fmaxf(silu_f(g0[j]) * u0[j] * 8.0f, -448.0f), 448.0f); h1[j] = __builtin_fminf(__builtin_fmaxf(silu_f(g1[j]) * u1[j] * 8.0f, -448.0f), 448.0f); }
                int w0 = 0, w1 = 0;
                w0 = __builtin_amdgcn_cvt_pk_fp8_f32(h0[0], h0[1], w0, false); w0 = __builtin_amdgcn_cvt_pk_fp8_f32(h0[2], h0[3], w0, true);
                w1 = __builtin_amdgcn_cvt_pk_fp8_f32(h1[0], h1[1], w1, false); w1 = __builtin_amdgcn_cvt_pk_fp8_f32(h1[2], h1[3], w1, true);
                typedef unsigned v2u_ __attribute__((ext_vector_type(2)));
                *(v2u_*)rowp = (v2u_){(unsigned)w0, (unsigned)w1}; }
    }
};
struct EpiF32Mod {
    static constexpr bool PERM = false, AFTER_DRAIN = false;
    float* C; int ldc;
    __device__ __forceinline__ void operator()(const f32x4 (&acc)[2][2][4][2], const Unit& u, int wr, int wc, int fr, int fq) const {
        const int row0 = u.opm * BM + wr * 64 + fr, col0 = u.opn * BM + wc * 32 + 4 * fq;
#pragma unroll
        for (int ai = 0; ai < 2; ++ai)
#pragma unroll
            for (int m = 0; m < 4; ++m) { float* rowp = C + (size_t)(row0 + ai * HALF + m * 16) * ldc + col0;
#pragma unroll
                for (int bj = 0; bj < 2; ++bj)
#pragma unroll
                    for (int n = 0; n < 2; ++n) *(f32x4*)(rowp + bj * HALF + n * 16) = acc[ai][bj][m][n]; }
    }
};
struct EpiBf16Mod {
    static constexpr bool PERM = true, AFTER_DRAIN = false;
    bf16_t* O; int ldc;
    __device__ __forceinline__ void operator()(const f32x4 (&acc)[2][2][4][2], const Unit& u, int wr, int wc, int fr, int fq) const {
        const int row0 = u.opm * BM + wr * 64 + fr, col0 = u.opn * BM + wc * 32 + 8 * fq;
#pragma unroll
        for (int ai = 0; ai < 2; ++ai)
#pragma unroll
            for (int m = 0; m < 4; ++m) { bf16_t* rowp = O + (size_t)(row0 + ai * HALF + m * 16) * ldc + col0;
#pragma unroll
                for (int bj = 0; bj < 2; ++bj) { const f32x4 v0 = acc[ai][bj][m][0], v1 = acc[ai][bj][m][1];
                    u32x4 w; w.x = cvt_pk_bf16(v0[0], v0[1]); w.y = cvt_pk_bf16(v0[2], v0[3]); w.z = cvt_pk_bf16(v1[0], v1[1]); w.w = cvt_pk_bf16(v1[2], v1[3]);
                    *(u32x4*)(rowp + bj * HALF) = w; } }
    }
};
struct EpiQKV {
    static constexpr bool PERM = true, AFTER_DRAIN = false;
    bf16_t* O; int ldc; const float* rope; float* kpart;
    __device__ __forceinline__ void operator()(const f32x4 (&acc)[2][2][4][2], const Unit& u, int wr, int wc, int fr, int fq) const {
        const int row0 = u.pm * BM + wr * 64 + fr; const int col0 = u.pn * BM + wc * 32 + 8 * fq;
        const bool rot = (u.pn < 12) && (wc == 0), isk = (u.pn >= 6) && (u.pn < 12);
        f32x4 cs_[2][2];
#pragma unroll
        for (int bj = 0; bj < 2; ++bj)
#pragma unroll
            for (int n = 0; n < 2; ++n) cs_[bj][n] = (f32x4){0.f, 0.f, 0.f, 0.f};
#pragma unroll
        for (int ai = 0; ai < 2; ++ai)
#pragma unroll
            for (int m = 0; m < 4; ++m) { const int t = row0 + ai * HALF + m * 16; bf16_t* rowp = O + (size_t)t * ldc + col0;
                f32x4 c4[2];
                if (rot) { c4[0] = *(const f32x4*)(rope + ((size_t)t * 16 + 4 * fq) * 2); c4[1] = *(const f32x4*)(rope + ((size_t)t * 16 + 4 * fq + 2) * 2); }
#pragma unroll
                for (int bj = 0; bj < 2; ++bj) { f32x4 v[2];
#pragma unroll
                    for (int n = 0; n < 2; ++n) { v[n] = acc[ai][bj][m][n];
                        if (rot) { const f32x4 x = v[n], c = c4[n]; v[n] = (f32x4){x[0] * c[0] - x[1] * c[1], x[1] * c[0] + x[0] * c[1], x[2] * c[2] - x[3] * c[3], x[3] * c[2] + x[2] * c[3]}; }
                        cs_[bj][n] += v[n]; }
                    u32x4 w; w.x = cvt_pk_bf16(v[0][0], v[0][1]); w.y = cvt_pk_bf16(v[0][2], v[0][3]); w.z = cvt_pk_bf16(v[1][0], v[1][1]); w.w = cvt_pk_bf16(v[1][2], v[1][3]);
                    *(u32x4*)(rowp + bj * HALF) = w; } }
        if (isk) {
#pragma unroll
            for (int bj = 0; bj < 2; ++bj)
#pragma unroll
                for (int n = 0; n < 2; ++n)
#pragma unroll
                    for (int j = 0; j < 4; ++j) { float s = cs_[bj][n][j]; s += __shfl_xor(s, 1); s += __shfl_xor(s, 2); s += __shfl_xor(s, 4); s += __shfl_xor(s, 8); cs_[bj][n][j] = s; }
            if (fr == 0) {
#pragma unroll
                for (int bj = 0; bj < 2; ++bj) { float* kp = kpart + ((size_t)((2 * (u.pn - 6) + bj) * 32 + u.pm) * 2 + wr) * 128 + wc * 32 + 8 * fq;
                    *(f32x4*)kp = cs_[bj][0]; *(f32x4*)(kp + 4) = cs_[bj][1]; } }
        }
    }
};
struct EpiIn1 {
    static constexpr bool PERM = true, AFTER_DRAIN = false;
    bf16_t* O; int ldc; float* DT; int dt_pn;
    __device__ __forceinline__ void operator()(const f32x4 (&acc)[2][2][4][2], const Unit& u, int wr, int wc, int fr, int fq) const {
        const int row0 = u.pm * BM + wr * 64 + fr; const int col0 = u.pn * BM + wc * 32 + 8 * fq;
#pragma unroll
        for (int ai = 0; ai < 2; ++ai)
#pragma unroll
            for (int m = 0; m < 4; ++m) { bf16_t* rowp = O + (size_t)(row0 + ai * HALF + m * 16) * ldc + col0;
#pragma unroll
                for (int bj = 0; bj < 2; ++bj) { const f32x4 v0 = acc[ai][bj][m][0], v1 = acc[ai][bj][m][1];
                    u32x4 w; w.x = cvt_pk_bf16(v0[0], v0[1]); w.y = cvt_pk_bf16(v0[2], v0[3]); w.z = cvt_pk_bf16(v1[0], v1[1]); w.w = cvt_pk_bf16(v1[2], v1[3]);
                    *(u32x4*)(rowp + bj * HALF) = w; } }
        if (u.pn == dt_pn && wc == 0 && fq < 3) {
#pragma unroll
            for (int ai = 0; ai < 2; ++ai)
#pragma unroll
                for (int m = 0; m < 4; ++m) { float* dp = DT + (size_t)(row0 + ai * HALF + m * 16) * 32 + 8 * fq;
                    *(f32x4*)dp = acc[ai][0][m][0]; *(f32x4*)(dp + 4) = acc[ai][0][m][1]; }
        }
    }
};
struct MoeOrder {
    int G, c, npn, per, imax; int tp[9];
    __device__ __forceinline__ void init(const int* counts, int npn_, int G_, int c_, int imax_) { G = G_; c = c_; npn = npn_; imax = imax_; tp[0] = 0;
#pragma unroll
        for (int e = 0; e < 8; ++e) tp[e + 1] = tp[e] + ((counts[e] + 255) >> 8);
        per = tp[8] * npn / 8; }
    __device__ __forceinline__ void decode(int L, Unit& u) const {
        int e = 0;
#pragma unroll
        for (int k = 1; k < 8; ++k) e += (L >= tp[k] * npn) ? 1 : 0;
        int tpe = 0, tpn = 0;
#pragma unroll
        for (int k = 0; k < 8; ++k) { if (k == e) { tpe = tp[k]; tpn = tp[k + 1]; } }
        const int r = L - tpe * npn, nt = tpn - tpe; const int pn = r / nt, pml = r - pn * nt;
        u.pm = tpe + pml; u.pn = e * npn + pn; u.kofs = 0; u.opm = u.pm; u.opn = pn; }
    __device__ __forceinline__ bool next(int i, Unit& u) const {
        const int s = i * (G >> 3) + (c >> 3); if (i >= imax || s >= per) return false;
        decode((c & 7) * per + s, u); return true; }
    __device__ __forceinline__ void a_ready(const Unit&) const {}
    __device__ __forceinline__ void done(const Unit&) const {}
};
struct MoeSplitOrder {
    MoeOrder base; int first, S, kpiece;
    __device__ __forceinline__ void init(const MoeOrder& b, int done_rounds, int S_, int Ktot) { base = b; first = done_rounds * (b.G >> 3); S = S_; kpiece = Ktot / S_; }
    __device__ __forceinline__ bool next(int i, Unit& u) const {
        const int q = base.c >> 3; if (i > 0 || first + q / S >= base.per) return false;
        base.decode((base.c & 7) * base.per + first + q / S, u); u.kofs = (q % S) * kpiece; u.opm = (base.c & 7) * 32 + q; u.opn = 0; return true; }
    __device__ __forceinline__ void a_ready(const Unit&) const {}
    __device__ __forceinline__ void done(const Unit&) const {}
};
template <class Base> struct RangeOrder {
    Base b; int i0, i1;
    __device__ __forceinline__ bool next(int i, Unit& u) const { return (i0 + i < i1) && b.next(i0 + i, u); }
    __device__ __forceinline__ void a_ready(const Unit&) const {}
    __device__ __forceinline__ void done(const Unit&) const {}
};
template <class Epi, class Sched, bool ALIGN_EPI = false, bool SP2 = false, int FP8 = 0>
__device__ __forceinline__ void gemm_phase(PG8_LAS unsigned char* lds, const Gemm g, const Sched& S, const Epi& E, int tid_in = -1) {
    int tid_ = fresh_tid(); (void)tid_in; asm volatile("" : "+v"(tid_));
    const int tid = tid_, wid = __builtin_amdgcn_readfirstlane(tid >> 6), lane = tid & 63, wr = wid >> 2, wc = wid & 3, fr = lane & 15, fq = lane >> 4;
    const int K = g.ld, nt = g.K / BK;
    unsigned voffA[2], voffB[2];
#pragma unroll
    for (int i = 0; i < 2; ++i) { int R, C; stage_rc(tid * 16 + i * 8192, R, C); const int Rb = Epi::PERM ? ((R & ~31) + perm32(R & 31)) : R;
        voffA[i] = (unsigned)(R * K + C) * 2u; voffB[i] = (unsigned)(Rb * K + C) * 2u; }
    const size_t kstep = (size_t)(BK * 2);
    const size_t hstep = (size_t)HALF * K * 2;
    const size_t tstep = 2 * hstep;
    const unsigned ldsw = (unsigned)wid * 1024u;
    const int aoff = lds_byte(wr * 64 + fr, fq * 8), boff = lds_byte(wc * 32 + fr, fq * 8);
#define PG8_SA(b, h) (((b) * 2 + (h)) * HTB)
#define PG8_SB(b, h) ((4 + (b) * 2 + (h)) * HTB)
#define PG8_STAGE(bufoff, gbase, voff) do { _Pragma("unroll") for (int _i = 0; _i < 2; ++_i) { unsigned vo_ = (voff)[_i]; if constexpr (FP8 != 0) asm volatile("" : "+v"(vo_));     \
        __builtin_amdgcn_global_load_lds((const unsigned*)((const char*)(gbase) + vo_), (PG8_LAS unsigned*)(lds + (bufoff) + ldsw + _i * 8192), 16, 0, 0); } } while (0)
#define PG8_LDA(dst, b, h) do { if constexpr (FP8 == 0) { _Pragma("unroll") for (int m = 0; m < 4; ++m) _Pragma("unroll") for (int k = 0; k < 2; ++k) dst[m][k] = *(const PG8_LAS bf16x8*)(lds + PG8_SA(b, h) + aoff + m * 2048 + k * 1024); } \
    else { _Pragma("unroll") for (int m = 0; m < 4; ++m) { const v4i_ l_ = *(const PG8_LAS v4i_*)(lds + PG8_SA(b, h) + aoff + m * 2048), h_ = *(const PG8_LAS v4i_*)(lds + PG8_SA(b, h) + aoff + m * 2048 + 1024); \
        dst##8[m] = __builtin_shufflevector(l_, h_, 0, 1, 2, 3, 4, 5, 6, 7); } } } while (0)
#define PG8_LDB(dst, b, h) do { if constexpr (FP8 == 0) { _Pragma("unroll") for (int n = 0; n < 2; ++n) _Pragma("unroll") for (int k = 0; k < 2; ++k) dst[n][k] = *(const PG8_LAS bf16x8*)(lds + PG8_SB(b, h) + boff + n * 2048 + k * 1024); } \
    else { _Pragma("unroll") for (int n = 0; n < 2; ++n) { const v4i_ l_ = *(const PG8_LAS v4i_*)(lds + PG8_SB(b, h) + boff + n * 2048), h_ = *(const PG8_LAS v4i_*)(lds + PG8_SB(b, h) + boff + n * 2048 + 1024); \
        dst##8[n] = __builtin_shufflevector(l_, h_, 0, 1, 2, 3, 4, 5, 6, 7); } } } while (0)
#define PG8_MMA(ai, bj, At, Bt) do { __builtin_amdgcn_s_setprio(1); if constexpr (FP8 == 0) { _Pragma("unroll") for (int m = 0; m < 4; ++m) _Pragma("unroll") for (int n = 0; n < 2; ++n) _Pragma("unroll") for (int k = 0; k < 2; ++k) \
        acc[ai][bj][m][n] = __builtin_amdgcn_mfma_f32_16x16x32_bf16(Bt[n][k], At[m][k], acc[ai][bj][m][n], 0, 0, 0); } \
    else { _Pragma("unroll") for (int m = 0; m < 4; ++m) _Pragma("unroll") for (int n = 0; n < 2; ++n) \
        acc[ai][bj][m][n] = __builtin_amdgcn_mfma_scale_f32_16x16x128_f8f6f4(Bt##8[n], At##8[m], acc[ai][bj][m][n], 0, 0, 0, FP8 * 0x01010101, 0, FP8 * 0x01010101); } \
    __builtin_amdgcn_s_setprio(0); } while (0)
#define PG8_WAIT_V(n) asm volatile("s_waitcnt vmcnt(" #n ")" ::: "memory")
#define PG8_WAIT_L(n) asm volatile("s_waitcnt lgkmcnt(" #n ")" ::: "memory")
#define PG8_BAR __builtin_amdgcn_s_barrier()
#define PG8_SCHED __builtin_amdgcn_sched_barrier(0)
    Unit cur, nxt; int ui = 0;
    if (!S.next(0, cur)) return;
    f32x4 acc[2][2][4][2];
#pragma unroll
    for (int a = 0; a < 2; ++a)
#pragma unroll
        for (int b = 0; b < 2; ++b)
#pragma unroll
            for (int m = 0; m < 4; ++m)
#pragma unroll
                for (int n = 0; n < 2; ++n) acc[a][b][m][n] = (f32x4){0.f, 0.f, 0.f, 0.f};
    typedef int v4i_ __attribute__((ext_vector_type(4))); typedef int v8i_ __attribute__((ext_vector_type(8)));
    bf16x8 At[4][2], B0[2][2], B1[2][2];
    v8i_ At8[4], B08[2], B18[2];
    const char* cA = (const char*)g.A + (size_t)cur.pm * tstep + (size_t)cur.kofs * 2; const char* cB = (const char*)g.Bt + (size_t)cur.pn * tstep + (size_t)cur.kofs * 2;
    S.a_ready(cur);
    if constexpr (SP2) {
        PG8_STAGE(PG8_SB(0, 0), cB, voffB); PG8_STAGE(PG8_SB(0, 1), cB + hstep, voffB); PG8_STAGE(PG8_SA(0, 0), cA, voffA); PG8_STAGE(PG8_SA(0, 1), cA + hstep, voffA);
        if (wr == 1) PG8_BAR;
        PG8_WAIT_V(2); PG8_BAR;
        PG8_STAGE(PG8_SB(1, 0), cB + kstep, voffB); PG8_STAGE(PG8_SA(1, 0), cA + kstep, voffA); PG8_STAGE(PG8_SB(1, 1), cB + hstep + kstep, voffB);
        PG8_WAIT_V(6); PG8_BAR;
    } else {
        PG8_STAGE(PG8_SB(0, 0), cB, voffB); PG8_STAGE(PG8_SA(0, 0), cA, voffA); PG8_STAGE(PG8_SB(0, 1), cB + hstep, voffB); PG8_STAGE(PG8_SA(0, 1), cA + hstep, voffA);
        if (wr == 1) PG8_BAR;
        PG8_WAIT_V(4); PG8_BAR;
        PG8_STAGE(PG8_SB(1, 0), cB + kstep, voffB); PG8_STAGE(PG8_SA(1, 0), cA + kstep, voffA); PG8_STAGE(PG8_SB(1, 1), cB + hstep + kstep, voffB);
        PG8_WAIT_V(6); PG8_BAR;
    }
    for (;;) {
        const bool has_next = S.next(ui + 1, nxt);
        const char* nA = has_next ? (const char*)g.A + (size_t)nxt.pm * tstep + (size_t)nxt.kofs * 2 : cA; const char* nB = has_next ? (const char*)g.Bt + (size_t)nxt.pn * tstep + (size_t)nxt.kofs * 2 : cB;
        for (int t = 0; t < nt; t += 2) {
            const bool last = (t == nt - 2);
            const char* a1 = cA + (size_t)(t + 1) * kstep;
            const char* a2 = last ? nA : cA + (size_t)(t + 2) * kstep; const char* b2 = last ? nB : cB + (size_t)(t + 2) * kstep;
            const char* a3 = a2 + kstep; const char* b3 = b2 + kstep;
            if constexpr (FP8 != 0) { asm volatile("" : "+s"(a1), "+s"(a2), "+s"(b2), "+s"(a3), "+s"(b3)); }
            if (last && has_next) S.a_ready(nxt);
            if constexpr (SP2) {
            PG8_LDB(B0, 0, 0); PG8_LDB(B1, 0, 1); PG8_SCHED; PG8_LDA(At, 0, 0); PG8_STAGE(PG8_SA(1, 1), a1 + hstep, voffA);
            PG8_WAIT_V(8); PG8_WAIT_L(0); PG8_BAR; PG8_MMA(0, 0, At, B0); PG8_MMA(0, 1, At, B1); PG8_BAR; PG8_SCHED;
            PG8_LDA(At, 0, 1); PG8_STAGE(PG8_SB(0, 0), b2, voffB); PG8_STAGE(PG8_SB(0, 1), b2 + hstep, voffB); PG8_STAGE(PG8_SA(0, 0), a2, voffA);
            PG8_WAIT_V(8); PG8_WAIT_L(0); PG8_BAR; PG8_MMA(1, 0, At, B0); PG8_MMA(1, 1, At, B1); PG8_BAR; PG8_SCHED;
            PG8_LDB(B0, 1, 0); PG8_LDB(B1, 1, 1); PG8_SCHED; PG8_LDA(At, 1, 0); PG8_STAGE(PG8_SA(0, 1), a2 + hstep, voffA);
            PG8_WAIT_V(8); PG8_WAIT_L(0); PG8_BAR; PG8_MMA(0, 0, At, B0); PG8_MMA(0, 1, At, B1); PG8_BAR; PG8_SCHED;
            PG8_LDA(At, 1, 1); PG8_STAGE(PG8_SB(1, 0), b3, voffB); PG8_STAGE(PG8_SB(1, 1), b3 + hstep, voffB); PG8_STAGE(PG8_SA(1, 0), a3, voffA);
            PG8_WAIT_V(8); PG8_WAIT_L(0); PG8_BAR; PG8_MMA(1, 0, At, B0); PG8_MMA(1, 1, At, B1); PG8_BAR; PG8_SCHED;
            } else {
            PG8_LDB(B0, 0, 0); PG8_SCHED; PG8_LDA(At, 0, 0); PG8_STAGE(PG8_SA(1, 1), a1 + hstep, voffA);
            PG8_WAIT_L(8); PG8_BAR; PG8_WAIT_L(0); PG8_MMA(0, 0, At, B0); PG8_BAR; PG8_SCHED;
            PG8_LDB(B1, 0, 1); PG8_STAGE(PG8_SB(0, 0), b2, voffB);
            PG8_BAR; PG8_WAIT_L(0); PG8_MMA(0, 1, At, B1); PG8_BAR;
            PG8_LDA(At, 0, 1); PG8_STAGE(PG8_SA(0, 0), a2, voffA);
            PG8_BAR; PG8_WAIT_L(0); PG8_MMA(1, 0, At, B0); PG8_BAR; PG8_SCHED;
            PG8_STAGE(PG8_SB(0, 1), b2 + hstep, voffB);
            PG8_WAIT_V(6); PG8_BAR; PG8_MMA(1, 1, At, B1); PG8_BAR;
            PG8_LDB(B0, 1, 0); PG8_SCHED; PG8_LDA(At, 1, 0); PG8_STAGE(PG8_SA(0, 1), a2 + hstep, voffA);
            PG8_WAIT_L(8); PG8_BAR; PG8_WAIT_L(0); PG8_MMA(0, 0, At, B0); PG8_BAR; PG8_SCHED;
            PG8_LDB(B1, 1, 1); PG8_STAGE(PG8_SB(1, 0), b3, voffB);
            PG8_BAR; PG8_WAIT_L(0); PG8_MMA(0, 1, At, B1); PG8_BAR;
            PG8_LDA(At, 1, 1); PG8_STAGE(PG8_SA(1, 0), a3, voffA);
            PG8_BAR; PG8_WAIT_L(0); PG8_MMA(1, 0, At, B0); PG8_BAR; PG8_SCHED;
            PG8_STAGE(PG8_SB(1, 1), b3 + hstep, voffB);
            PG8_WAIT_V(6); PG8_BAR; PG8_MMA(1, 1, At, B1); PG8_BAR;
            }
        }
        if constexpr (ALIGN_EPI) { if (wr == 0) PG8_BAR; }
        if constexpr (!Epi::AFTER_DRAIN) { int fr_ = fr, fq_ = fq; if constexpr (FP8 != 0) asm volatile("" : "+v"(fr_), "+v"(fq_));
            E(acc, cur, wr, wc, fr_, fq_); S.done(cur); }
        if (!has_next) break;
#pragma unroll
        for (int a = 0; a < 2; ++a)
#pragma unroll
            for (int b = 0; b < 2; ++b)
#pragma unroll
                for (int m = 0; m < 4; ++m)
#pragma unroll
                    for (int n = 0; n < 2; ++n) acc[a][b][m][n] = (f32x4){0.f, 0.f, 0.f, 0.f};
        cur = nxt; cA = nA; cB = nB; ++ui;
        if constexpr (ALIGN_EPI) { if (wr == 1) PG8_BAR; }
    }
    PG8_WAIT_V(0);
    if constexpr (!ALIGN_EPI) { if (wr == 0) PG8_BAR; }
    PG8_BAR;
    if constexpr (Epi::AFTER_DRAIN) { E.fused(acc, cur, wr, wc, fr, fq, lds, wid, lane); S.done(cur); }
#undef PG8_SA
#undef PG8_SB
#undef PG8_STAGE
#undef PG8_LDA
#undef PG8_LDB
#undef PG8_MMA
#undef PG8_WAIT_V
#undef PG8_WAIT_L
#undef PG8_BAR
#undef PG8_SCHED
}
}

namespace att {
using bf16x8 = __attribute__((ext_vector_type(8))) short;
using s16x4  = __attribute__((ext_vector_type(4))) short;
using f32x16 = __attribute__((ext_vector_type(16))) float;
using f32x4  = __attribute__((ext_vector_type(4))) float;
using u32x4  = __attribute__((ext_vector_type(4))) unsigned;
using u32x2  = __attribute__((ext_vector_type(2))) unsigned;
typedef unsigned short bf16;
constexpr int   D = 128, NW = 8, QBLK = 32, KVBLK = 64;
constexpr float SCALE = 0.088388347648318440f;
constexpr float THR = 8.f;
constexpr float NEG = -1e30f;
constexpr int SHM_V = KVBLK * D * 2, SHM_K = KVBLK * D * 2;
constexpr int SHM_ATTN = 2 * SHM_V + 2 * SHM_K + NW * 64 * 4;
constexpr int ACS_OFF = SHM_ATTN;
#define KSWZ(row, colB) ((row) * 256 + ((colB) ^ (((row) & 7) << 4)))
#define SBAR() __builtin_amdgcn_sched_barrier(0)
__device__ __forceinline__ int crow(int r, int hi) { return (r & 3) + 8 * (r >> 2) + 4 * hi; }
__device__ __forceinline__ unsigned cvtpk(float lo, float hi) { unsigned r; asm volatile("v_cvt_pk_bf16_f32 %0, %1, %2" : "=v"(r) : "v"(lo), "v"(hi)); return r; }
__device__ __forceinline__ float bf2f(unsigned short b) { return __uint_as_float(((unsigned)b) << 16); }
__device__ __forceinline__ bf16x8 ld8(const bf16* p) { return *reinterpret_cast<const bf16x8*>(p); }

__device__ __forceinline__ int moba_lim(int idx, int qrow, unsigned rowmask, int hi) {
  const int vis = ((rowmask >> (((idx - 4) >> 2) & 31)) & 1u) ? 64 : -1;
  return ((idx < 4) ? (qrow - 64 * idx) : vis) - 4 * hi;
}
__device__ __forceinline__ void partialSM(f32x16& p0, f32x16& p1, float& m_reg, float& mn, float& alpha) {
  constexpr float C = SCALE * 1.4426950408889634f;
  float pmax = p0[0];
#pragma unroll
  for (int r = 1; r < 16; ++r) pmax = fmaxf(pmax, p0[r]);
#pragma unroll
  for (int r = 0; r < 16; ++r) pmax = fmaxf(pmax, p1[r]);
  { auto rr = __builtin_amdgcn_permlane32_swap(__float_as_uint(pmax), __float_as_uint(pmax), false, false);
    pmax = fmaxf(__uint_as_float(rr[0]), __uint_as_float(rr[1])); }
  if (__builtin_expect(__all(pmax - m_reg <= THR / SCALE), 1)) { mn = m_reg; alpha = 1.f; }
  else { mn = fmaxf(m_reg, pmax); alpha = __builtin_amdgcn_exp2f((m_reg - mn) * C); m_reg = mn; }
  const float mnC = -mn * C;
#pragma unroll
  for (int r = 0; r < 16; ++r) p0[r] = fmaf(p0[r], C, mnC);
#pragma unroll
  for (int r = 0; r < 16; ++r) p1[r] = fmaf(p1[r], C, mnC);
#pragma unroll
  for (int r = 0; r < 16; ++r) p0[r] = __builtin_amdgcn_exp2f(p0[r]);
}
#define ATT_PK4(P, BASE, OUT) do { unsigned a0 = cvtpk(P[BASE + 0], P[BASE + 1]), a1 = cvtpk(P[BASE + 2], P[BASE + 3]);   \
    unsigned b0 = cvtpk(P[BASE + 4], P[BASE + 5]), b1 = cvtpk(P[BASE + 6], P[BASE + 7]);                              \
    auto r0 = __builtin_amdgcn_permlane32_swap(a0, b0, false, false); auto r1 = __builtin_amdgcn_permlane32_swap(a1, b1, false, false); \
    u32x4 w = {r0[0], r1[0], r0[1], r1[1]}; OUT = *reinterpret_cast<bf16x8*>(&w); } while (0)
__device__ __forceinline__ void finishSM(f32x16& p0, f32x16& p1, float alpha, float& l_reg, bf16x8& pa0, bf16x8& pa1, bf16x8& pa2, bf16x8& pa3) {
#pragma unroll
  for (int r = 0; r < 16; ++r) p1[r] = __builtin_amdgcn_exp2f(p1[r]);
  float ps = 0;
#pragma unroll
  for (int r = 0; r < 16; ++r) ps += p0[r];
#pragma unroll
  for (int r = 0; r < 16; ++r) ps += p1[r];
  { auto rr = __builtin_amdgcn_permlane32_swap(__float_as_uint(ps), __float_as_uint(ps), false, false);
    ps = __uint_as_float(rr[0]) + __uint_as_float(rr[1]); }
  l_reg = l_reg * alpha + ps;
  ATT_PK4(p0, 0, pa0); ATT_PK4(p0, 8, pa1); ATT_PK4(p1, 0, pa2); ATT_PK4(p1, 8, pa3);
}
template <bool MASKED>
__device__ __forceinline__ void qkt(f32x16& p0, f32x16& p1, const char* Ks, const bf16x8* qr, int r32, int hi, int lim = 0) {
  if (MASKED) {
#pragma unroll
    for (int r = 0; r < 16; ++r) { const int cr = (r & 3) + 8 * (r >> 2); p0[r] = (cr > lim) ? NEG : 0.f; p1[r] = (cr + 32 > lim) ? NEG : 0.f; }
  } else { p0 = f32x16{}; p1 = f32x16{}; }
#pragma unroll
  for (int d0 = 0; d0 < 8; ++d0) { const int cb = (d0 * 16 + hi * 8) * 2;
    bf16x8 b0 = *reinterpret_cast<const bf16x8*>(Ks + KSWZ(r32, cb));
    bf16x8 b1 = *reinterpret_cast<const bf16x8*>(Ks + KSWZ(32 + r32, cb));
    p0 = __builtin_amdgcn_mfma_f32_32x32x16_bf16(b0, qr[d0], p0, 0, 0, 0);
    p1 = __builtin_amdgcn_mfma_f32_32x32x16_bf16(b1, qr[d0], p1, 0, 0, 0); }
}
__device__ __forceinline__ int v_st(int k, int c) { const int kk = (k & ~0xC) | ((k & 4) << 1) | ((k & 8) >> 1); return ((kk >> 3) * 4 + (c >> 5)) * 512 + ((kk & 7) * 32 + (c & 31)) * 2; }
__device__ __forceinline__ int v_rd_base(int lane) { return ((lane & 3) << 3) | (((lane >> 2) & 3) << 6) | (((lane >> 4) & 1) << 5) | (((lane >> 5) & 1) << 8); }
constexpr int v_rd_off(int d0, int ks, int half) { return d0 * 512 + ks * 4096 + half * 2048; }
template <int OFF> __device__ __forceinline__ s16x4 tr_read(int vb) {
  s16x4 r; asm volatile("ds_read_b64_tr_b16 %0, %1 offset:%2" : "=&v"(r) : "v"(vb), "i"(OFF) : "memory"); return r;
}
#define ATT_PK(L, H) (bf16x8){L[0], L[1], L[2], L[3], H[0], H[1], H[2], H[3]}
template <int D0> __device__ __forceinline__ void pv_one(f32x16& od, int vb, bf16x8 pa0, bf16x8 pa1, bf16x8 pa2, bf16x8 pa3) {
  const s16x4 l0 = tr_read<v_rd_off(D0, 0, 0)>(vb), h0 = tr_read<v_rd_off(D0, 0, 1)>(vb), l1 = tr_read<v_rd_off(D0, 1, 0)>(vb), h1 = tr_read<v_rd_off(D0, 1, 1)>(vb);
  const s16x4 l2 = tr_read<v_rd_off(D0, 2, 0)>(vb), h2 = tr_read<v_rd_off(D0, 2, 1)>(vb), l3 = tr_read<v_rd_off(D0, 3, 0)>(vb), h3 = tr_read<v_rd_off(D0, 3, 1)>(vb);
  asm volatile("s_waitcnt lgkmcnt(0)" ::: "memory"); SBAR();
  od = __builtin_amdgcn_mfma_f32_32x32x16_bf16(pa0, ATT_PK(l0, h0), od, 0, 0, 0);
  od = __builtin_amdgcn_mfma_f32_32x32x16_bf16(pa1, ATT_PK(l1, h1), od, 0, 0, 0);
  od = __builtin_amdgcn_mfma_f32_32x32x16_bf16(pa2, ATT_PK(l2, h2), od, 0, 0, 0);
  od = __builtin_amdgcn_mfma_f32_32x32x16_bf16(pa3, ATT_PK(l3, h3), od, 0, 0, 0);
}
__device__ __forceinline__ void pv_d0(f32x16* o, int vb, bf16x8 pa0, bf16x8 pa1, bf16x8 pa2, bf16x8 pa3) {
  pv_one<0>(o[0], vb, pa0, pa1, pa2, pa3); pv_one<1>(o[1], vb, pa0, pa1, pa2, pa3); pv_one<2>(o[2], vb, pa0, pa1, pa2, pa3); pv_one<3>(o[3], vb, pa0, pa1, pa2, pa3);
}
template <int KS> __device__ __forceinline__ void pv_ks(f32x16* o, int vb, bf16x8 pa) {
  const s16x4 l0 = tr_read<v_rd_off(0, KS, 0)>(vb), h0 = tr_read<v_rd_off(0, KS, 1)>(vb), l1 = tr_read<v_rd_off(1, KS, 0)>(vb), h1 = tr_read<v_rd_off(1, KS, 1)>(vb);
  const s16x4 l2 = tr_read<v_rd_off(2, KS, 0)>(vb), h2 = tr_read<v_rd_off(2, KS, 1)>(vb), l3 = tr_read<v_rd_off(3, KS, 0)>(vb), h3 = tr_read<v_rd_off(3, KS, 1)>(vb);
  asm volatile("s_waitcnt lgkmcnt(0)" ::: "memory"); SBAR();
  o[0] = __builtin_amdgcn_mfma_f32_32x32x16_bf16(pa, ATT_PK(l0, h0), o[0], 0, 0, 0);
  o[1] = __builtin_amdgcn_mfma_f32_32x32x16_bf16(pa, ATT_PK(l1, h1), o[1], 0, 0, 0);
  o[2] = __builtin_amdgcn_mfma_f32_32x32x16_bf16(pa, ATT_PK(l2, h2), o[2], 0, 0, 0);
  o[3] = __builtin_amdgcn_mfma_f32_32x32x16_bf16(pa, ATT_PK(l3, h3), o[3], 0, 0, 0);
}
__device__ __forceinline__ void pv_il(f32x16* o, int vb, bf16x8 pa0, bf16x8 pa1, bf16x8 pa2, bf16x8 pa3) {
  pv_ks<0>(o, vb, pa0); pv_ks<1>(o, vb, pa1); pv_ks<2>(o, vb, pa2); pv_ks<3>(o, vb, pa3);
}

template <bool MOBA, int ldq, int ldk, int ldo>
__device__ __forceinline__ void attn_unit(const bf16* __restrict__ Qb, const bf16* __restrict__ Kh, const bf16* __restrict__ Vh, bf16* __restrict__ Ob,
                                          int NT, int b, const float* __restrict__ kmean, char* lds) {
  const int tid = fresh_tid(), wid = tid >> 6, lane = tid & 63, r32 = lane & 31, hi = lane >> 5;
  char* V_lds = lds; char* K_lds = lds + 2 * SHM_V;
  float* ws = (float*)(lds + 2 * SHM_V + 2 * SHM_K) + wid * 64; float* li_l = ws; float* al_l = ws + 32;
  float m_reg = NEG, l_reg = 0; f32x16 o[4] = {}; bf16x8 qr[8];
  const bf16* Qw = Qb + (long)(wid * QBLK + r32) * ldq + hi * 8;
#pragma unroll
  for (int d0 = 0; d0 < 8; ++d0) qr[d0] = ld8(Qw + d0 * 16);
  const int sr = tid >> 4, sc = (tid & 15) * 8, vst0 = v_st(sr, sc), vst1 = v_st(32 + sr, sc);
  const int vb0 = (int)(uintptr_t)V_lds + v_rd_base(lane);
  const int qrow = wid * QBLK + r32;
  unsigned rowmask = 0u;
  if (MOBA) {
    { const float* km = kmean + sr * 128 + sc; const f32x4 a = *(const f32x4*)km, c4 = *(const f32x4*)(km + 4);
      u32x4 w = {cvtpk(a[0], a[1]), cvtpk(a[2], a[3]), cvtpk(c4[0], c4[1]), cvtpk(c4[2], c4[3])};
      *(u32x4*)(K_lds + KSWZ(sr, sc * 2)) = w; }
    __syncthreads();
    f32x16 g = f32x16{};
#pragma unroll
    for (int d0 = 0; d0 < 8; ++d0) { const int cb = (d0 * 16 + hi * 8) * 2;
      bf16x8 b0 = *reinterpret_cast<const bf16x8*>(K_lds + KSWZ(r32, cb));
      g = __builtin_amdgcn_mfma_f32_32x32x16_bf16(b0, qr[d0], g, 0, 0, 0); }
#pragma unroll
    for (int r = 0; r < 16; ++r) g[r] = (crow(r, hi) < b) ? g[r] : -__builtin_inff();
#pragma unroll
    for (int k = 0; k < 3; ++k) {
      float best = -__builtin_inff(); int bi = 99;
#pragma unroll
      for (int r = 0; r < 16; ++r) { const int n = crow(r, hi); const bool t = (g[r] > best) || (g[r] == best && n < bi); best = t ? g[r] : best; bi = t ? n : bi; }
      const float pv = __shfl_xor(best, 32); const int pi = __shfl_xor(bi, 32);
      const bool pt = (pv > best) || (pv == best && pi < bi);
      const int wi = pt ? pi : bi;
      if (k < b) rowmask |= 1u << (wi & 31);
#pragma unroll
      for (int r = 0; r < 16; ++r) g[r] = (crow(r, hi) == wi) ? -__builtin_inff() : g[r];
    }
    __syncthreads();
  }
  const bf16* Kp = Kh + (long)sr * ldk + sc; const bf16* Vp = Vh + (long)sr * ldk + sc;
#define TK0(idx) (MOBA ? ((idx) < 4 ? 256 * b + 64 * (idx) : 64 * ((idx) - 4)) : 64 * (idx))
#define RESC(a) do { if (__any((a) < 1.f)) { if (hi == 0) al_l[r32] = (a); asm volatile("s_waitcnt lgkmcnt(0)" ::: "memory"); \
    _Pragma("unroll") for (int d = 0; d < 4; ++d) _Pragma("unroll") for (int r = 0; r < 16; ++r) o[d][r] *= al_l[crow(r, hi)]; } } while (0)
  if constexpr (MOBA) {
    bf16x8 vs0, vs1, ks0, ks1;
#define SLOAD1(idx) do { const long ko_ = (long)(TK0(idx)) * ldk; vs0 = ld8(Vp + ko_); vs1 = ld8(Vp + ko_ + 32 * ldk); ks0 = ld8(Kp + ko_); ks1 = ld8(Kp + ko_ + 32 * ldk); } while (0)
    SLOAD1(0);
#pragma nounroll
    for (int idx = 0; idx < NT; ++idx) {
      __syncthreads();
      *(bf16x8*)(V_lds + vst0) = vs0; *(bf16x8*)(V_lds + vst1) = vs1; { const int kc = sc * 2; *(bf16x8*)(K_lds + KSWZ(sr, kc)) = ks0; *(bf16x8*)(K_lds + KSWZ(32 + sr, kc)) = ks1; }
      if (idx + 1 < NT) SLOAD1(idx + 1);
      __syncthreads();
      f32x16 p0, p1; float mn, al; bf16x8 pa0, pa1, pa2, pa3;
      qkt<true>(p0, p1, K_lds, qr, r32, hi, moba_lim(idx, qrow, rowmask, hi));
      partialSM(p0, p1, m_reg, mn, al);
      RESC(al);
      finishSM(p0, p1, al, l_reg, pa0, pa1, pa2, pa3); SBAR();
      pv_d0(o, vb0, pa0, pa1, pa2, pa3);
    }
#undef SLOAD1
  } else {
  constexpr int SDEPTH = MOBA ? 1 : 2;
  struct { bf16x8 vs0, vs1, ks0, ks1; } sr_[SDEPTH];
#define SLOAD(i, idx) do { const long ko_ = (long)(TK0(idx)) * ldk; sr_[i].vs0 = ld8(Vp + ko_); sr_[i].vs1 = ld8(Vp + ko_ + 32 * ldk); \
    sr_[i].ks0 = ld8(Kp + ko_); sr_[i].ks1 = ld8(Kp + ko_ + 32 * ldk); } while (0)
#define SWRITE(bb, i) do { *(bf16x8*)(V_lds + (bb) * SHM_V + vst0) = sr_[i].vs0;          \
    *(bf16x8*)(V_lds + (bb) * SHM_V + vst1) = sr_[i].vs1; const int kc = sc * 2;               \
    *(bf16x8*)(K_lds + (bb) * SHM_K + KSWZ(sr, kc)) = sr_[i].ks0;                       \
    *(bf16x8*)(K_lds + (bb) * SHM_K + KSWZ(32 + sr, kc)) = sr_[i].ks1; } while (0)
#define SWAIT() do { if constexpr (SDEPTH == 2) asm volatile("s_waitcnt vmcnt(4)" ::: "memory"); else asm volatile("s_waitcnt vmcnt(0)" ::: "memory"); } while (0)
#define QKT(P0, P1, KS, idx) qkt<MOBA>(P0, P1, KS, qr, r32, hi, MOBA ? moba_lim((idx), qrow, rowmask, hi) : 0)
  f32x16 pA0, pA1, pB0, pB1; float mnA, mnB, alA, alB; bf16x8 pa0, pa1, pa2, pa3;
  constexpr int SE = 0, SO = SDEPTH - 1;
  SLOAD(SE, 0); asm volatile("s_waitcnt vmcnt(0)" ::: "memory"); SWRITE(0, SE); __syncthreads();
  QKT(pA0, pA1, K_lds, 0); partialSM(pA0, pA1, m_reg, mnA, alA);
  SLOAD(SO, 1); if constexpr (SDEPTH == 2) { if (2 < NT) SLOAD(SE, 2); }
  SWAIT(); SWRITE(1, SO); __syncthreads();
  for (int j = 1; j + 1 < NT; j += 2) {
    SBAR(); QKT(pB0, pB1, K_lds + SHM_K, j);
    finishSM(pA0, pA1, alA, l_reg, pa0, pa1, pa2, pa3); SBAR();
    SLOAD(SO, j + SDEPTH); SBAR();
    pv_d0(o, vb0, pa0, pa1, pa2, pa3); partialSM(pB0, pB1, m_reg, mnB, alB);
    __syncthreads(); SWAIT(); SWRITE(0, SE);
    RESC(alB); __syncthreads();
    SBAR(); QKT(pA0, pA1, K_lds, j + 1);
    finishSM(pB0, pB1, alB, l_reg, pa0, pa1, pa2, pa3); SBAR();
    if (SDEPTH == 1 || j + 3 < NT) SLOAD(SE, j + 1 + SDEPTH); SBAR();
    pv_d0(o, vb0 + SHM_V, pa0, pa1, pa2, pa3); partialSM(pA0, pA1, m_reg, mnA, alA);
    __syncthreads(); SWAIT(); SWRITE(1, SO);
    RESC(alA); __syncthreads();
  }
  SBAR(); QKT(pB0, pB1, K_lds + SHM_K, NT - 1);
  finishSM(pA0, pA1, alA, l_reg, pa0, pa1, pa2, pa3); SBAR();
  pv_d0(o, vb0, pa0, pa1, pa2, pa3); partialSM(pB0, pB1, m_reg, mnB, alB);
  __syncthreads(); RESC(alB);
  finishSM(pB0, pB1, alB, l_reg, pa0, pa1, pa2, pa3); SBAR();
  pv_d0(o, vb0 + SHM_V, pa0, pa1, pa2, pa3);
  }
  if (hi == 0) li_l[r32] = l_reg; asm volatile("s_waitcnt lgkmcnt(0)" ::: "memory");
  float rli[16];
#pragma unroll
  for (int r = 0; r < 16; ++r) rli[r] = __builtin_amdgcn_rcpf(li_l[crow(r, hi)]);
  bf16* Ow = Ob + (long)(wid * QBLK) * ldo;
#pragma unroll
  for (int r = 0; r < 16; ++r) { const int orow = crow(r, hi);
#pragma unroll
    for (int d0 = 0; d0 < 4; ++d0) Ow[(long)orow * ldo + d0 * 32 + r32] = (bf16)(cvtpk(o[d0][r] * rli[r], 0.f) & 0xffffu); }
  __syncthreads();
#undef TK0
#undef SLOAD
#undef SWRITE
#undef SWAIT
#undef RESC
#undef QKT
}

__device__ __forceinline__ void moba_gate_unit(const bf16* __restrict__ Qb, const float* __restrict__ kmean, int b, int h, unsigned* __restrict__ ROWMASK, unsigned char* __restrict__ SEG, int* __restrict__ CNT, char* lds) {
  const int tid = fresh_tid(), wid = tid >> 6, lane = tid & 63, r32 = lane & 31, hi = lane >> 5;
  char* K_lds = lds + 2 * SHM_V; int* cw = (int*)(lds + ACS_OFF);
  constexpr int ldq = 5120;
  bf16x8 qr[8];
  const bf16* Qw = Qb + (long)(wid * QBLK + r32) * ldq + hi * 8;
#pragma unroll
  for (int d0 = 0; d0 < 8; ++d0) qr[d0] = ld8(Qw + d0 * 16);
  const int sr = tid >> 4, sc = (tid & 15) * 8;
  unsigned rowmask = 0u;
  { const float* km = kmean + (size_t)sr * 256 + sc;
    const f32x4 a = (*(const f32x4*)km + *(const f32x4*)(km + 128)) * (1.0f / 256.0f), c4 = (*(const f32x4*)(km + 4) + *(const f32x4*)(km + 132)) * (1.0f / 256.0f);
    u32x4 w = {cvtpk(a[0], a[1]), cvtpk(a[2], a[3]), cvtpk(c4[0], c4[1]), cvtpk(c4[2], c4[3])};
    *(u32x4*)(K_lds + KSWZ(sr, sc * 2)) = w; }
  __syncthreads();
  f32x16 g = f32x16{};
#pragma unroll
  for (int d0 = 0; d0 < 8; ++d0) { const int cb = (d0 * 16 + hi * 8) * 2;
    bf16x8 b0 = *reinterpret_cast<const bf16x8*>(K_lds + KSWZ(r32, cb));
    g = __builtin_amdgcn_mfma_f32_32x32x16_bf16(b0, qr[d0], g, 0, 0, 0); }
#pragma unroll
  for (int r = 0; r < 16; ++r) g[r] = (crow(r, hi) < b) ? g[r] : -__builtin_inff();
#pragma unroll
  for (int k = 0; k < 3; ++k) {
    float best = -__builtin_inff(); int bi = 99;
#pragma unroll
    for (int r = 0; r < 16; ++r) { const int n = crow(r, hi); const bool t = (g[r] > best) || (g[r] == best && n < bi); best = t ? g[r] : best; bi = t ? n : bi; }
    const float pv = __shfl_xor(best, 32); const int pi = __shfl_xor(bi, 32);
    const bool pt = (pv > best) || (pv == best && pi < bi);
    const int wi = pt ? pi : bi;
    if (k < b) rowmask |= 1u << (wi & 31);
#pragma unroll
    for (int r = 0; r < 16; ++r) g[r] = (crow(r, hi) == wi) ? -__builtin_inff() : g[r];
  }
  if (hi == 0) ROWMASK[(size_t)(256 * b + wid * QBLK + r32) * 12 + h] = rowmask;
  int mycnt = 0;
  for (int j = 0; j < b; ++j) { const unsigned long long bal = __ballot(((rowmask >> j) & 1u) && hi == 0); const int c = __popcll(bal); if (lane == j) mycnt = c; }
  if (lane < 32) cw[wid * 32 + lane] = mycnt;
  __syncthreads();
  int off = 0, tot = 0;
  if (lane < 32) {
#pragma unroll
    for (int w = 0; w < 8; ++w) { const int c = cw[w * 32 + lane]; off += (w < wid) ? c : 0; tot += c; } }
  if (wid == 0 && lane < b) CNT[(h * 32 + lane) * 32 + b] = tot;
  for (int j = 0; j < b; ++j) { const bool bit = ((rowmask >> j) & 1u) && hi == 0; const unsigned long long bal = __ballot(bit); const int base = __shfl(off, j);
    if (bit) { const int rank = __popcll(bal & ((1ull << lane) - 1ull)); SEG[((size_t)(h * 32 + j) * 32 + b) * 256 + base + rank] = (unsigned char)(wid * QBLK + r32); } }
  __syncthreads();
}
template <bool OWN>
__device__ __forceinline__ void attn_part_unit(const bf16* __restrict__ Qw, const bf16* __restrict__ Kh, const bf16* __restrict__ Vh, int dst, bf16* __restrict__ PARTO, float* __restrict__ PARTML, char* lds) {
  constexpr int ldk = 5120, NT = 4;
  const int tid = fresh_tid(), wid = tid >> 6, lane = tid & 63, r32 = lane & 31, hi = lane >> 5;
  char* V_lds = lds; char* K_lds = lds + 2 * SHM_V;
  float* ws = (float*)(lds + 2 * SHM_V + 2 * SHM_K) + wid * 64; float* li_l = ws; float* al_l = ws + 32; int* dst_l = (int*)(lds + ACS_OFF) + wid * 32;
  float m_reg = NEG, l_reg = 0; f32x16 o[4] = {}; bf16x8 qr[8];
#pragma unroll
  for (int d0 = 0; d0 < 8; ++d0) qr[d0] = ld8(Qw + d0 * 16);
  const int sr = tid >> 4, sc = (tid & 15) * 8, vst0 = v_st(sr, sc), vst1 = v_st(32 + sr, sc);
  const int vb0 = (int)(uintptr_t)V_lds + v_rd_base(lane);
  const int qrow = wid * QBLK + r32;
  const bf16* Kp = Kh + (long)sr * ldk + sc; const bf16* Vp = Vh + (long)sr * ldk + sc;
#define RESC(a) do { if (__any((a) < 1.f)) { if (hi == 0) al_l[r32] = (a); asm volatile("s_waitcnt lgkmcnt(0)" ::: "memory"); \
    _Pragma("unroll") for (int d = 0; d < 4; ++d) _Pragma("unroll") for (int r = 0; r < 16; ++r) o[d][r] *= al_l[crow(r, hi)]; } } while (0)
  if constexpr (OWN) {
    bf16x8 vs0, vs1, ks0, ks1;
#define SLOAD1(idx) do { const long ko_ = (long)(64 * (idx)) * ldk; vs0 = ld8(Vp + ko_); vs1 = ld8(Vp + ko_ + 32 * ldk); ks0 = ld8(Kp + ko_); ks1 = ld8(Kp + ko_ + 32 * ldk); } while (0)
    SLOAD1(0);
#pragma nounroll
    for (int idx = 0; idx < NT; ++idx) {
      __syncthreads();
      *(bf16x8*)(V_lds + vst0) = vs0; *(bf16x8*)(V_lds + vst1) = vs1; { const int kc = sc * 2; *(bf16x8*)(K_lds + KSWZ(sr, kc)) = ks0; *(bf16x8*)(K_lds + KSWZ(32 + sr, kc)) = ks1; }
      if (idx + 1 < NT) SLOAD1(idx + 1);
      __syncthreads();
      f32x16 p0, p1; float mn, al; bf16x8 pa0, pa1, pa2, pa3;
      qkt<true>(p0, p1, K_lds, qr, r32, hi, qrow - 64 * idx - 4 * hi);
      partialSM(p0, p1, m_reg, mn, al);
      RESC(al);
      finishSM(p0, p1, al, l_reg, pa0, pa1, pa2, pa3); SBAR();
      pv_d0(o, vb0, pa0, pa1, pa2, pa3);
    }
#undef SLOAD1
  } else {
    struct { bf16x8 vs0, vs1, ks0, ks1; } sr_[2];
#define SLOAD(i, idx) do { const long ko_ = (long)(64 * (idx)) * ldk; sr_[i].vs0 = ld8(Vp + ko_); sr_[i].vs1 = ld8(Vp + ko_ + 32 * ldk); \
    sr_[i].ks0 = ld8(Kp + ko_); sr_[i].ks1 = ld8(Kp + ko_ + 32 * ldk); } while (0)
#define SWRITE(bb, i) do { *(bf16x8*)(V_lds + (bb) * SHM_V + vst0) = sr_[i].vs0;          \
    *(bf16x8*)(V_lds + (bb) * SHM_V + vst1) = sr_[i].vs1; const int kc = sc * 2;               \
    *(bf16x8*)(K_lds + (bb) * SHM_K + KSWZ(sr, kc)) = sr_[i].ks0;                       \
    *(bf16x8*)(K_lds + (bb) * SHM_K + KSWZ(32 + sr, kc)) = sr_[i].ks1; } while (0)
#define SWAIT() asm volatile("s_waitcnt vmcnt(4)" ::: "memory")
    f32x16 pA0, pA1, pB0, pB1; float mnA, mnB, alA, alB; bf16x8 pa0, pa1, pa2, pa3;
    SLOAD(0, 0); asm volatile("s_waitcnt vmcnt(0)" ::: "memory"); SWRITE(0, 0); __syncthreads();
    qkt<false>(pA0, pA1, K_lds, qr, r32, hi); partialSM(pA0, pA1, m_reg, mnA, alA);
    SLOAD(1, 1); SLOAD(0, 2);
    SWAIT(); SWRITE(1, 1); __syncthreads();
    SBAR(); qkt<false>(pB0, pB1, K_lds + SHM_K, qr, r32, hi);
    finishSM(pA0, pA1, alA, l_reg, pa0, pa1, pa2, pa3); SBAR();
    SLOAD(1, 3); SBAR();
    pv_d0(o, vb0, pa0, pa1, pa2, pa3); partialSM(pB0, pB1, m_reg, mnB, alB);
    __syncthreads(); SWAIT(); SWRITE(0, 0);
    RESC(alB); __syncthreads();
    SBAR(); qkt<false>(pA0, pA1, K_lds, qr, r32, hi);
    finishSM(pB0, pB1, alB, l_reg, pa0, pa1, pa2, pa3); SBAR();
    pv_d0(o, vb0 + SHM_V, pa0, pa1, pa2, pa3); partialSM(pA0, pA1, m_reg, mnA, alA);
    __syncthreads(); asm volatile("s_waitcnt vmcnt(0)" ::: "memory"); SWRITE(1, 1);
    RESC(alA); __syncthreads();
    SBAR(); qkt<false>(pB0, pB1, K_lds + SHM_K, qr, r32, hi);
    finishSM(pA0, pA1, alA, l_reg, pa0, pa1, pa2, pa3); SBAR();
    pv_d0(o, vb0, pa0, pa1, pa2, pa3); partialSM(pB0, pB1, m_reg, mnB, alB);
    __syncthreads(); RESC(alB);
    finishSM(pB0, pB1, alB, l_reg, pa0, pa1, pa2, pa3); SBAR();
    pv_d0(o, vb0 + SHM_V, pa0, pa1, pa2, pa3);
#undef SLOAD
#undef SWRITE
#undef SWAIT
  }
#undef RESC
  if (hi == 0) { li_l[r32] = l_reg; dst_l[r32] = dst; if (dst >= 0) { PARTML[2 * (size_t)dst] = m_reg; PARTML[2 * (size_t)dst + 1] = l_reg; } }
  asm volatile("s_waitcnt lgkmcnt(0)" ::: "memory");
#pragma unroll
  for (int r = 0; r < 16; ++r) { const int row = crow(r, hi); const int d = dst_l[row]; const float rl = __builtin_amdgcn_rcpf(li_l[row]);
    if (d >= 0) { bf16* op = PARTO + (size_t)d * 128 + r32;
#pragma unroll
      for (int d0 = 0; d0 < 4; ++d0) op[d0 * 32] = (bf16)(cvtpk(o[d0][r] * rl, 0.f) & 0xffffu); } }
  __syncthreads();
}

__device__ __forceinline__ void moba_kv_item(const bf16* __restrict__ QKVM, int h, int j, int row0, int rowend, const int* segp, const unsigned* __restrict__ ROWMASK, const unsigned char* __restrict__ SEG,
                                             bf16* __restrict__ PARTO, float* __restrict__ PARTML, char* lds, char* scr) {
  constexpr int ld = 5120;
  const int tid = fresh_tid(), wid = tid >> 6, lane = tid & 63, r32 = lane & 31, hi = lane >> 5;
  char* V_lds = lds; char* K_lds = lds + 4 * SHM_V;
  float* ws = (float*)scr + wid * 64; float* li_l = ws; float* al_l = ws + 32; int* dst_l = (int*)(scr + 2048) + wid * 32;
  {
    const int sr = tid >> 4, sc = (tid & 15) * 8, vst0 = v_st(sr, sc), vst1 = v_st(32 + sr, sc);
    const bf16* Kp = QKVM + (size_t)(256 * j + sr) * ld + 1536 + h * 128 + sc; const bf16* Vp = Kp + 1536;
    bf16x8 kv[16];
#pragma unroll
    for (int i = 0; i < 4; ++i) { kv[4 * i] = ld8(Kp + (size_t)(64 * i) * ld); kv[4 * i + 1] = ld8(Kp + (size_t)(64 * i + 32) * ld); kv[4 * i + 2] = ld8(Vp + (size_t)(64 * i) * ld); kv[4 * i + 3] = ld8(Vp + (size_t)(64 * i + 32) * ld); }
#pragma unroll
    for (int i = 0; i < 4; ++i) { const int kc = sc * 2;
      *(bf16x8*)(K_lds + i * SHM_K + KSWZ(sr, kc)) = kv[4 * i]; *(bf16x8*)(K_lds + i * SHM_K + KSWZ(32 + sr, kc)) = kv[4 * i + 1];
      *(bf16x8*)(V_lds + i * SHM_V + vst0) = kv[4 * i + 2]; *(bf16x8*)(V_lds + i * SHM_V + vst1) = kv[4 * i + 3]; } }
  __syncthreads();
  const int vb0 = (int)(uintptr_t)V_lds + v_rd_base(lane);
  const int nwu = (rowend - row0 + 31) >> 5;
#pragma nounroll
  for (int wu = wid; wu < nwu; wu += NW) {
    const int r = row0 + wu * 32 + r32; const bool own = r < 256; const bool valid = r < rowend;
    int t, dst;
    if (own) { t = 256 * j + r; dst = (t * 12 + h) * 4 + 3; }
    else { const int rg = valid ? r - 256 : 0; int b = j + 1; while (b < 31 && rg >= segp[b + 1]) ++b;
      t = 256 * b + SEG[((size_t)(h * 32 + j) * 32 + b) * 256 + (rg - segp[b])];
      const unsigned rm = ROWMASK[(size_t)t * 12 + h]; dst = valid ? (t * 12 + h) * 4 + __popc(rm & ((1u << j) - 1u)) : -1; }
    bf16x8 qr[8];
    { const bf16* Qw = QKVM + (size_t)t * ld + h * 128 + hi * 8;
#pragma unroll
      for (int d0 = 0; d0 < 8; ++d0) qr[d0] = ld8(Qw + d0 * 16); }
    float m_reg = NEG, l_reg = 0; f32x16 o[4] = {};
    const int limbase = own ? (r - 4 * hi) : 4096;
    const int ntl = own ? ((row0 + wu * 32 + 31) >> 6) + 1 : 4;
#pragma nounroll
    for (int idx = 0; idx < ntl; ++idx) {
      f32x16 p0, p1; float mn, al; bf16x8 pa0, pa1, pa2, pa3;
      qkt<true>(p0, p1, K_lds + idx * SHM_K, qr, r32, hi, limbase - 64 * idx);
      partialSM(p0, p1, m_reg, mn, al);
      if (__any(al < 1.f)) { if (hi == 0) al_l[r32] = al; asm volatile("s_waitcnt lgkmcnt(0)" ::: "memory");
#pragma unroll
        for (int d = 0; d < 4; ++d)
#pragma unroll
          for (int rr = 0; rr < 16; ++rr) o[d][rr] *= al_l[crow(rr, hi)]; }
      finishSM(p0, p1, al, l_reg, pa0, pa1, pa2, pa3); SBAR();
      pv_il(o, vb0 + idx * SHM_V, pa0, pa1, pa2, pa3);
    }
    if (hi == 0) { li_l[r32] = l_reg; dst_l[r32] = dst; if (dst >= 0) { PARTML[2 * (size_t)dst] = m_reg; PARTML[2 * (size_t)dst + 1] = l_reg; } }
    asm volatile("s_waitcnt lgkmcnt(0)" ::: "memory");
#pragma unroll
    for (int rr = 0; rr < 16; ++rr) { const int row = crow(rr, hi); const int d = dst_l[row]; const float rl = __builtin_amdgcn_rcpf(li_l[row]);
      if (d >= 0) { bf16* op = PARTO + (size_t)d * 128 + r32;
#pragma unroll
        for (int d0 = 0; d0 < 4; ++d0) op[d0 * 32] = (bf16)(cvtpk(o[d0][rr] * rl, 0.f) & 0xffffu); } }
    asm volatile("s_waitcnt lgkmcnt(0)" ::: "memory");
  }
  __syncthreads();
}
constexpr int CVP = 4096, CV_B = 1536, CV_C = 2048, CV_XDT = 2560;
constexpr float LOG2E = 1.4426950408889634f;
__device__ __forceinline__ void ssd_state_unit(const bf16* __restrict__ CV, const float* __restrict__ ACS, float* __restrict__ STATES, int c, int h, char* lds) {
  const int tid = fresh_tid(), wid = tid >> 6, lane = tid & 63, r32 = lane & 31, hi = lane >> 5;
  const int g = h / 6; const long t0 = 256L * c;
  char* X_lds = lds; char* B_lds = lds + SHM_V; float* acs_lds = (float*)(lds + ACS_OFF);
  if (tid < 256) acs_lds[tid] = ACS[(c * 24 + h) * 256 + tid];
  const int sr = tid >> 4, sc = (tid & 15) * 8, vst0 = v_st(sr, sc), vst1 = v_st(32 + sr, sc);
  const int pb = wid & 1, nb = wid >> 1;
  const int xb = (int)(uintptr_t)X_lds + v_rd_base(lane) + pb * 512, bb = (int)(uintptr_t)B_lds + v_rd_base(lane) + nb * 512;
  bf16x8 xv0 = {}, xv1 = {}, kb0, kb1;
#define SLOAD(i) do { const bf16* rp = CV + (t0 + 64 * (i) + sr) * CVP; kb0 = ld8(rp + CV_B + g * 128 + sc); kb1 = ld8(rp + 32 * CVP + CV_B + g * 128 + sc); \
    if (sc < 64) { xv0 = ld8(rp + CV_XDT + h * 64 + sc); xv1 = ld8(rp + 32 * CVP + CV_XDT + h * 64 + sc); } } while (0)
  SLOAD(0);
  f32x16 acc = f32x16{};
#pragma nounroll
  for (int i = 0; i < 4; ++i) {
    __syncthreads();
    const float aend = acs_lds[255];
    if (sc < 64) {
      const float f0 = __builtin_amdgcn_exp2f((aend - acs_lds[64 * i + sr]) * LOG2E), f1 = __builtin_amdgcn_exp2f((aend - acs_lds[64 * i + 32 + sr]) * LOG2E);
      u32x4 w0, w1;
#pragma unroll
      for (int q = 0; q < 4; ++q) { w0[q] = cvtpk(bf2f((unsigned short)xv0[2 * q]) * f0, bf2f((unsigned short)xv0[2 * q + 1]) * f0);
                                    w1[q] = cvtpk(bf2f((unsigned short)xv1[2 * q]) * f1, bf2f((unsigned short)xv1[2 * q + 1]) * f1); }
      *(u32x4*)(X_lds + vst0) = w0; *(u32x4*)(X_lds + vst1) = w1;
    }
    *(bf16x8*)(B_lds + vst0) = kb0; *(bf16x8*)(B_lds + vst1) = kb1;
    if (i < 3) SLOAD(i + 1);
    __syncthreads();
    { const s16x4 al0 = tr_read<v_rd_off(0, 0, 0)>(xb), ah0 = tr_read<v_rd_off(0, 0, 1)>(xb), al1 = tr_read<v_rd_off(0, 1, 0)>(xb), ah1 = tr_read<v_rd_off(0, 1, 1)>(xb);
      const s16x4 al2 = tr_read<v_rd_off(0, 2, 0)>(xb), ah2 = tr_read<v_rd_off(0, 2, 1)>(xb), al3 = tr_read<v_rd_off(0, 3, 0)>(xb), ah3 = tr_read<v_rd_off(0, 3, 1)>(xb);
      const s16x4 bl0 = tr_read<v_rd_off(0, 0, 0)>(bb), bh0 = tr_read<v_rd_off(0, 0, 1)>(bb), bl1 = tr_read<v_rd_off(0, 1, 0)>(bb), bh1 = tr_read<v_rd_off(0, 1, 1)>(bb);
      const s16x4 bl2 = tr_read<v_rd_off(0, 2, 0)>(bb), bh2 = tr_read<v_rd_off(0, 2, 1)>(bb), bl3 = tr_read<v_rd_off(0, 3, 0)>(bb), bh3 = tr_read<v_rd_off(0, 3, 1)>(bb);
      asm volatile("s_waitcnt lgkmcnt(0)" ::: "memory"); SBAR();
      acc = __builtin_amdgcn_mfma_f32_32x32x16_bf16(ATT_PK(al0, ah0), ATT_PK(bl0, bh0), acc, 0, 0, 0);
      acc = __builtin_amdgcn_mfma_f32_32x32x16_bf16(ATT_PK(al1, ah1), ATT_PK(bl1, bh1), acc, 0, 0, 0);
      acc = __builtin_amdgcn_mfma_f32_32x32x16_bf16(ATT_PK(al2, ah2), ATT_PK(bl2, bh2), acc, 0, 0, 0);
      acc = __builtin_amdgcn_mfma_f32_32x32x16_bf16(ATT_PK(al3, ah3), ATT_PK(bl3, bh3), acc, 0, 0, 0); }
  }
#undef SLOAD
  float* Sp = STATES + ((long)(c * 24 + h) * 64 + 32 * pb) * 128 + 32 * nb + r32;
#pragma unroll
  for (int r = 0; r < 16; ++r) Sp[crow(r, hi) * 128] = acc[r];
  __syncthreads();
}
__device__ __forceinline__ void ssd_y_unit(const bf16* __restrict__ CV, const float* __restrict__ ACS, const bf16* __restrict__ PREV, float dsk, float* __restrict__ YS, int c, int h, char* lds) {
  const int tid = fresh_tid(), wid = tid >> 6, lane = tid & 63, r32 = lane & 31, hi = lane >> 5;
  const int g = h / 6; const long t0 = 256L * c;
  char* V_lds = lds; char* K_lds = lds + 2 * SHM_V; float* acs_lds = (float*)(lds + ACS_OFF);
  if (tid < 256) acs_lds[tid] = ACS[(c * 24 + h) * 256 + tid];
  const int lrow = wid * 32 + r32;
  const float acs_l = ACS[(c * 24 + h) * 256 + lrow];
  bf16x8 qr[8];
  { const bf16* Qw = CV + (t0 + lrow) * CVP + CV_C + g * 128 + hi * 8;
#pragma unroll
    for (int d0 = 0; d0 < 8; ++d0) qr[d0] = ld8(Qw + d0 * 16); }
  const int sr = tid >> 4, sc = (tid & 15) * 8, vst0 = v_st(sr, sc), vst1 = v_st(32 + sr, sc);
  const int vb0 = (int)(uintptr_t)V_lds + v_rd_base(lane);
  bf16x8 xv0 = {}, xv1 = {}, kb0, kb1;
#define SLOAD(i) do { const bf16* rp = CV + (t0 + 64 * (i) + sr) * CVP; kb0 = ld8(rp + CV_B + g * 128 + sc); kb1 = ld8(rp + 32 * CVP + CV_B + g * 128 + sc); \
    if (sc < 64) { xv0 = ld8(rp + CV_XDT + h * 64 + sc); xv1 = ld8(rp + 32 * CVP + CV_XDT + h * 64 + sc); } } while (0)
  SLOAD(0);
  f32x16 o[2] = {};
#pragma nounroll
  for (int i = 0; i < 4; ++i) {
    __syncthreads();
    { const int kc = sc * 2; *(bf16x8*)(K_lds + KSWZ(sr, kc)) = kb0; *(bf16x8*)(K_lds + KSWZ(32 + sr, kc)) = kb1; }
    if (sc < 64) { *(bf16x8*)(V_lds + vst0) = xv0; *(bf16x8*)(V_lds + vst1) = xv1; }
    if (i < 3) SLOAD(i + 1);
    __syncthreads();
    if (64 * i <= wid * 32 + 31) {
      f32x16 p0, p1; qkt<false>(p0, p1, K_lds, qr, r32, hi);
#pragma unroll
      for (int r = 0; r < 16; ++r) { const int s = 64 * i + crow(r, hi);
        const float e0 = __builtin_amdgcn_exp2f((acs_l - acs_lds[s]) * LOG2E), e1 = __builtin_amdgcn_exp2f((acs_l - acs_lds[s + 32]) * LOG2E);
        p0[r] = (s <= lrow) ? p0[r] * e0 : 0.f; p1[r] = (s + 32 <= lrow) ? p1[r] * e1 : 0.f; }
      bf16x8 pa0, pa1, pa2, pa3;
      ATT_PK4(p0, 0, pa0); ATT_PK4(p0, 8, pa1); ATT_PK4(p1, 0, pa2); ATT_PK4(p1, 8, pa3);
      pv_one<0>(o[0], vb0, pa0, pa1, pa2, pa3); pv_one<1>(o[1], vb0, pa0, pa1, pa2, pa3);
    }
  }
#undef SLOAD
  f32x16 o2[2] = {};
  { const bf16* Pp = PREV + ((long)(c * 24 + h) * 64 + r32) * 128 + hi * 8;
#pragma unroll
    for (int d0 = 0; d0 < 2; ++d0)
#pragma unroll
      for (int d = 0; d < 8; ++d) { const bf16x8 bfrag = ld8(Pp + d0 * 32 * 128 + d * 16);
        o2[d0] = __builtin_amdgcn_mfma_f32_32x32x16_bf16(qr[d], bfrag, o2[d0], 0, 0, 0); } }
  { const bf16* xp0 = CV + (t0 + wid * 32 + 4 * hi) * CVP + h * 64 + r32; float* yp0 = YS + (t0 + wid * 32 + 4 * hi) * 1536 + h * 64 + r32; const float* ap = acs_lds + wid * 32 + 4 * hi;
#pragma unroll
  for (int r = 0; r < 16; ++r) { const int ro = (r & 3) + 8 * (r >> 2); const float ea = __builtin_amdgcn_exp2f(ap[ro] * LOG2E);
    asm volatile("" ::: "memory");
#pragma unroll
    for (int d0 = 0; d0 < 2; ++d0) yp0[ro * 1536 + d0 * 32] = o[d0][r] + o2[d0][r] * ea + dsk * bf2f(xp0[ro * CVP + d0 * 32]); } }
  __syncthreads();
}
__device__ __forceinline__ void ssd_state_unit2(const bf16* __restrict__ CV, const float* __restrict__ ACS, float* __restrict__ STATES, int c, int h, char* lds, float* acs_lds) {
  const int tid = fresh_tid(), wid = tid >> 6, lane = tid & 63, r32 = lane & 31, hi = lane >> 5;
  const int g = h / 6; const long t0 = 256L * c;
  char* X_lds = lds; char* B_lds = lds + 4 * SHM_V;
  const float* acs_g = ACS + (c * 24 + h) * 256;
  const int sr = tid >> 4, sc = (tid & 15) * 8, vst0 = v_st(sr, sc), vst1 = v_st(32 + sr, sc);
  const int pb = wid & 1, nb = wid >> 1;
  const int xb = (int)(uintptr_t)X_lds + v_rd_base(lane) + pb * 512, bb = (int)(uintptr_t)B_lds + v_rd_base(lane) + nb * 512;
  { bf16x8 kb[8], xv[8]; const float aend = acs_g[255]; float f[8];
    const bf16* rp = CV + (t0 + sr) * CVP;
#pragma unroll
    for (int i = 0; i < 4; ++i) { kb[2 * i] = ld8(rp + (size_t)(64 * i) * CVP + CV_B + g * 128 + sc); kb[2 * i + 1] = ld8(rp + (size_t)(64 * i + 32) * CVP + CV_B + g * 128 + sc);
      if (sc < 64) { xv[2 * i] = ld8(rp + (size_t)(64 * i) * CVP + CV_XDT + h * 64 + sc); xv[2 * i + 1] = ld8(rp + (size_t)(64 * i + 32) * CVP + CV_XDT + h * 64 + sc);
        f[2 * i] = __builtin_amdgcn_exp2f((aend - acs_g[64 * i + sr]) * LOG2E); f[2 * i + 1] = __builtin_amdgcn_exp2f((aend - acs_g[64 * i + 32 + sr]) * LOG2E); } }
#pragma unroll
    for (int i = 0; i < 4; ++i) {
      *(bf16x8*)(B_lds + i * SHM_V + vst0) = kb[2 * i]; *(bf16x8*)(B_lds + i * SHM_V + vst1) = kb[2 * i + 1];
      if (sc < 64) { u32x4 w0, w1;
#pragma unroll
        for (int q = 0; q < 4; ++q) { w0[q] = cvtpk(bf2f((unsigned short)xv[2 * i][2 * q]) * f[2 * i], bf2f((unsigned short)xv[2 * i][2 * q + 1]) * f[2 * i]);
                                      w1[q] = cvtpk(bf2f((unsigned short)xv[2 * i + 1][2 * q]) * f[2 * i + 1], bf2f((unsigned short)xv[2 * i + 1][2 * q + 1]) * f[2 * i + 1]); }
        *(u32x4*)(X_lds + i * SHM_V + vst0) = w0; *(u32x4*)(X_lds + i * SHM_V + vst1) = w1; } } }
  __syncthreads();
  f32x16 acc = f32x16{};
#pragma unroll
  for (int i = 0; i < 4; ++i) {
    const int xo = xb + i * SHM_V, bo = bb + i * SHM_V;
    const s16x4 al0 = tr_read<v_rd_off(0, 0, 0)>(xo), ah0 = tr_read<v_rd_off(0, 0, 1)>(xo), al1 = tr_read<v_rd_off(0, 1, 0)>(xo), ah1 = tr_read<v_rd_off(0, 1, 1)>(xo);
    const s16x4 al2 = tr_read<v_rd_off(0, 2, 0)>(xo), ah2 = tr_read<v_rd_off(0, 2, 1)>(xo), al3 = tr_read<v_rd_off(0, 3, 0)>(xo), ah3 = tr_read<v_rd_off(0, 3, 1)>(xo);
    const s16x4 bl0 = tr_read<v_rd_off(0, 0, 0)>(bo), bh0 = tr_read<v_rd_off(0, 0, 1)>(bo), bl1 = tr_read<v_rd_off(0, 1, 0)>(bo), bh1 = tr_read<v_rd_off(0, 1, 1)>(bo);
    const s16x4 bl2 = tr_read<v_rd_off(0, 2, 0)>(bo), bh2 = tr_read<v_rd_off(0, 2, 1)>(bo), bl3 = tr_read<v_rd_off(0, 3, 0)>(bo), bh3 = tr_read<v_rd_off(0, 3, 1)>(bo);
    asm volatile("s_waitcnt lgkmcnt(0)" ::: "memory"); SBAR();
    acc = __builtin_amdgcn_mfma_f32_32x32x16_bf16(ATT_PK(al0, ah0), ATT_PK(bl0, bh0), acc, 0, 0, 0);
    acc = __builtin_amdgcn_mfma_f32_32x32x16_bf16(ATT_PK(al1, ah1), ATT_PK(bl1, bh1), acc, 0, 0, 0);
    acc = __builtin_amdgcn_mfma_f32_32x32x16_bf16(ATT_PK(al2, ah2), ATT_PK(bl2, bh2), acc, 0, 0, 0);
    acc = __builtin_amdgcn_mfma_f32_32x32x16_bf16(ATT_PK(al3, ah3), ATT_PK(bl3, bh3), acc, 0, 0, 0);
  }
  float* Sp = STATES + ((long)(c * 24 + h) * 64 + 32 * pb) * 128 + 32 * nb + r32;
#pragma unroll
  for (int r = 0; r < 16; ++r) Sp[crow(r, hi) * 128] = acc[r];
  __syncthreads();
}
__device__ __forceinline__ void ssd_y_unit2(const bf16* __restrict__ CV, const float* __restrict__ ACS, const bf16* __restrict__ PREV, float dsk, float* __restrict__ YS, int c, int h, char* lds, float* acs_lds) {
  const int tid = fresh_tid(), wid = tid >> 6, lane = tid & 63, r32 = lane & 31, hi = lane >> 5;
  const int g = h / 6; const long t0 = 256L * c;
  char* V_lds = lds; char* K_lds = lds + 4 * SHM_V;
  if (tid < 256) acs_lds[tid] = ACS[(c * 24 + h) * 256 + tid];
  const int lrow = wid * 32 + r32;
  const float acs_l = ACS[(c * 24 + h) * 256 + lrow];
  bf16x8 qr[8];
  { const bf16* Qw = CV + (t0 + lrow) * CVP + CV_C + g * 128 + hi * 8;
#pragma unroll
    for (int d0 = 0; d0 < 8; ++d0) qr[d0] = ld8(Qw + d0 * 16); }
  { const int sr = tid >> 4, sc = (tid & 15) * 8, vst0 = v_st(sr, sc), vst1 = v_st(32 + sr, sc);
    bf16x8 kb[8], xv[8]; const bf16* rp = CV + (t0 + sr) * CVP;
#pragma unroll
    for (int i = 0; i < 4; ++i) { kb[2 * i] = ld8(rp + (size_t)(64 * i) * CVP + CV_B + g * 128 + sc); kb[2 * i + 1] = ld8(rp + (size_t)(64 * i + 32) * CVP + CV_B + g * 128 + sc);
      if (sc < 64) { xv[2 * i] = ld8(rp + (size_t)(64 * i) * CVP + CV_XDT + h * 64 + sc); xv[2 * i + 1] = ld8(rp + (size_t)(64 * i + 32) * CVP + CV_XDT + h * 64 + sc); } }
#pragma unroll
    for (int i = 0; i < 4; ++i) { const int kc = sc * 2;
      *(bf16x8*)(K_lds + i * SHM_K + KSWZ(sr, kc)) = kb[2 * i]; *(bf16x8*)(K_lds + i * SHM_K + KSWZ(32 + sr, kc)) = kb[2 * i + 1];
      if (sc < 64) { *(bf16x8*)(V_lds + i * SHM_V + vst0) = xv[2 * i]; *(bf16x8*)(V_lds + i * SHM_V + vst1) = xv[2 * i + 1]; } } }
  __syncthreads();
  const int vb0 = (int)(uintptr_t)V_lds + v_rd_base(lane);
  f32x16 o[2] = {};
  const int ntile = (wid * 32 + 31) / 64 + 1;
#pragma nounroll
  for (int i = 0; i < ntile; ++i) {
    f32x16 p0, p1; qkt<false>(p0, p1, K_lds + i * SHM_K, qr, r32, hi);
#pragma unroll
    for (int r = 0; r < 16; ++r) { const int s = 64 * i + crow(r, hi);
      const float e0 = __builtin_amdgcn_exp2f((acs_l - acs_lds[s]) * LOG2E), e1 = __builtin_amdgcn_exp2f((acs_l - acs_lds[s + 32]) * LOG2E);
      p0[r] = (s <= lrow) ? p0[r] * e0 : 0.f; p1[r] = (s + 32 <= lrow) ? p1[r] * e1 : 0.f; }
    bf16x8 pa0, pa1, pa2, pa3;
    ATT_PK4(p0, 0, pa0); ATT_PK4(p0, 8, pa1); ATT_PK4(p1, 0, pa2); ATT_PK4(p1, 8, pa3);
    pv_one<0>(o[0], vb0 + i * SHM_V, pa0, pa1, pa2, pa3); pv_one<1>(o[1], vb0 + i * SHM_V, pa0, pa1, pa2, pa3);
  }
  f32x16 o2[2] = {};
  { const bf16* Pp = PREV + ((long)(c * 24 + h) * 64 + r32) * 128 + hi * 8;
#pragma unroll
    for (int d0 = 0; d0 < 2; ++d0)
#pragma unroll
      for (int d = 0; d < 8; ++d) { const bf16x8 bfrag = ld8(Pp + d0 * 32 * 128 + d * 16);
        o2[d0] = __builtin_amdgcn_mfma_f32_32x32x16_bf16(qr[d], bfrag, o2[d0], 0, 0, 0); } }
  { const bf16* xp0 = CV + (t0 + wid * 32 + 4 * hi) * CVP + h * 64 + r32; float* yp0 = YS + (t0 + wid * 32 + 4 * hi) * 1536 + h * 64 + r32; const float* ap = acs_lds + wid * 32 + 4 * hi;
  unsigned short xs0[16], xs1[16];
#pragma unroll
  for (int r = 0; r < 16; ++r) { const int ro = (r & 3) + 8 * (r >> 2); xs0[r] = xp0[ro * CVP]; xs1[r] = xp0[ro * CVP + 32]; }
#pragma unroll
  for (int r = 0; r < 16; ++r) { const int ro = (r & 3) + 8 * (r >> 2); const float ea = __builtin_amdgcn_exp2f(ap[ro] * LOG2E);
    yp0[ro * 1536] = o[0][r] + o2[0][r] * ea + dsk * bf2f(xs0[r]); yp0[ro * 1536 + 32] = o[1][r] + o2[1][r] * ea + dsk * bf2f(xs1[r]); } }
  __syncthreads();
}
__device__ __forceinline__ void ssd_y_units(const bf16* __restrict__ CV, const float* __restrict__ ACS, const bf16* __restrict__ PREV, const float* __restrict__ dskp, float* __restrict__ YS,
                                            int u0, int ustep, char* lds, float* acs_lds) {
  const int tid = fresh_tid(), wid = tid >> 6, lane = tid & 63, r32 = lane & 31, hi = lane >> 5;
  char* V_lds = lds; char* K_lds = lds + 4 * SHM_V;
  const int lrow = wid * 32 + r32;
  const int sr = tid >> 4, sc = (tid & 15) * 8, vst0 = v_st(sr, sc), vst1 = v_st(32 + sr, sc);
  const int vb0 = (int)(uintptr_t)V_lds + v_rd_base(lane);
  const int ntile = (wid * 32 + 31) / 64 + 1;
  const int sr2 = tid >> 3, sc2 = (tid & 7) * 8, vst2 = v_st(sr2, sc2);
  bf16x8 kbn[8], xvn[4], qn[8]; float acsn = 0.f, acsln = 0.f;
#define YU_LOAD(u_) do { const int c_ = (u_) / 24, h_ = (u_) % 24, g_ = h_ / 6; const long t0_ = 256L * c_; const bf16* rp_ = CV + (t0_ + sr) * CVP; \
    _Pragma("unroll") for (int i = 0; i < 4; ++i) { kbn[2 * i] = ld8(rp_ + (size_t)(64 * i) * CVP + CV_B + g_ * 128 + sc); kbn[2 * i + 1] = ld8(rp_ + (size_t)(64 * i + 32) * CVP + CV_B + g_ * 128 + sc); \
      xvn[i] = ld8(CV + (t0_ + 64 * i + sr2) * CVP + CV_XDT + h_ * 64 + sc2); } \
    { const bf16* Qw_ = CV + (t0_ + lrow) * CVP + CV_C + g_ * 128 + hi * 8; _Pragma("unroll") for (int d0 = 0; d0 < 8; ++d0) qn[d0] = ld8(Qw_ + d0 * 16); } \
    acsn = ACS[(c_ * 24 + h_) * 256 + (tid & 255)]; acsln = ACS[(c_ * 24 + h_) * 256 + lrow]; } while (0)
  if (u0 < 768) YU_LOAD(u0);
#pragma nounroll
  for (int u = u0; u < 768; u += ustep) {
    const int c = u / 24, h = u % 24; const long t0 = 256L * c; const float dsk = dskp[h];
    bf16x8 qr[8]; const float acs_l = acsln;
#pragma unroll
    for (int d0 = 0; d0 < 8; ++d0) qr[d0] = qn[d0];
    if (tid < 256) acs_lds[tid] = acsn;
#pragma unroll
    for (int i = 0; i < 4; ++i) { const int kc = sc * 2;
      *(bf16x8*)(K_lds + i * SHM_K + KSWZ(sr, kc)) = kbn[2 * i]; *(bf16x8*)(K_lds + i * SHM_K + KSWZ(32 + sr, kc)) = kbn[2 * i + 1];
      *(bf16x8*)(V_lds + i * SHM_V + vst2) = xvn[i]; }
    __syncthreads();
    if (u + ustep < 768) YU_LOAD(u + ustep);
    f32x16 o[2] = {};
#pragma nounroll
    for (int i = 0; i < ntile; ++i) {
      f32x16 p0, p1; qkt<false>(p0, p1, K_lds + i * SHM_K, qr, r32, hi);
#pragma unroll
      for (int r = 0; r < 16; ++r) { const int s = 64 * i + crow(r, hi);
        const float e0 = __builtin_amdgcn_exp2f((acs_l - acs_lds[s]) * LOG2E), e1 = __builtin_amdgcn_exp2f((acs_l - acs_lds[s + 32]) * LOG2E);
        p0[r] = (s <= lrow) ? p0[r] * e0 : 0.f; p1[r] = (s + 32 <= lrow) ? p1[r] * e1 : 0.f; }
      bf16x8 pa0, pa1, pa2, pa3;
      ATT_PK4(p0, 0, pa0); ATT_PK4(p0, 8, pa1); ATT_PK4(p1, 0, pa2); ATT_PK4(p1, 8, pa3);
      pv_one<0>(o[0], vb0 + i * SHM_V, pa0, pa1, pa2, pa3); pv_one<1>(o[1], vb0 + i * SHM_V, pa0, pa1, pa2, pa3);
    }
    f32x16 o2[2] = {};
    { const bf16* Pp = PREV + ((long)(c * 24 + h) * 64 + r32) * 128 + hi * 8;
#pragma unroll
      for (int d0 = 0; d0 < 2; ++d0)
#pragma unroll
        for (int d = 0; d < 8; ++d) { const bf16x8 bfrag = ld8(Pp + d0 * 32 * 128 + d * 16);
          o2[d0] = __builtin_amdgcn_mfma_f32_32x32x16_bf16(qr[d], bfrag, o2[d0], 0, 0, 0); } }
    { const bf16* xp0 = CV + (t0 + wid * 32 + 4 * hi) * CVP + h * 64 + r32; float* yp0 = YS + (t0 + wid * 32 + 4 * hi) * 1536 + h * 64 + r32; const float* ap = acs_lds + wid * 32 + 4 * hi;
      unsigned short xs0[16], xs1[16];
#pragma unroll
      for (int r = 0; r < 16; ++r) { const int ro = (r & 3) + 8 * (r >> 2); xs0[r] = xp0[ro * CVP]; xs1[r] = xp0[ro * CVP + 32]; }
#pragma unroll
      for (int r = 0; r < 16; ++r) { const int ro = (r & 3) + 8 * (r >> 2); const float ea = __builtin_amdgcn_exp2f(ap[ro] * LOG2E);
        yp0[ro * 1536] = o[0][r] + o2[0][r] * ea + dsk * bf2f(xs0[r]); yp0[ro * 1536 + 32] = o[1][r] + o2[1][r] * ea + dsk * bf2f(xs1[r]); } }
    __syncthreads();
  }
#undef YU_LOAD
}
#undef KSWZ
#undef SBAR
#undef ATT_PK
#undef ATT_PK4
}
constexpr int T = 8192, DM = 2048, DFF = 7168, NEXP = 8, MEML = 256;
constexpr int N_IN0 = 5120, N_IN1 = 4864, N_IN1_REAL = 4632;
constexpr int MOE_ROWS = 72 * 256;
constexpr float LN_EPS = 1e-5f, RMS_EPS = 1e-5f, DN_ALPHA = 1.41421356237309515f;
constexpr int NWAVES = 8;
#ifndef MK_PER_PHASE
#define MK_PER_PHASE 0
#endif
constexpr int NPHASE = 24;

constexpr size_t MiB = 1u << 20;
constexpr size_t WS_CTL = 0, CTL_ZERO_BYTES = 1 * MiB;
constexpr size_t WS_ROPE = 1 * MiB, WS_KMEAN = 2 * MiB, WS_DTR = 3 * MiB, WS_ACS = 4 * MiB;
constexpr size_t WS_TOKE = 5 * MiB, WS_TOKW = 5 * MiB + 65536, WS_POS = 5 * MiB + 131072, WS_COUNTS = 5 * MiB + 262144;
constexpr size_t WS_MEMB = 6 * MiB, WS_MEMKV = 7 * MiB;
constexpr size_t WS_WMKV = 8 * MiB, WS_WIN0 = WS_WMKV + 4 * MiB, WS_WO0 = WS_WIN0 + 20 * MiB, WS_WGU0 = WS_WO0 + 8 * MiB, WS_WD0 = WS_WGU0 + 56 * MiB;
constexpr size_t WS_WIN1 = WS_WD0 + 28 * MiB, WS_WO1 = WS_WIN1 + 19 * MiB, WS_WGUE = WS_WO1 + 8 * MiB, WS_WDE = WS_WGUE + 448 * MiB, WS_WEND = WS_WDE + 224 * MiB;
constexpr size_t WS_XCUR = WS_WEND + 1 * MiB, WS_XCURB = WS_XCUR + 64 * MiB, WS_HEADS = WS_XCURB + 32 * MiB, WS_YF = WS_HEADS + 32 * MiB;
constexpr size_t WS_RA = WS_YF + 64 * MiB, WS_RB = WS_RA + 252 * MiB, WS_RC = WS_RB + 144 * MiB;
constexpr size_t WS_STATES = WS_RC + 72 * MiB, WS_PREV = WS_STATES + 24 * MiB, WS_YSSD = WS_PREV + 12 * MiB, WS_END = WS_YSSD + 48 * MiB;
static_assert((size_t)N_IN1 * DM * 2 <= 19 * MiB && (size_t)MOE_ROWS * DFF * 2 <= 252 * MiB && (size_t)MOE_ROWS * DM * 4 <= 144 * MiB && (size_t)MOE_ROWS * DM * 2 <= 72 * MiB, "ws map");
constexpr size_t WS_ROWMASK = WS_YSSD, WS_CNT = WS_YSSD + 1 * MiB, WS_SEG = WS_YSSD + 2 * MiB;
constexpr int CW_TMO = 0, CW_BAR = 4096;

constexpr int RING_OFF = 0, RING_BYTES = 131072;
constexpr int LDSCTL_OFF = RING_BYTES, MISC_OFF = LDSCTL_OFF + 320;
constexpr int LDS_BYTES = 147456;

#define GAS __attribute__((address_space(1)))
#define LAS __attribute__((address_space(3)))
typedef unsigned short bf16;
typedef unsigned v4u __attribute__((ext_vector_type(4)));
typedef unsigned v2u __attribute__((ext_vector_type(2)));
typedef float f32x4 __attribute__((ext_vector_type(4)));
typedef short bf16x8 __attribute__((ext_vector_type(8)));
typedef GAS unsigned gu32;
#define RLX_AGENT __ATOMIC_RELAXED, __HIP_MEMORY_SCOPE_AGENT
#define LDS_WAIT() asm volatile("s_waitcnt lgkmcnt(0)" ::: "memory")
__device__ __forceinline__ unsigned pk2(float lo, float hi) { unsigned r; asm volatile("v_cvt_pk_bf16_f32 %0, %1, %2" : "=v"(r) : "v"(lo), "v"(hi)); return r; }
__device__ __forceinline__ float bf2f(unsigned short b) { return __uint_as_float(((unsigned)b) << 16); }
__device__ __forceinline__ float bflo(unsigned w) { return __uint_as_float(w << 16); }
__device__ __forceinline__ float bfhi(unsigned w) { return __uint_as_float(w & 0xffff0000u); }
__device__ __forceinline__ float wave_sum(float v) {
#pragma unroll
    for (int o = 1; o < 64; o <<= 1) v += __shfl_xor(v, o);
    return v;
}
__device__ __forceinline__ float silu_f(float g) { return g * __builtin_amdgcn_rcpf(1.0f + __builtin_amdgcn_exp2f(-1.4426950408889634f * g)); }
__device__ __forceinline__ float softplus_f(float x) { return x > 20.f ? x : log1pf(__expf(x)); }
#define XB_TMO      128
#define XB_XCNT(j)  (256  + 64 * (j))
#define XB_XSUB(j)  (1280 + 64 * (j))
#define XB_XGEN(j)  (2304 + 64 * (j))
#define XB_TOP      3328
#define XB_TOPGEN   3392
#define XCD_BAR_WORDS 3456
#define XB_SPIN_CAP (1u << 18)

__device__ __forceinline__ unsigned xb_ld(unsigned* p)              { return __hip_atomic_load(p, __ATOMIC_RELAXED, __HIP_MEMORY_SCOPE_AGENT); }
__device__ __forceinline__ unsigned xb_add(unsigned* p, unsigned v) { return __hip_atomic_fetch_add(p, v, __ATOMIC_RELAXED, __HIP_MEMORY_SCOPE_AGENT); }
__device__ __forceinline__ unsigned xb_xcc_id() { return (unsigned)__builtin_amdgcn_s_getreg((3 << 11) | 20) & 0xFu; }
#define XB_SPIN(cond, bar) do { unsigned _sp = 0; while (cond) { __builtin_amdgcn_s_sleep(1); \
    if ((++_sp & 255u) == 0u) { if (xb_ld(&(bar)[XB_TMO])) break; if (_sp > XB_SPIN_CAP) { atomicAdd(&(bar)[XB_TMO], 1u); break; } } } } while (0)

struct XcdBarrier {
    unsigned* bar; unsigned x; int w;
    volatile LAS unsigned* st;
};

__device__ __forceinline__ XcdBarrier xcd_barrier_post(unsigned* bar, volatile LAS unsigned* st, int wave) {
    XcdBarrier b; b.bar = bar; b.x = xb_xcc_id(); b.st = st; b.w = wave;
    if (threadIdx.x == 0) (void)xb_add(&bar[XB_XCNT(b.x)], 1u);
    return b;
}
__device__ __forceinline__ void xcd_barrier_complete(unsigned* bar, unsigned x, unsigned& nloc, unsigned& nx) {
    const unsigned G = gridDim.x * gridDim.y * gridDim.z;
    unsigned sum, cnt, mine, sp = 0u;
    for (;;) {
        sum = 0u; cnt = 0u; mine = 0u;
#pragma unroll
        for (unsigned j = 0; j < 16; ++j) { const unsigned c = xb_ld(&bar[XB_XCNT(j)]); sum += c; cnt += (c > 0u) ? 1u : 0u; mine = (j == x) ? c : mine; }
        if (sum == G) break;
        __builtin_amdgcn_s_sleep(1);
        if ((++sp & 255u) == 0u) { if (xb_ld(&bar[XB_TMO])) break; if (sp > XB_SPIN_CAP) { atomicAdd(&bar[XB_TMO], 1u); break; } }
    }
    nloc = mine > 0u ? mine : 1u; nx = cnt > 0u ? cnt : 1u;
}

__device__ __forceinline__ void xcd_barrier(const XcdBarrier& b) {
    asm volatile("s_waitcnt vmcnt(0)" ::: "memory");
    __syncthreads();
    unsigned z_; asm volatile("s_mov_b32 %0, 0" : "=s"(z_));
    if (b.w == 0 && __builtin_amdgcn_mbcnt_hi(~0u, __builtin_amdgcn_mbcnt_lo(~0u, z_)) == 0u) {
        unsigned* bar = b.bar;
        __builtin_amdgcn_s_waitcnt(0);
        unsigned nloc = b.st[0], nx = b.st[1];
        if (nloc == 0u) { xcd_barrier_complete(bar, b.x, nloc, nx); b.st[0] = nloc; b.st[1] = nx; }
        const unsigned old = xb_add(&bar[XB_XSUB(b.x)], 1u);
        const unsigned gen = old / nloc;
        if (old + 1u == (gen + 1u) * nloc) {
            __builtin_amdgcn_fence(__ATOMIC_RELEASE, "agent");
            asm volatile("s_waitcnt vmcnt(0)" ::: "memory");
            const unsigned og = xb_add(&bar[XB_TOP], 1u);
            const unsigned tg = og / nx;
            if (og + 1u == (tg + 1u) * nx) xb_add(&bar[XB_TOPGEN], 1u);
            else XB_SPIN(xb_ld(&bar[XB_TOPGEN]) == tg, bar);
            __builtin_amdgcn_fence(__ATOMIC_ACQUIRE, "agent");
            xb_add(&bar[XB_XGEN(b.x)], 1u);
            asm volatile("s_waitcnt vmcnt(0)" ::: "memory");
        } else {
            XB_SPIN(xb_ld(&bar[XB_XGEN(b.x)]) == gen, bar);
            __builtin_amdgcn_fence(__ATOMIC_ACQUIRE, "agent");
            asm volatile("s_waitcnt vmcnt(0)" ::: "memory");
        }
    }
    __syncthreads();
}

struct Args { const void* in[29]; float* out; unsigned char* ws; int ph_lo, ph_hi; };
struct Frame {
    LAS unsigned char* lds; char* ldsg; volatile LAS unsigned* MISC; gu32* ctl;
    int tid, lane, wave, G, gw, NGW;
};

__device__ __forceinline__ int dest_row(int mode, int n) {
    if (mode == 1) return ((n >> 7) << 8) + (n & 127);
    if (mode == 2) return ((n >> 7) << 8) + 128 + (n & 127);
    if (mode == 3) return n < 4096 ? n : (n < 4120 ? 4608 + (n - 4096) : 4096 + (n - 4120));
    if (mode == 4) { const int c = n & 127; return (n < 3072 && c < 32) ? (n & ~127) + 2 * (c & 15) + (c >> 4) : n; }
    return n;
}
struct CvItem { const float* W; bf16* WT; int K, N, mode, loc, fp8; };
__device__ __forceinline__ void cv_load(const CvItem& c, f32x4 (&v)[8], int lane) {
    const int nblk = (c.N + 31) >> 5, kb = c.loc / nblk, nb = c.loc - kb * nblk, k0 = 64 * kb, n0 = 32 * nb;
    const int col = n0 + (lane & 7) * 4; const int colc = col < c.N ? col : c.N - 4;
    const float* src = c.W + (size_t)(k0 + 8 * (lane >> 3)) * c.N + colc;
#pragma unroll
    for (int i = 0; i < 8; ++i) v[i] = __builtin_nontemporal_load((const f32x4*)(src + (size_t)i * c.N));
}
__device__ __forceinline__ void cv_store(const CvItem& c, const f32x4 (&v)[8], LAS float* scr, int lane) {
    const int nblk = (c.N + 31) >> 5, kb = c.loc / nblk, nb = c.loc - kb * nblk, k0 = 64 * kb, n0 = 32 * nb;
    if (c.fp8) {
        const float sc_ = __builtin_ldexpf(1.0f, c.fp8); const int dbl = c.mode ? 1 : 0, off = (c.mode >> 1) << 7;
        const int rowb = ((n0 >> 7) << (7 + dbl)) + off + (n0 & 127) + 4 * (lane & 7);
        unsigned char* pq = (unsigned char*)c.WT + (size_t)rowb * c.K + k0 + 8 * (lane >> 3);
#pragma unroll
        for (int cc = 0; cc < 4; ++cc) { int w0 = 0, w1 = 0;
            w0 = __builtin_amdgcn_cvt_pk_fp8_f32(v[0][cc] * sc_, v[1][cc] * sc_, w0, false); w0 = __builtin_amdgcn_cvt_pk_fp8_f32(v[2][cc] * sc_, v[3][cc] * sc_, w0, true);
            w1 = __builtin_amdgcn_cvt_pk_fp8_f32(v[4][cc] * sc_, v[5][cc] * sc_, w1, false); w1 = __builtin_amdgcn_cvt_pk_fp8_f32(v[6][cc] * sc_, v[7][cc] * sc_, w1, true);
            *(v2u*)(pq + (size_t)cc * c.K) = (v2u){(unsigned)w0, (unsigned)w1}; }
        return; }
#pragma unroll
    for (int cc = 0; cc < 4; ++cc) { const int n = n0 + 4 * (lane & 7) + cc;
        v4u o; o.x = pk2(v[0][cc], v[1][cc]); o.y = pk2(v[2][cc], v[3][cc]); o.z = pk2(v[4][cc], v[5][cc]); o.w = pk2(v[6][cc], v[7][cc]);
        if (n < c.N) __builtin_nontemporal_store(o, (v4u*)(c.WT + (size_t)dest_row(c.mode, n) * c.K + k0 + 8 * (lane >> 3))); }
}
constexpr int CV_I_MKV = 32 * 32, CV_I_IN0 = 32 * 160, CV_I_O = 32 * 64, CV_I_GU = 32 * 224, CV_I_D = 112 * 64, CV_I_IN1 = 32 * 145;
constexpr int CV_B1 = CV_I_MKV, CV_B2 = CV_B1 + CV_I_IN0, CV_B3 = CV_B2 + CV_I_O, CV_B4 = CV_B3 + CV_I_GU, CV_B5 = CV_B4 + CV_I_GU, CV_B6 = CV_B5 + CV_I_D, CV_B7 = CV_B6 + CV_I_IN1, CV_B8 = CV_B7 + CV_I_O;
constexpr int CV_NITEMS = CV_B8 + 24 * 7168;
constexpr int CV_C1A = CV_B3 + 10 * 2048, CV_C1 = CV_C1A + 20 * 1024, CV_C2 = CV_C1 + 25 * 2048, CV_C3 = CV_C2 + 10 * 2048, CV_C4 = CV_NITEMS - 8 * 7168, CV_C4A = CV_C4 - 20 * 1280;
static_assert(CV_C1 >= CV_B8 && CV_C4A >= CV_C3 && CV_C4 >= CV_B8 + 16 * 7168, "dense weights are converted before the FFN phase, expert gate/up weights before the expert phase");
__device__ __forceinline__ CvItem cv_decode(const Args& A, int it) {
    unsigned char* ws = A.ws; CvItem c; c.fp8 = 0;
    constexpr int B1 = CV_B1, B2 = CV_B2, B3 = CV_B3, B4 = CV_B4, B5 = CV_B5, B6 = CV_B6, B7 = CV_B7, B8 = CV_B8;
    if (it < B1)      { c.W = (const float*)A.in[3];  c.K = DM; c.N = 1024; c.WT = (bf16*)(ws + WS_WMKV); c.mode = 0; c.loc = it; }
    else if (it < B2) { c.W = (const float*)A.in[4];  c.K = DM; c.N = N_IN0; c.WT = (bf16*)(ws + WS_WIN0); c.mode = 4; c.loc = it - B1; }
    else if (it < B3) { c.W = (const float*)A.in[5];  c.K = DM; c.N = DM; c.WT = (bf16*)(ws + WS_WO0); c.mode = 0; c.loc = it - B2; }
    else if (it < B4) { c.W = (const float*)A.in[8];  c.K = DM; c.N = DFF; c.WT = (bf16*)(ws + WS_WGU0); c.mode = 1; c.loc = it - B3; c.fp8 = 6; }
    else if (it < B5) { c.W = (const float*)A.in[9];  c.K = DM; c.N = DFF; c.WT = (bf16*)(ws + WS_WGU0); c.mode = 2; c.loc = it - B4; c.fp8 = 6; }
    else if (it < B6) { c.W = (const float*)A.in[10]; c.K = DFF; c.N = DM; c.WT = (bf16*)(ws + WS_WD0); c.mode = 0; c.loc = it - B5; c.fp8 = 7; }
    else if (it < B7) { c.W = (const float*)A.in[13]; c.K = DM; c.N = N_IN1_REAL; c.WT = (bf16*)(ws + WS_WIN1); c.mode = 3; c.loc = it - B6; }
    else if (it < B8) { c.W = (const float*)A.in[20]; c.K = DM; c.N = DM; c.WT = (bf16*)(ws + WS_WO1); c.mode = 0; c.loc = it - B7; }
    else { const int r = it - B8, r2 = r / 7168, kind = r2 >> 3, e = r2 & 7; c.loc = r - r2 * 7168;
        if (kind == 0)      { c.W = (const float*)A.in[24] + (size_t)e * DM * DFF; c.K = DM; c.N = DFF; c.WT = (bf16*)(ws + WS_WGUE + (size_t)e * 2 * DFF * DM); c.mode = 1; c.fp8 = 6; }
        else if (kind == 1) { c.W = (const float*)A.in[25] + (size_t)e * DM * DFF; c.K = DM; c.N = DFF; c.WT = (bf16*)(ws + WS_WGUE + (size_t)e * 2 * DFF * DM); c.mode = 2; c.fp8 = 6; }
        else                { c.W = (const float*)A.in[26] + (size_t)e * DFF * DM; c.K = DFF; c.N = DM; c.WT = (bf16*)(ws + WS_WDE + (size_t)e * DM * DFF); c.mode = 0; c.fp8 = 7; } }
    return c;
}
__device__ __forceinline__ void convert_items(Frame& F, const Args& A, int lo_, int hi_, int gwl, int ngwl) {
    LAS float* scr = (LAS float*)(F.lds + RING_OFF + F.wave * 16384);
    int it = lo_ + gwl; if (it >= hi_) return;
    f32x4 va[8], vb[8], vc[8], vd[8];
#define CV_LD(buf, idx) do { if ((idx) < hi_) { const CvItem c_ = cv_decode(A, (idx)); cv_load(c_, buf, F.lane); } } while (0)
#define CV_ST(buf, idx) do { const CvItem c_ = cv_decode(A, (idx)); cv_store(c_, buf, scr, F.lane); } while (0)
    CV_LD(va, it); CV_LD(vb, it + ngwl); CV_LD(vc, it + 2 * ngwl); CV_LD(vd, it + 3 * ngwl);
    for (;;) {
        CV_ST(va, it); CV_LD(va, it + 4 * ngwl); if (it + ngwl >= hi_) break;
        CV_ST(vb, it + ngwl); CV_LD(vb, it + 5 * ngwl); if (it + 2 * ngwl >= hi_) break;
        CV_ST(vc, it + 2 * ngwl); CV_LD(vc, it + 6 * ngwl); if (it + 3 * ngwl >= hi_) break;
        CV_ST(vd, it + 3 * ngwl); CV_LD(vd, it + 7 * ngwl); if (it + 4 * ngwl >= hi_) break;
        it += 4 * ngwl;
    }
#undef CV_LD
#undef CV_ST
}
__device__ __forceinline__ void p0_prologue(Frame& F, const Args& A) {
    unsigned char* ws = A.ws;
    convert_items(F, A, 0, CV_B3, F.gw, F.NGW);
    const int gid = blockIdx.x * 512 + F.tid, NT_ = F.G * 512;
    { const float* x = (const float*)A.in[0]; const float* mem = (const float*)A.in[1]; bf16* xb = (bf16*)(ws + WS_XCURB); bf16* mb = (bf16*)(ws + WS_MEMB);
      constexpr int NX8 = T * DM / 8, NM8 = MEML * DM / 8;
      for (int i0 = gid; i0 < NX8 + NM8; i0 += 4 * NT_) { f32x4 a[4], b[4];
#pragma unroll
          for (int q = 0; q < 4; ++q) { const int i = i0 + q * NT_; const int ic = i < NX8 + NM8 ? i : i0; const bool ix = ic < NX8; const int j = ix ? ic : ic - NX8; const float* s = (ix ? x : mem) + (size_t)j * 8;
              a[q] = __builtin_nontemporal_load((const f32x4*)s); b[q] = __builtin_nontemporal_load((const f32x4*)(s + 4)); }
#pragma unroll
          for (int q = 0; q < 4; ++q) { const int i = i0 + q * NT_; if (i < NX8 + NM8) { const bool ix = i < NX8; const int j = ix ? i : i - NX8;
              v4u o = {pk2(a[q][0], a[q][1]), pk2(a[q][2], a[q][3]), pk2(b[q][0], b[q][1]), pk2(b[q][2], b[q][3])};
              *(v4u*)((ix ? xb : mb) + (size_t)j * 8) = o; } } } }
    { v4u z = {0u, 0u, 0u, 0u}; v4u* p = (v4u*)((bf16*)(ws + WS_WIN1) + (size_t)N_IN1_REAL * DM); constexpr int NZ = (N_IN1 - N_IN1_REAL) * DM / 8;
      for (int i = gid; i < NZ; i += NT_) p[i] = z; }
    { const int* pos = (const int*)A.in[2]; float* rope = (float*)(ws + WS_ROPE);
      for (int i = gid; i < T * 16; i += NT_) { const int t = i >> 4, j = i & 15;
          const float inv = (float)exp(-((double)j / 16.0) * 13.122363377404328);
          const float ang = (float)pos[t] * inv;
          double rev = (double)ang * 0.15915494309189535; rev -= floor(rev);
          const double x = rev * 6.283185307179586; const double q = rint(x * 0.6366197723675814); const double y = x - q * 1.5707963267948966; const double y2 = y * y;
          const double sn = y * (1.0 + y2 * (-1.0 / 6 + y2 * (1.0 / 120 + y2 * (-1.0 / 5040 + y2 * (1.0 / 362880 + y2 * (-1.0 / 39916800 + y2 * (1.0 / 6227020800.0)))))));
          const double cs = 1.0 + y2 * (-0.5 + y2 * (1.0 / 24 + y2 * (-1.0 / 720 + y2 * (1.0 / 40320 + y2 * (-1.0 / 3628800 + y2 * (1.0 / 479001600.0))))));
          const int qi = ((int)q) & 3; double s, c;
          if (qi == 0) { s = sn; c = cs; } else if (qi == 1) { s = cs; c = -sn; } else if (qi == 2) { s = -sn; c = -cs; } else { s = -cs; c = sn; }
          rope[2 * i] = (float)c; rope[2 * i + 1] = (float)s; } }
}

__device__ __forceinline__ void rot8(v4u& a, v4u& b, const float* __restrict__ cs) {
    unsigned ao[4], bo[4]; const unsigned aw[4] = {a.x, a.y, a.z, a.w}, bw[4] = {b.x, b.y, b.z, b.w};
#pragma unroll
    for (int q = 0; q < 4; ++q) { const f32x4 t = *(const f32x4*)(cs + 4 * q);
        const float x1a = bflo(aw[q]), x1b = bfhi(aw[q]), x2a = bflo(bw[q]), x2b = bfhi(bw[q]);
        ao[q] = pk2(x1a * t[0] - x2a * t[1], x1b * t[2] - x2b * t[3]); bo[q] = pk2(x2a * t[0] + x1a * t[1], x2b * t[2] + x1b * t[3]); }
    a = (v4u){ao[0], ao[1], ao[2], ao[3]}; b = (v4u){bo[0], bo[1], bo[2], bo[3]};
}
__device__ __forceinline__ void p2_rotary_kmean(Frame& F, unsigned char* ws) {
    bf16* QKVM = (bf16*)(ws + WS_RB); const float* rope = (const float*)(ws + WS_ROPE); float* KMEAN = (float*)(ws + WS_KMEAN);
    { const int gid = blockIdx.x * 512 + F.tid, NT_ = F.G * 512;
      for (int i = gid; i < T * 24; i += NT_) { const int t = i / 24, r = i - t * 24, h = r >> 1, c = r & 1;
          bf16* p = QKVM + (size_t)t * N_IN0 + h * 128 + 8 * c; v4u a = *(v4u*)p, b = *(v4u*)(p + 16);
          rot8(a, b, rope + ((size_t)t * 16 + 8 * c) * 2); *(v4u*)p = a; *(v4u*)(p + 16) = b; } }
    LAS float* red = (LAS float*)(F.lds);
    for (int it = blockIdx.x; it < 32 * 12; it += F.G) { const int b = it / 12, h = it - b * 12;
        const int rgp = F.tid >> 4, c = F.tid & 15;
        float s[16];
#pragma unroll
        for (int q = 0; q < 16; ++q) s[q] = 0.f;
        if (c < 2 || c >= 4) {
            v4u ra[8], rb[8];
#pragma unroll
            for (int rr = 0; rr < 8; ++rr) { const int t = 256 * b + rgp * 8 + rr; const bf16* p = QKVM + (size_t)t * N_IN0 + 1536 + h * 128 + 8 * c; ra[rr] = *(const v4u*)p; rb[rr] = *(const v4u*)(p + (c < 2 ? 16 : 0)); }
#pragma unroll
            for (int rr = 0; rr < 8; ++rr) { const int t = 256 * b + rgp * 8 + rr; bf16* p = QKVM + (size_t)t * N_IN0 + 1536 + h * 128 + 8 * c;
                v4u a = ra[rr];
                if (c < 2) { v4u bq = rb[rr]; rot8(a, bq, rope + ((size_t)t * 16 + 8 * c) * 2); *(v4u*)p = a; *(v4u*)(p + 16) = bq;
                    s[8] += bflo(bq.x); s[9] += bfhi(bq.x); s[10] += bflo(bq.y); s[11] += bfhi(bq.y); s[12] += bflo(bq.z); s[13] += bfhi(bq.z); s[14] += bflo(bq.w); s[15] += bfhi(bq.w); }
                s[0] += bflo(a.x); s[1] += bfhi(a.x); s[2] += bflo(a.y); s[3] += bfhi(a.y); s[4] += bflo(a.z); s[5] += bfhi(a.z); s[6] += bflo(a.w); s[7] += bfhi(a.w); }
        }
        __syncthreads();
        if (c < 2 || c >= 4) {
#pragma unroll
            for (int q = 0; q < 8; ++q) red[rgp * 128 + 8 * c + q] = s[q];
            if (c < 2) {
#pragma unroll
                for (int q = 0; q < 8; ++q) red[rgp * 128 + 16 + 8 * c + q] = s[8 + q]; }
        }
        __syncthreads();
        if (F.tid < 128) { float a = 0.f;
#pragma unroll
            for (int g = 0; g < 32; ++g) a += red[g * 128 + F.tid];
            KMEAN[(size_t)(h * 32 + b) * 128 + F.tid] = a * (1.0f / 256.0f); }
    }
    __syncthreads();
}

template <bool ROUTER, bool RES_F32, bool X8 = false>
__device__ __forceinline__ void ln_rows(Frame& F, const void* res, const bf16* __restrict__ y, const float* __restrict__ gam, const float* __restrict__ bet,
                                        bf16* outb, const float* __restrict__ wr, int* __restrict__ toke, float* __restrict__ tokw, unsigned char* out8 = nullptr) {
    if (ROUTER) {
        LAS float* wt = (LAS float*)(F.lds);
        f32x4 w8[8];
#pragma unroll
        for (int q = 0; q < 8; ++q) w8[q] = *(const f32x4*)(wr + (size_t)(F.tid + q * 512) * 4);
#pragma unroll
        for (int q = 0; q < 8; ++q) { const int i = F.tid + q * 512; const int d = i >> 1, hf = i & 1;
            wt[(4 * hf + 0) * 2048 + d] = w8[q][0]; wt[(4 * hf + 1) * 2048 + d] = w8[q][1]; wt[(4 * hf + 2) * 2048 + d] = w8[q][2]; wt[(4 * hf + 3) * 2048 + d] = w8[q][3]; }
        __syncthreads();
    }
    f32x4 nx[8]; v2u nxb[8], ny[8];
#define LN_LOAD(row) do { _Pragma("unroll") for (int j = 0; j < 8; ++j) { \
        if (RES_F32) nx[j] = ((const f32x4*)((const float*)res + (size_t)(row) * DM) + F.lane)[64 * j]; else nxb[j] = ((const v2u*)((const bf16*)res + (size_t)(row) * DM) + F.lane)[64 * j]; \
        ny[j] = ((const v2u*)(y + (size_t)(row) * DM) + F.lane)[64 * j]; } } while (0)
    if (F.gw < T) LN_LOAD(F.gw);
    for (int m = F.gw; m < T; m += F.NGW) {
        f32x4 v[8]; float s = 0.f;
#pragma unroll
        for (int j = 0; j < 8; ++j) { const f32x4 xr = RES_F32 ? nx[j] : (f32x4){bflo(nxb[j].x), bfhi(nxb[j].x), bflo(nxb[j].y), bfhi(nxb[j].y)};
            const f32x4 yr = {bflo(ny[j].x), bfhi(ny[j].x), bflo(ny[j].y), bfhi(ny[j].y)};
            v[j] = xr * DN_ALPHA + yr; s += (v[j][0] + v[j][1]) + (v[j][2] + v[j][3]); }
        if (m + F.NGW < T) LN_LOAD(m + F.NGW);
        const float mean = wave_sum(s) * (1.f / DM); float s2 = 0.f;
#pragma unroll
        for (int j = 0; j < 8; ++j) { v[j] = v[j] - mean; s2 += (v[j][0] * v[j][0] + v[j][1] * v[j][1]) + (v[j][2] * v[j][2] + v[j][3] * v[j][3]); }
        const float rstd = 1.f / sqrtf(wave_sum(s2) * (1.f / DM) + LN_EPS);
        v2u* ob = (v2u*)(outb + (size_t)m * DM) + F.lane;
#pragma unroll
        for (int j = 0; j < 8; ++j) { const f32x4 g4 = ((const f32x4*)gam)[F.lane + 64 * j], b4 = ((const f32x4*)bet)[F.lane + 64 * j];
            v[j] = v[j] * rstd * g4 + b4;
            ob[64 * j] = (v2u){pk2(v[j][0], v[j][1]), pk2(v[j][2], v[j][3])};
            if (X8) { int w8_ = 0; w8_ = __builtin_amdgcn_cvt_pk_fp8_f32(v[j][0], v[j][1], w8_, false); w8_ = __builtin_amdgcn_cvt_pk_fp8_f32(v[j][2], v[j][3], w8_, true);
                ((unsigned*)(out8 + (size_t)m * DM))[F.lane + 64 * j] = (unsigned)w8_; } }
        if (ROUTER) {
            float lg[8];
#pragma unroll
            for (int e = 0; e < 8; ++e) lg[e] = 0.f;
            const LAS f32x4* wl = (const LAS f32x4*)(F.lds) + F.lane;
#pragma unroll
            for (int j = 0; j < 8; ++j)
#pragma unroll
                for (int e = 0; e < 8; ++e) { const f32x4 w4 = wl[e * 512 + 64 * j]; lg[e] += (v[j][0] * w4[0] + v[j][1] * w4[1]) + (v[j][2] * w4[2] + v[j][3] * w4[3]); }
#pragma unroll
            for (int e = 0; e < 8; ++e) lg[e] = wave_sum(lg[e]);
            float b0 = lg[0]; int i0 = 0;
#pragma unroll
            for (int e = 1; e < 8; ++e) if (lg[e] > b0) { b0 = lg[e]; i0 = e; }
            float b1 = -__builtin_inff(); int i1 = 0;
#pragma unroll
            for (int e = 0; e < 8; ++e) if (e != i0 && lg[e] > b1) { b1 = lg[e]; i1 = e; }
            if (F.lane == 0) { const float e1 = __expf(b1 - b0); const float w0 = 1.f / (1.f + e1); toke[m] = i0 | (i1 << 8); tokw[2 * m] = w0; tokw[2 * m + 1] = e1 * w0; }
        }
    }
#undef LN_LOAD
}

__device__ __forceinline__ void p10_conv(Frame& F, const Args& A) {
    unsigned char* ws = A.ws; const bf16* H1 = (const bf16*)(ws + WS_RB); bf16* CV = (bf16*)(ws + WS_RC); const float* DTR = (const float*)(ws + WS_DTR); float* ACS = (float*)(ws + WS_ACS);
    const float* cw = (const float*)A.in[14]; const float* cb = (const float*)A.in[15]; const float* dtb = (const float*)A.in[16]; const float* alog = (const float*)A.in[17];
    const int gid = blockIdx.x * 512 + F.tid, NT_ = F.G * 512;
    for (int i = gid; i < (T / 16) * 320; i += NT_) { const int tb = i / 320, cg = i - tb * 320, ch0 = 8 * cg, t0 = 16 * tb;
        v4u xr[19];
#pragma unroll
        for (int r = 0; r < 19; ++r) { const int tt = t0 - 3 + r; const v4u ld_ = *(const v4u*)(H1 + (size_t)(tt < 0 ? 0 : tt) * N_IN1 + 1536 + ch0); xr[r] = (tt >= 0) ? ld_ : (v4u){0u, 0u, 0u, 0u}; }
        float w[4][8], bias[8];
#pragma unroll
        for (int k = 0; k < 4; ++k) { const f32x4 w0 = *(const f32x4*)(cw + k * 2560 + ch0), w1 = *(const f32x4*)(cw + k * 2560 + ch0 + 4);
            w[k][0] = w0[0]; w[k][1] = w0[1]; w[k][2] = w0[2]; w[k][3] = w0[3]; w[k][4] = w1[0]; w[k][5] = w1[1]; w[k][6] = w1[2]; w[k][7] = w1[3]; }
        { const f32x4 b0 = *(const f32x4*)(cb + ch0), b1 = *(const f32x4*)(cb + ch0 + 4);
          bias[0] = b0[0]; bias[1] = b0[1]; bias[2] = b0[2]; bias[3] = b0[3]; bias[4] = b1[0]; bias[5] = b1[1]; bias[6] = b1[2]; bias[7] = b1[3]; }
        const bool isx = ch0 < 1536; const int hd = isx ? (ch0 >> 6) : 0; const float dbias = dtb[hd];
        float dtr[16];
#pragma unroll
        for (int r = 0; r < 16; ++r) dtr[r] = DTR[(size_t)(t0 + r) * 32 + hd];
#pragma unroll
        for (int r = 0; r < 16; ++r) { float acc[8];
#pragma unroll
            for (int q = 0; q < 8; ++q) acc[q] = bias[q];
#pragma unroll
            for (int k = 0; k < 4; ++k) { const v4u xv = xr[r + k];
                acc[0] += w[k][0] * bflo(xv.x); acc[1] += w[k][1] * bfhi(xv.x); acc[2] += w[k][2] * bflo(xv.y); acc[3] += w[k][3] * bfhi(xv.y);
                acc[4] += w[k][4] * bflo(xv.z); acc[5] += w[k][5] * bfhi(xv.z); acc[6] += w[k][6] * bflo(xv.w); acc[7] += w[k][7] * bfhi(xv.w); }
#pragma unroll
            for (int q = 0; q < 8; ++q) acc[q] = silu_f(acc[q]);
            const size_t t = (size_t)(t0 + r);
            *(v4u*)(CV + t * 4096 + ch0) = (v4u){pk2(acc[0], acc[1]), pk2(acc[2], acc[3]), pk2(acc[4], acc[5]), pk2(acc[6], acc[7])};
            if (isx) { const float dt = softplus_f(dtr[r] + dbias);
                *(v4u*)(CV + t * 4096 + 2560 + ch0) = (v4u){pk2(acc[0] * dt, acc[1] * dt), pk2(acc[2] * dt, acc[3] * dt), pk2(acc[4] * dt, acc[5] * dt), pk2(acc[6] * dt, acc[7] * dt)}; }
        }
    }
    for (int it = F.gw; it < 32 * 24; it += F.NGW) { const int c = it / 24, h = it - c * 24; const float a = -__expf(alog[h]); const float bias = dtb[h];
        float v[4]; float run = 0.f;
#pragma unroll
        for (int q = 0; q < 4; ++q) { const int t = 256 * c + 4 * F.lane + q; run += softplus_f(DTR[(size_t)t * 32 + h] + bias) * a; v[q] = run; }
        float incl = run;
#pragma unroll
        for (int o = 1; o < 64; o <<= 1) { const float u = __shfl_up(incl, o); if (F.lane >= o) incl += u; }
        const float excl = incl - run;
        *(f32x4*)(ACS + (size_t)(c * 24 + h) * 256 + 4 * F.lane) = (f32x4){v[0] + excl, v[1] + excl, v[2] + excl, v[3] + excl};
    }
}

__device__ __forceinline__ void p12_scan(Frame& F, unsigned char* ws) {
    const float* __restrict__ STATES = (const float*)(ws + WS_STATES); bf16* __restrict__ PREV = (bf16*)(ws + WS_PREV); const float* __restrict__ ACS = (const float*)(ws + WS_ACS);
    const int gid = blockIdx.x * 512 + F.tid, NT_ = F.G * 512;
    for (int i = gid; i < 24 * 64 * 32; i += NT_) { const int h = i >> 11;
        f32x4 carry = {0.f, 0.f, 0.f, 0.f};
#pragma unroll 8
        for (int c = 0; c < 32; ++c) {
            *(v2u*)(PREV + ((size_t)c * 24 * 64 * 32 + i) * 4) = (v2u){pk2(carry[0], carry[1]), pk2(carry[2], carry[3])};
            const float dec = __expf(ACS[(size_t)(c * 24 + h) * 256 + 255]);
            const f32x4 st = *(const f32x4*)(STATES + ((size_t)c * 24 * 64 * 32 + i) * 4);
            carry = carry * dec + st; }
    }
}

__device__ __forceinline__ void p14_gated_norm(Frame& F, const Args& A) {
    unsigned char* ws = A.ws; const float* YS = (const float*)(ws + WS_YSSD); const bf16* H1 = (const bf16*)(ws + WS_RB); bf16* HEADS = (bf16*)(ws + WS_HEADS); const float* ng = (const float*)A.in[19];
    f32x4 ny[6]; v2u nz[6];
#define GN_LOAD(row) do { _Pragma("unroll") for (int j = 0; j < 6; ++j) { ny[j] = *((const f32x4*)(YS + (size_t)(row) * 1536) + F.lane + 64 * j); nz[j] = *((const v2u*)(H1 + (size_t)(row) * N_IN1) + F.lane + 64 * j); } } while (0)
    if (F.gw < T) GN_LOAD(F.gw);
    for (int m = F.gw; m < T; m += F.NGW) {
        f32x4 v[6]; float s2 = 0.f; f32x4 cy[6]; v2u cz[6];
#pragma unroll
        for (int j = 0; j < 6; ++j) { cy[j] = ny[j]; cz[j] = nz[j]; }
        if (m + F.NGW < T) GN_LOAD(m + F.NGW);
#pragma unroll
        for (int j = 0; j < 6; ++j) { const f32x4 yv = cy[j]; const v2u zz = cz[j];
            v[j] = (f32x4){yv[0] * silu_f(bflo(zz.x)), yv[1] * silu_f(bfhi(zz.x)), yv[2] * silu_f(bflo(zz.y)), yv[3] * silu_f(bfhi(zz.y))};
            s2 += (v[j][0] * v[j][0] + v[j][1] * v[j][1]) + (v[j][2] * v[j][2] + v[j][3] * v[j][3]); }
        const float rstd = 1.f / sqrtf(wave_sum(s2) * (1.f / 1536.f) + RMS_EPS);
#pragma unroll
        for (int j = 0; j < 6; ++j) { const f32x4 g4 = ((const f32x4*)ng)[F.lane + 64 * j]; const f32x4 o = v[j] * rstd * g4;
            *((v2u*)(HEADS + (size_t)m * DM) + F.lane + 64 * j) = (v2u){pk2(o[0], o[1]), pk2(o[2], o[3])}; }
    }
}

__device__ __forceinline__ void p17_sort_gather(Frame& F, unsigned char* ws) {
    const int* TOKE = (const int*)(ws + WS_TOKE); int* POS = (int*)(ws + WS_POS); int* COUNTS = (int*)(ws + WS_COUNTS);
    const bf16* XB = (const bf16*)(ws + WS_XCURB); bf16* XG = (bf16*)(ws + WS_RC);
    LAS unsigned long long* wtot = (LAS unsigned long long*)(F.lds);
    LAS int* posl = (LAS int*)(F.lds + 256);
    int te[16];
    { const int4* p = (const int4*)(TOKE + 16 * F.tid);
#pragma unroll
      for (int q = 0; q < 4; ++q) { const int4 v = p[q]; te[4 * q] = v.x; te[4 * q + 1] = v.y; te[4 * q + 2] = v.z; te[4 * q + 3] = v.w; } }
    unsigned long long ca = 0ull, cb = 0ull;
#pragma unroll
    for (int q = 0; q < 16; ++q) {
#pragma unroll
        for (int k = 0; k < 2; ++k) { const int e = (te[q] >> (8 * k)) & 0xff; const unsigned long long one = 1ull << (16 * (e & 3)); if (e < 4) ca += one; else cb += one; } }
    unsigned long long ia = ca, ib = cb;
#pragma unroll
    for (int o = 1; o < 64; o <<= 1) { const unsigned long long ua = __shfl_up(ia, o), ub = __shfl_up(ib, o); if (F.lane >= o) { ia += ua; ib += ub; } }
    if (F.lane == 63) { wtot[F.wave * 2] = ia; wtot[F.wave * 2 + 1] = ib; }
    __syncthreads();
    unsigned long long pa = 0ull, pb = 0ull, ta = 0ull, tb = 0ull;
#pragma unroll
    for (int w = 0; w < 8; ++w) { const unsigned long long xa = wtot[w * 2], xb = wtot[w * 2 + 1]; if (w < F.wave) { pa += xa; pb += xb; } ta += xa; tb += xb; }
    const unsigned long long ea = pa + ia - ca, eb = pb + ib - cb;
    int cnt[8], pst[8];
#pragma unroll
    for (int e = 0; e < 8; ++e) cnt[e] = (int)(((e < 4 ? ta : tb) >> (16 * (e & 3))) & 0xffffull);
    pst[0] = 0;
#pragma unroll
    for (int e = 1; e < 8; ++e) pst[e] = pst[e - 1] + ((cnt[e - 1] + 255) & ~255);
    if (blockIdx.x == 0 && F.tid < 8) { int c = 0;
#pragma unroll
        for (int e = 0; e < 8; ++e) c = (F.tid == e) ? cnt[e] : c;
        COUNTS[F.tid] = c; }
    const int b = blockIdx.x;
    for (int tb0 = b * 32; tb0 < T; tb0 += F.G * 32) {
        __syncthreads();
        if ((F.tid >> 1) == (tb0 >> 5)) {
            unsigned long long ra = ea, rb = eb;
#pragma unroll
            for (int q = 0; q < 16; ++q) {
#pragma unroll
                for (int k = 0; k < 2; ++k) { const int e = (te[q] >> (8 * k)) & 0xff; const int sh = 16 * (e & 3);
                    const int off = (int)(((e < 4 ? ra : rb) >> sh) & 0xffffull); int ps = 0;
#pragma unroll
                    for (int x = 0; x < 8; ++x) ps = (x == e) ? pst[x] : ps;
                    const int pos = ps + off; if (e < 4) ra += 1ull << sh; else rb += 1ull << sh;
                    const int tok = 16 * F.tid + q; POS[2 * tok + k] = pos; posl[(tok - tb0) * 2 + k] = pos; } }
        }
        __syncthreads();
        for (int i0 = F.tid; i0 < 64 * 256; i0 += 512 * 8) { v4u tmp[8];
#pragma unroll
            for (int q = 0; q < 8; ++q) { const int i = i0 + q * 512; const int r = i >> 8, ch = i & 255; tmp[q] = *((const v4u*)(XB + (size_t)(tb0 + (r >> 1)) * DM) + ch); }
#pragma unroll
            for (int q = 0; q < 8; ++q) { const int i = i0 + q * 512; const int r = i >> 8, ch = i & 255; const v4u t_ = tmp[q]; int w0 = 0, w1 = 0;
                w0 = __builtin_amdgcn_cvt_pk_fp8_f32(bflo(t_.x), bfhi(t_.x), w0, false); w0 = __builtin_amdgcn_cvt_pk_fp8_f32(bflo(t_.y), bfhi(t_.y), w0, true);
                w1 = __builtin_amdgcn_cvt_pk_fp8_f32(bflo(t_.z), bfhi(t_.z), w1, false); w1 = __builtin_amdgcn_cvt_pk_fp8_f32(bflo(t_.w), bfhi(t_.w), w1, true);
                *((v2u*)((unsigned char*)XG + (size_t)posl[r] * DM) + ch) = (v2u){(unsigned)w0, (unsigned)w1}; } }
    }
    __syncthreads();
}

__device__ __forceinline__ void p20_final(Frame& F, const Args& A) {
    unsigned char* ws = A.ws; const bf16* X = (const bf16*)(ws + WS_XCURB); const bf16* YM = (const bf16*)(ws + WS_RB); const int* POS = (const int*)(ws + WS_POS); const float* TOKW = (const float*)(ws + WS_TOKW);
    const float* gam = (const float*)A.in[27]; const float* bet = (const float*)A.in[28]; float* out = A.out;
    v2u nxa[8], nya[8], nyb[8]; float nw0 = 0.f, nw1 = 0.f;
#define FN_LOAD(row) do { const int p0_ = POS[2 * (row)], p1_ = POS[2 * (row) + 1]; nw0 = TOKW[2 * (row)]; nw1 = TOKW[2 * (row) + 1]; \
        const v2u* xr_ = (const v2u*)(X + (size_t)(row) * DM) + F.lane; const v2u* y0_ = (const v2u*)(YM + (size_t)p0_ * DM) + F.lane; const v2u* y1_ = (const v2u*)(YM + (size_t)p1_ * DM) + F.lane; \
        _Pragma("unroll") for (int j = 0; j < 8; ++j) { nxa[j] = xr_[64 * j]; nya[j] = y0_[64 * j]; nyb[j] = y1_[64 * j]; } } while (0)
    if (F.gw < T) FN_LOAD(F.gw);
    for (int m = F.gw; m < T; m += F.NGW) {
        const float w0 = nw0, w1 = nw1;
        v2u xa[8], ya[8], yb[8];
#pragma unroll
        for (int j = 0; j < 8; ++j) { xa[j] = nxa[j]; ya[j] = nya[j]; yb[j] = nyb[j]; }
        if (m + F.NGW < T) FN_LOAD(m + F.NGW);
        f32x4 v[8]; float s = 0.f;
#pragma unroll
        for (int j = 0; j < 8; ++j) { const f32x4 xv = {bflo(xa[j].x), bfhi(xa[j].x), bflo(xa[j].y), bfhi(xa[j].y)}, a = {bflo(ya[j].x), bfhi(ya[j].x), bflo(ya[j].y), bfhi(ya[j].y)}, b = {bflo(yb[j].x), bfhi(yb[j].x), bflo(yb[j].y), bfhi(yb[j].y)};
            v[j] = xv * DN_ALPHA + (a * w0 + b * w1); s += (v[j][0] + v[j][1]) + (v[j][2] + v[j][3]); }
        const float mean = wave_sum(s) * (1.f / DM); float s2 = 0.f;
#pragma unroll
        for (int j = 0; j < 8; ++j) { v[j] = v[j] - mean; s2 += (v[j][0] * v[j][0] + v[j][1] * v[j][1]) + (v[j][2] * v[j][2] + v[j][3] * v[j][3]); }
        const float rstd = 1.f / sqrtf(wave_sum(s2) * (1.f / DM) + LN_EPS);
        f32x4* of = (f32x4*)(out + (size_t)m * DM) + F.lane;
#pragma unroll
        for (int j = 0; j < 8; ++j) { const f32x4 g4 = ((const f32x4*)gam)[F.lane + 64 * j], b4 = ((const f32x4*)bet)[F.lane + 64 * j]; of[64 * j] = v[j] * rstd * g4 + b4; }
    }
}
__global__ void __launch_bounds__(NWAVES * 64, 2) mega_fwd(Args args) {
    extern __shared__ __attribute__((aligned(16))) unsigned char lds[];
    Frame F;
    F.lds = (LAS unsigned char*)lds; F.ldsg = (char*)lds;
    F.MISC = (volatile LAS unsigned*)(F.lds + MISC_OFF);
    F.tid = threadIdx.x; F.lane = F.tid & 63; F.wave = __builtin_amdgcn_readfirstlane(F.tid >> 6); const int wid_s = F.wave;
#define FRESH_TID(var) int var = fresh_tid()
    F.G = gridDim.x; F.gw = blockIdx.x * NWAVES + F.wave; F.NGW = F.G * NWAVES;
    unsigned char* ws = args.ws;
    F.ctl = (gu32*)(ws + WS_CTL);
    for (int u = F.tid; u < (LDS_BYTES - LDSCTL_OFF) / 4; u += NWAVES * 64) ((LAS unsigned*)(F.lds + LDSCTL_OFF))[u] = 0u;
    __syncthreads();
    if (F.lane == 0) ((LAS int*)(F.lds + WTAB_OFF))[(unsigned)__builtin_amdgcn_s_getreg((5 << 11) | 4) & 63u] = wid_s;
    __syncthreads();
#if MK_PER_PHASE
#define GRID_BAR() do { } while (0)
#else
    XcdBarrier bar = xcd_barrier_post((unsigned*)(F.ctl + CW_BAR), F.MISC + 8, wid_s);
#define GRID_BAR() xcd_barrier(bar)
#endif
#ifndef PROBE_PHASE
#define PROBE_PHASE -1
#endif
#ifndef PROBE_REPS
#define PROBE_REPS 2
#endif
#define REPS(k) (((k) == PROBE_PHASE) ? PROBE_REPS : 1)
#define HOSTED_GEMM(EPI, RW, CLO, CMID, CHI, WLO) HOSTED_GEMM_O(EPI, pg8::StaticOrder, RW, CLO, CMID, CHI, WLO)
#define HOSTED_GEMM_O(EPI, ORD, RW, CLO, CMID, CHI, WLO) do { const int rw_ = (RW); \
        pg8::RangeOrder<ORD> R1_{S, 0, rw_}, R2_{S, rw_, 1 << 20}; \
        pg8::gemm_phase<EPI, pg8::RangeOrder<ORD>, true, true>(F.lds + RING_OFF, g, R1_, E); \
        { FRESH_TID(tx_); F.tid = tx_; F.lane = tx_ & 63; F.wave = wid_s; F.gw = blockIdx.x * NWAVES + F.wave; } \
        __syncthreads(); convert_items(F, args, (CLO), (CMID), F.gw, F.NGW); \
        if ((int)blockIdx.x >= (WLO)) convert_items(F, args, (CMID), (CHI), F.gw - (WLO) * NWAVES, F.NGW - (WLO) * NWAVES); \
        __syncthreads(); \
        pg8::gemm_phase<EPI, pg8::RangeOrder<ORD>, true, true>(F.lds + RING_OFF, g, R2_, E); } while (0)
#define HOSTED_GEMM8(EPI, SC, RW, CLO, CMID, CHI, WLO) HOSTED_GEMM8_O(EPI, pg8::StaticOrder, SC, RW, CLO, CMID, CHI, WLO)
#define HOSTED_GEMM8_O(EPI, ORD, SC, RW, CLO, CMID, CHI, WLO) do { const int rw_ = (RW);     \
        pg8::RangeOrder<ORD> R1_{S, 0, rw_}, R2_{S, rw_, 1 << 20}; \
        { FRESH_TID(t8_); pg8::gemm_phase<EPI, pg8::RangeOrder<ORD>, true, true, SC>(F.lds + RING_OFF, g, R1_, E, t8_); } \
        { FRESH_TID(tx_); F.tid = tx_; F.lane = tx_ & 63; F.wave = wid_s; F.gw = blockIdx.x * NWAVES + F.wave; } \
        __syncthreads(); convert_items(F, args, (CLO), (CMID), F.gw, F.NGW); \
        if ((int)blockIdx.x >= (WLO)) convert_items(F, args, (CMID), (CHI), F.gw - (WLO) * NWAVES, F.NGW - (WLO) * NWAVES); \
        __syncthreads(); \
        { FRESH_TID(t8_); pg8::gemm_phase<EPI, pg8::RangeOrder<ORD>, true, true, SC>(F.lds + RING_OFF, g, R2_, E, t8_); } \
        { FRESH_TID(tx_); F.tid = tx_; F.lane = tx_ & 63; F.wave = wid_s; F.gw = blockIdx.x * NWAVES + F.wave; } } while (0)
    const int lo = args.ph_lo, hi = args.ph_hi;
#define IN(k) (lo <= (k) && (k) < hi)
#define REFRAME() { FRESH_TID(tx_); F.tid = tx_; F.lane = tx_ & 63; F.wave = wid_s; F.gw = blockIdx.x * NWAVES + F.wave; }
#define SEAM(k) do { if (IN(k) && IN((k) + 1)) GRID_BAR(); REFRAME(); } while (0)
    bf16* const XCURB = (bf16*)(ws + WS_XCURB); bf16* const YB = (bf16*)(ws + WS_YF); bf16* const HEADS = (bf16*)(ws + WS_HEADS); float* const YF = (float*)(ws + WS_YF);
    bf16* const QKVM = (bf16*)(ws + WS_RB); bf16* const H1 = (bf16*)(ws + WS_RB); bf16* const MEMKV = (bf16*)(ws + WS_MEMKV);

    if (IN(0)) for (int rep_ = 0; rep_ < REPS(0); ++rep_) { if (rep_) GRID_BAR(); p0_prologue(F, args); } SEAM(0);

    if (IN(1)) {
        { pg8::Gemm g{XCURB, (const bf16*)(ws + WS_WIN0), T, N_IN0, DM, DM}; pg8::StaticOrder S; S.init(T, N_IN0, F.G, (int)blockIdx.x);
          pg8::EpiQKV E{QKVM, N_IN0, (const float*)(ws + WS_ROPE), (float*)(ws + WS_KMEAN)};
          HOSTED_GEMM(pg8::EpiQKV, (int)((blockIdx.x & 7) % 3), CV_B3, CV_C1A, CV_C1, 128); }
        { pg8::Gemm g{(const bf16*)(ws + WS_MEMB), (const bf16*)(ws + WS_WMKV), MEML, 1024, DM, DM}; pg8::StaticOrder S; S.init(MEML, 1024, F.G, (int)((blockIdx.x + 4) % F.G));
          pg8::EpiBf16<0> E{MEMKV, 1024, nullptr, 0, 0, 1.f};
          pg8::gemm_phase<pg8::EpiBf16<0>, pg8::StaticOrder, true, true>(F.lds + RING_OFF, g, S, E); }
    } SEAM(1);


    if (IN(3)) {
        const float* KMEAN = (const float*)(ws + WS_KMEAN);
        for (int u = blockIdx.x; u < 384; u += F.G) { const int b = u / 12, h = u % 12;
            att::moba_gate_unit(QKVM + (size_t)(256 * b) * N_IN0 + h * 128, KMEAN + (size_t)h * 32 * 256, b, h, (unsigned*)(ws + WS_ROWMASK), (unsigned char*)(ws + WS_SEG), (int*)(ws + WS_CNT), F.ldsg); }
    } SEAM(3);

    if (IN(4)) {
        const unsigned* ROWMASK = (const unsigned*)(ws + WS_ROWMASK); const unsigned char* SEG = (const unsigned char*)(ws + WS_SEG); const int* CNT = (const int*)(ws + WS_CNT);
        bf16* PARTO = (bf16*)(ws + WS_RA); float* PARTML = (float*)(ws + WS_RA + 128 * MiB);
        char* scr = F.ldsg + 132096;
        LAS int* ipre = (LAS int*)(F.lds + 135168);
        int* segp = (int*)(F.ldsg + 137216);
        { int ng = 0;
          if (F.tid < 384) { const int j = F.tid & 31; int tot = 0; const int4* cp = (const int4*)(CNT + F.tid * 32); int4 cv[8];
#pragma unroll
              for (int q = 0; q < 8; ++q) cv[q] = cp[q];
#pragma unroll
              for (int q = 0; q < 8; ++q) { tot += (4 * q + 0 > j ? cv[q].x : 0) + (4 * q + 1 > j ? cv[q].y : 0) + (4 * q + 2 > j ? cv[q].z : 0) + (4 * q + 3 > j ? cv[q].w : 0); }
              ng = (256 + tot + 511) >> 9; }
          int incl = ng;
#pragma unroll
          for (int o = 1; o < 64; o <<= 1) { const int v = __shfl_up(incl, o); if (F.lane >= o) incl += v; }
          if (F.lane == 63) ipre[400 + F.wave] = incl;
          __syncthreads();
          int wbase = 0;
#pragma unroll
          for (int w = 0; w < 8; ++w) wbase += (w < F.wave) ? ipre[400 + w] : 0;
          if (F.tid < 384) ipre[F.tid + 1] = wbase + incl;
          if (F.tid == 0) ipre[0] = 0;
          __syncthreads(); }
        const int NIG = ipre[384];
#pragma nounroll
        for (int it = blockIdx.x; it < NIG; it += F.G) {
            int lo_ = 0, hi_ = 384;
            while (hi_ - lo_ > 1) { const int mid = (lo_ + hi_) >> 1; if (ipre[mid] <= it) lo_ = mid; else hi_ = mid; }
            const int hj = lo_, h = hj >> 5, j = hj & 31, chunk = it - ipre[hj];
            __syncthreads();
            if (F.tid < 64) { const int b = F.tid; const int c = (b > j && b < 32) ? CNT[hj * 32 + b] : 0; int incl = c;
#pragma unroll
                for (int o = 1; o < 64; o <<= 1) { const int v = __shfl_up(incl, o); if (F.lane >= o) incl += v; }
                if (b < 33) segp[b] = incl - c; }
            __syncthreads();
            const int R = 256 + segp[32]; const int row0 = chunk * 512; const int rowend = (row0 + 512 < R) ? row0 + 512 : R;
            att::moba_kv_item(QKVM, h, j, row0, rowend, segp, ROWMASK, SEG, PARTO, PARTML, F.ldsg, scr);
        }
#pragma nounroll
        for (int m = blockIdx.x; m < 128; m += F.G) { const int mh = m & 3, qb = m >> 2;
            att::attn_unit<false, N_IN0, 1024, DM>(QKVM + (size_t)(256 * qb) * N_IN0 + 4608 + mh * 128, MEMKV + mh * 128, MEMKV + 512 + mh * 128, HEADS + (size_t)(256 * qb) * DM + 1536 + mh * 128,
                                                   4, 0, nullptr, F.ldsg); }
    } SEAM(4);

    if (IN(5)) {
        const unsigned* ROWMASK = (const unsigned*)(ws + WS_ROWMASK); const bf16* PARTO = (const bf16*)(ws + WS_RA); const float* PARTML = (const float*)(ws + WS_RA + 128 * MiB);
        constexpr float C = 0.088388347648318440f * 1.4426950408889634f;
        const int gid = blockIdx.x * 512 + F.tid, NT_ = F.G * 512;
        for (int i = gid; i < T * 12 * 16; i += NT_) { const int th = i >> 4, c = i & 15; const int t = th / 12, h = th - t * 12;
            const unsigned rmask = ROWMASK[th];
            const float2* ml = (const float2*)PARTML + (size_t)th * 4; const v4u* po = (const v4u*)(PARTO + (size_t)th * 512) + c;
            float2 ms[4]; v4u pv[4];
#pragma unroll
            for (int s = 0; s < 4; ++s) { ms[s] = ml[s]; pv[s] = po[s * 16]; }
            const int cnt = __popc(rmask);
            float M = ms[3].x;
#pragma unroll
            for (int s = 0; s < 3; ++s) M = (s < cnt) ? fmaxf(M, ms[s].x) : M;
            float den = 0.f; float acc[8];
#pragma unroll
            for (int q = 0; q < 8; ++q) acc[q] = 0.f;
#pragma unroll
            for (int s = 0; s < 4; ++s) { const bool use = (s == 3) || (s < cnt); const float w = use ? ms[s].y * __builtin_amdgcn_exp2f((ms[s].x - M) * C) : 0.f; den += w; const v4u v = pv[s];
                acc[0] += use ? bflo(v.x) * w : 0.f; acc[1] += use ? bfhi(v.x) * w : 0.f; acc[2] += use ? bflo(v.y) * w : 0.f; acc[3] += use ? bfhi(v.y) * w : 0.f;
                acc[4] += use ? bflo(v.z) * w : 0.f; acc[5] += use ? bfhi(v.z) * w : 0.f; acc[6] += use ? bflo(v.w) * w : 0.f; acc[7] += use ? bfhi(v.w) * w : 0.f; }
            const float rd = 1.0f / den;
            *((v4u*)(HEADS + (size_t)t * DM + h * 128) + c) = (v4u){pk2(acc[0] * rd, acc[1] * rd), pk2(acc[2] * rd, acc[3] * rd), pk2(acc[4] * rd, acc[5] * rd), pk2(acc[6] * rd, acc[7] * rd)}; }
    } SEAM(5);

    if (IN(6)) for (int rep_ = 0; rep_ < REPS(6); ++rep_) { if (rep_) GRID_BAR(); pg8::Gemm g{HEADS, (const bf16*)(ws + WS_WO0), T, DM, DM, DM}; pg8::StaticOrder S; S.init(T, DM, F.G, (int)blockIdx.x);
        pg8::EpiBf16<0> E{YB, DM, nullptr, 0, 0, 1.f};
        pg8::gemm_phase<pg8::EpiBf16<0>, pg8::StaticOrder, true, true>(F.lds + RING_OFF, g, S, E); } SEAM(6);

    if (IN(7)) { ln_rows<false, true, true>(F, args.in[0], YB, (const float*)args.in[6], (const float*)args.in[7], XCURB, nullptr, nullptr, nullptr, ws + WS_XCUR); } SEAM(7);

    { FRESH_TID(tx_); F.tid = tx_; F.lane = tx_ & 63; F.wave = wid_s; F.gw = blockIdx.x * NWAVES + F.wave; }
    if (IN(8)) for (int rep_ = 0; rep_ < REPS(8); ++rep_) { if (rep_) GRID_BAR(); pg8::Gemm g{(const bf16*)(ws + WS_XCUR), (const bf16*)(ws + WS_WGU0), T, 2 * DFF, DM / 2, DM / 2}; pg8::StaticOrder S; S.init(T, 2 * DFF, F.G, (int)blockIdx.x);
        pg8::EpiSwiGLU8 E{ws + WS_RA, DFF};
        HOSTED_GEMM8(pg8::EpiSwiGLU8, 124, (int)(blockIdx.x & 7), CV_C1, CV_C2, CV_C2, 0); } SEAM(8);

    if (IN(9)) for (int rep_ = 0; rep_ < REPS(9); ++rep_) { if (rep_) GRID_BAR(); pg8::Gemm g{(const bf16*)(ws + WS_RA), (const bf16*)(ws + WS_WD0), T, DM, DFF / 2, DFF / 2}; pg8::StaticOrder S; S.init(T, DM, F.G, (int)blockIdx.x);
        pg8::EpiBf16<0> E{YB, DM, nullptr, 0, 0, 1.f};
        HOSTED_GEMM8(pg8::EpiBf16<0>, 122, (int)(blockIdx.x & 1), CV_C2, CV_C3, CV_C3, 0); } SEAM(9);

    if (IN(10)) { ln_rows<false, false>(F, XCURB, YB, (const float*)args.in[11], (const float*)args.in[12], XCURB, nullptr, nullptr, nullptr); } SEAM(10);

    if (IN(11)) { pg8::Gemm g{XCURB, (const bf16*)(ws + WS_WIN1), T, N_IN1, DM, DM}; pg8::StaticOrder S; S.init(T, N_IN1, F.G, (int)blockIdx.x);
        pg8::EpiIn1 E{H1, N_IN1, (float*)(ws + WS_DTR), 18};
        HOSTED_GEMM(pg8::EpiIn1, (int)((blockIdx.x & 7) % 3), CV_C3, CV_C4A, CV_C4, 96); } SEAM(11);

    if (IN(12)) { p10_conv(F, args); } SEAM(12);

    if (IN(13)) {
        const bf16* CV = (const bf16*)(ws + WS_RC); const float* ACS = (const float*)(ws + WS_ACS); float* STATES = (float*)(ws + WS_STATES);
        for (int u = blockIdx.x; u < 32 * 24; u += F.G) att::ssd_state_unit2(CV, ACS, STATES, u / 24, u % 24, F.ldsg, (float*)(F.ldsg + 132096));
        for (int m = blockIdx.x; m < 128; m += F.G) { const int mh = m & 3, qb = m >> 2;
            att::attn_unit<false, N_IN1, 1024, DM>(H1 + (size_t)(256 * qb) * N_IN1 + 4096 + mh * 128, MEMKV + mh * 128, MEMKV + 512 + mh * 128, HEADS + (size_t)(256 * qb) * DM + 1536 + mh * 128,
                                  4, 0, nullptr, F.ldsg); }
    } SEAM(13);

    if (IN(14)) { p12_scan(F, ws); } SEAM(14);

    if (IN(15)) { const bf16* CV = (const bf16*)(ws + WS_RC); const float* ACS = (const float*)(ws + WS_ACS); const bf16* PREV = (const bf16*)(ws + WS_PREV); const float* dsk = (const float*)args.in[18];
        att::ssd_y_units(CV, ACS, PREV, dsk, (float*)(ws + WS_YSSD), (int)blockIdx.x, F.G, F.ldsg, (float*)(F.ldsg + 132096)); } SEAM(15);

    if (IN(16)) { p14_gated_norm(F, args); } SEAM(16);

    if (IN(17)) { pg8::Gemm g{HEADS, (const bf16*)(ws + WS_WO1), T, DM, DM, DM}; pg8::StaticOrder S; S.init(T, DM, F.G, (int)blockIdx.x);
        pg8::EpiBf16<0> E{YB, DM, nullptr, 0, 0, 1.f};
        pg8::gemm_phase<pg8::EpiBf16<0>, pg8::StaticOrder, true, true>(F.lds + RING_OFF, g, S, E); } SEAM(17);

    if (IN(18)) { ln_rows<true, false>(F, XCURB, YB, (const float*)args.in[21], (const float*)args.in[22], XCURB, (const float*)args.in[23], (int*)(ws + WS_TOKE), (float*)(ws + WS_TOKW)); } SEAM(18);

    if (IN(19)) { p17_sort_gather(F, ws); } SEAM(19);

    { FRESH_TID(tx_); F.tid = tx_; F.lane = tx_ & 63; F.wave = wid_s; F.gw = blockIdx.x * NWAVES + F.wave; }
    if (IN(20)) for (int rep_ = 0; rep_ < REPS(20); ++rep_) { if (rep_) GRID_BAR(); int cnt[8];
#pragma unroll
        for (int e = 0; e < 8; ++e) cnt[e] = __builtin_amdgcn_readfirstlane(((const int*)(ws + WS_COUNTS))[e]);
        pg8::MoeOrder S; S.init(cnt, 56, F.G, (int)blockIdx.x, 1 << 20);
        pg8::Gemm g{(const bf16*)(ws + WS_RC), (const bf16*)(ws + WS_WGUE), MOE_ROWS, 8 * 2 * DFF, DM / 2, DM / 2};
        pg8::EpiSwiGLU8 E{ws + WS_RA, DFF};
        HOSTED_GEMM8_O(pg8::EpiSwiGLU8, pg8::MoeOrder, 124, (int)(blockIdx.x & 7) * 2 + 1  , CV_C4, CV_NITEMS, CV_NITEMS, 0); } SEAM(20);

    { FRESH_TID(tx_); F.tid = tx_; F.lane = tx_ & 63; F.wave = wid_s; F.gw = blockIdx.x * NWAVES + F.wave; }
    if (IN(21)) for (int rep_ = 0; rep_ < REPS(21); ++rep_) { if (rep_) GRID_BAR(); int cnt[8];
#pragma unroll
        for (int e = 0; e < 8; ++e) cnt[e] = __builtin_amdgcn_readfirstlane(((const int*)(ws + WS_COUNTS))[e]);
        pg8::MoeOrder S; S.init(cnt, 8, F.G, (int)blockIdx.x, 2);
        { pg8::Gemm g{(const bf16*)(ws + WS_RA), (const bf16*)(ws + WS_WDE), MOE_ROWS, 8 * DM, DFF / 2, DFF / 2};
          pg8::EpiBf16Mod E{(bf16*)(ws + WS_RB), DM};
          { FRESH_TID(t8_); pg8::gemm_phase<pg8::EpiBf16Mod, pg8::MoeOrder, true, true, 122>(F.lds + RING_OFF, g, S, E, t8_); } }
        const int rem = S.per - 2 * (F.G >> 3);
        if (rem > 0) { const int SP = rem <= 4 ? 7 : 4;

          pg8::MoeSplitOrder S2; S2.init(S, 2, SP, DFF / 2);
          pg8::Gemm g{(const bf16*)(ws + WS_RA), (const bf16*)(ws + WS_WDE), MOE_ROWS, 8 * DM, DFF / 2 / SP, DFF / 2};
          pg8::EpiF32Mod E{(float*)(ws + WS_YF), 256};
          { FRESH_TID(t8_); pg8::gemm_phase<pg8::EpiF32Mod, pg8::MoeSplitOrder, true, true, 122>(F.lds + RING_OFF, g, S2, E, t8_); } } } SEAM(21);

    if (IN(22)) { int cnt[8];
#pragma unroll
        for (int e = 0; e < 8; ++e) cnt[e] = __builtin_amdgcn_readfirstlane(((const int*)(ws + WS_COUNTS))[e]);
        pg8::MoeOrder S; S.init(cnt, 8, F.G, (int)blockIdx.x, 2);
        const int rem = S.per - 2 * (F.G >> 3); const int SP = rem <= 4 ? 7 : 4;
          bf16* YM = (bf16*)(ws + WS_RB); const float* YF = (const float*)(ws + WS_YF);
        for (int it = blockIdx.x; it < 8 * rem * 4; it += F.G) { const int x = it / (4 * rem), r2 = it - x * 4 * rem, u = r2 >> 2, qt = r2 & 3;
            pg8::Unit un; S.decode(x * S.per + 2 * (F.G >> 3) + u, un);
            const float* pp = YF + (size_t)(x * 32 + u * SP) * 65536 + qt * 64 * 256; bf16* op = YM + (size_t)(un.opm * 256 + qt * 64) * DM + un.opn * 256;
            for (int i = F.tid; i < 64 * 64; i += NWAVES * 64) { const int r = i >> 6, c4 = i & 63; const float* q = pp + r * 256 + c4 * 4; f32x4 a;
                if (SP == 7) { f32x4 x[7];
#pragma unroll
                    for (int s = 0; s < 7; ++s) x[s] = *(const f32x4*)(q + (size_t)s * 65536);
                    a = ((x[0] + x[1]) + (x[2] + x[3])) + ((x[4] + x[5]) + x[6]); }
                else { f32x4 x[4];
#pragma unroll
                    for (int s = 0; s < 4; ++s) x[s] = *(const f32x4*)(q + (size_t)s * 65536);
                    a = (x[0] + x[1]) + (x[2] + x[3]); }
                *(v2u*)(op + (size_t)r * DM + c4 * 4) = (v2u){pk2(a[0], a[1]), pk2(a[2], a[3])}; } }
    } SEAM(22);


    if (IN(23)) { p20_final(F, args); }
#undef IN
#undef SEAM
#undef GRID_BAR
}

extern "C" void kernel_launch(void* const* d_in, const int* in_sizes, int n_in, void* d_out, int out_size, void* d_ws, size_t ws_size, hipStream_t stream) {
    static int grid = 0;
    if (grid == 0) {
        if (n_in != 29 || in_sizes[0] != T * DM || out_size != T * DM || ws_size < WS_END) {
            fprintf(stderr, "kernel_launch: unexpected shapes: n_in %d in0 %d out %d ws %zu (need %zu)\n", n_in, n_in > 0 ? in_sizes[0] : -1, out_size, ws_size, (size_t)WS_END); grid = -1; return; }
        int dev = 0, cus = 0, per_cu = 0;
        if (hipGetDevice(&dev) != hipSuccess || hipDeviceGetAttribute(&cus, hipDeviceAttributeMultiprocessorCount, dev) != hipSuccess) { grid = -1; return; }
        if (hipFuncSetAttribute((const void*)mega_fwd, hipFuncAttributeMaxDynamicSharedMemorySize, LDS_BYTES) != hipSuccess) { fprintf(stderr, "kernel_launch: hipFuncSetAttribute failed\n"); grid = -1; return; }
        if (hipOccupancyMaxActiveBlocksPerMultiprocessor(&per_cu, (const void*)mega_fwd, NWAVES * 64, LDS_BYTES) != hipSuccess || per_cu < 1)
            fprintf(stderr, "kernel_launch: occupancy query reports %d workgroups per CU\n", per_cu);
        (void)hipGetLastError();
        grid = cus;
    }
    if (grid < 0) return;
    if (hipMemsetAsync((char*)d_ws + WS_CTL, 0, CTL_ZERO_BYTES, stream) != hipSuccess) return;
    Args a{};
    for (int i = 0; i < 29; ++i) a.in[i] = d_in[i];
    a.out = (float*)d_out; a.ws = (unsigned char*)d_ws;
#if MK_PER_PHASE
    for (int p = 0; p < NPHASE; ++p) { a.ph_lo = p; a.ph_hi = p + 1; hipLaunchKernelGGL(mega_fwd, dim3(grid), dim3(NWAVES * 64), LDS_BYTES, stream, a); }
#else
    a.ph_lo = 0; a.ph_hi = NPHASE;
    hipLaunchKernelGGL(mega_fwd, dim3(grid), dim3(NWAVES * 64), LDS_BYTES, stream, a);
#endif
    const hipError_t le = hipPeekAtLastError();
    if (le != hipSuccess) fprintf(stderr, "kernel_launch: launch failed: %s\n", hipGetErrorName(le));
}
```
